# Optimizing an MI355X kernel written in HIP

```python
import math
import jax, jax.numpy as jnp
from jax import lax
import numpy as np

D_MODEL = 2048
BATCH = 4
SEQ = 2048
DEPTH = 2
DEC_BATCH = 128
DEC_SEQ = 1
PAST_LEN = 16384
PAGE_SIZE = 128

GDN_HEADS = 8
GDN_DK = 128
GDN_DV = 128
GLA_HEADS = 4
GLA_DK = 128
GLA_DV = 256
GLA_RANK = 16
GLA_TAU = 16.0
SSD_HEADS = 32
SSD_HEADDIM = 64
SSD_GROUPS = 4
SSD_STATE = 128
SSD_INNER = SSD_HEADS * SSD_HEADDIM
SSD_NORM_GROUPS = SSD_GROUPS
CONV_WIDTH = 4
CHUNK = 64
D_FF = 5504
N_BRANCH = 3
N_MOD = 9
EPS = 1e-6

GDN_QK = GDN_HEADS * GDN_DK
GDN_V = GDN_HEADS * GDN_DV
GDN_CONV_DIM = 2 * GDN_QK + GDN_V
GLA_QK = GLA_HEADS * GLA_DK
GLA_V = GLA_HEADS * GLA_DV
SSD_BC = SSD_GROUPS * SSD_STATE
SSD_CONV_DIM = SSD_INNER + 2 * SSD_BC
IN_SPLITS = (GDN_CONV_DIM, GDN_V, GDN_HEADS, GDN_HEADS,
             GLA_QK, GLA_QK, GLA_V, GLA_RANK, GLA_V,
             SSD_INNER, SSD_CONV_DIM, SSD_HEADS,
             N_BRANCH * D_MODEL)
IN_TOTAL = sum(IN_SPLITS)

kernel_name = "hybrid_gdn_gla_ssd_macaron_adaln_step"


def split_cols(t, sizes):
    offs = [int(o) for o in np.cumsum(sizes)[:-1]]
    return jnp.split(t, offs, axis=-1)


def rms_norm(x, w):
    xf = x.astype(jnp.float32)
    y = xf * lax.rsqrt(jnp.mean(xf * xf, axis=-1, keepdims=True) + EPS)
    return (y * w.astype(jnp.float32)).astype(x.dtype)


def l2norm(x):
    return x * lax.rsqrt(jnp.sum(x * x, axis=-1, keepdims=True) + EPS)


def swiglu(h, wg, wu, wd):
    return (jax.nn.silu(h @ wg) * (h @ wu)) @ wd


def causal_conv(x, buf, w):
    L = x.shape[1]
    xp = jnp.concatenate([buf.astype(x.dtype), x], axis=1)
    y = xp[:, 0:L] * w[0]
    for j in range(1, CONV_WIDTH):
        y = y + xp[:, j:j + L] * w[j]
    return y, xp[:, xp.shape[1] - (CONV_WIDTH - 1):]


def to_chunks(t, chunk):
    b, l = t.shape[:2]
    return jnp.moveaxis(t.reshape((b, l // chunk, chunk) + t.shape[2:]), 1, 0)


def from_chunks(t):
    n, b, c = t.shape[:3]
    return jnp.moveaxis(t, 0, 1).reshape((b, n * c) + t.shape[3:])


def gated_delta_rule(q, k, v, beta, g, S0, chunk):
    tri = jnp.tril(jnp.ones((chunk, chunk), bool))
    strict = jnp.tril(jnp.ones((chunk, chunk), bool), -1)
    eye = jnp.eye(chunk, dtype=jnp.float32)
    dv = v.shape[-1]

    def step(S, inp):
        qc, kc, vc, bc, gc = inp
        gcum = jnp.cumsum(gc, axis=1).transpose(0, 2, 1)
        decay = jnp.exp(jnp.where(tri, gcum[..., :, None] - gcum[..., None, :], -jnp.inf))
        bt = bc.transpose(0, 2, 1)
        kk = jnp.einsum('bthd,bshd->bhts', kc, kc)
        a_mat = eye + jnp.where(strict, bt[..., :, None] * decay * kk, 0.0)
        rhs = jnp.concatenate([jnp.einsum('bshv,bhs->bhsv', vc, bt),
                               jnp.einsum('bshd,bhs->bhsd', kc, bt * jnp.exp(gcum))], axis=-1)
        sol = lax.linalg.triangular_solve(a_mat, rhs, left_side=True, lower=True, unit_diagonal=True)
        w = sol[..., :dv] - jnp.einsum('bhsd,bhdv->bhsv', sol[..., dv:], S)
        qk = jnp.einsum('bthd,bshd->bhts', qc, kc) * decay
        o = (jnp.einsum('bthd,bhdv->bhtv', qc, S) * jnp.exp(gcum)[..., None]
             + jnp.einsum('bhts,bhsv->bhtv', qk, w))
        g_last = gcum[..., -1:]
        S = S * jnp.exp(g_last)[..., None] + jnp.einsum('bshd,bhs,bhsv->bhdv', kc, jnp.exp(g_last - gcum), w)
        return S, o.transpose(0, 2, 1, 3)

    S, o = lax.scan(step, S0, tuple(to_chunks(t, chunk) for t in (q, k, v, beta, g)))
    return from_chunks(o), S


def gla_recurrence(q, k, v, log_a, S0, chunk):
    tri = jnp.tril(jnp.ones((chunk, chunk), bool))[None, :, :, None, None]

    def step(S, inp):
        qc, kc, vc, ac = inp
        b = jnp.cumsum(ac, axis=1)
        decay = jnp.exp(jnp.where(tri, b[:, :, None] - b[:, None, :], -jnp.inf))
        att = jnp.sum(qc[:, :, None] * kc[:, None, :] * decay, axis=-1)
        o = (jnp.einsum('btsh,bshv->bthv', att, vc)
             + jnp.einsum('bthd,bhdv->bthv', qc * jnp.exp(b), S))
        b_last = b[:, -1]
        S = S * jnp.exp(b_last)[..., None] + jnp.einsum('bshd,bshv->bhdv', kc * jnp.exp(b_last[:, None] - b), vc)
        return S, o

    S, o = lax.scan(step, S0, tuple(to_chunks(t, chunk) for t in (q, k, v, log_a)))
    return from_chunks(o), S


def ssd_recurrence(x, dt, A, Bm, Cm, h0, chunk):
    tri = jnp.tril(jnp.ones((chunk, chunk), bool))
    rep = x.shape[2] // Bm.shape[2]

    def step(h, inp):
        xc, dtc, bc, cc = inp
        acum = jnp.cumsum(dtc * A, axis=1).transpose(0, 2, 1)
        decay = jnp.exp(jnp.where(tri, acum[..., :, None] - acum[..., None, :], -jnp.inf))
        cb = jnp.repeat(jnp.einsum('btgn,bsgn->bgts', cc, bc), rep, axis=1)
        xdt = xc * dtc[..., None]
        ch = jnp.repeat(cc, rep, axis=2)
        bh = jnp.repeat(bc, rep, axis=2)
        y = (jnp.einsum('bhts,bshp->bthp', cb * decay, xdt)
             + jnp.einsum('bthn,bhpn->bthp', ch, h) * jnp.exp(acum).transpose(0, 2, 1)[..., None])
        a_last = acum[..., -1:]
        h = h * jnp.exp(a_last)[..., None] + jnp.einsum('bshn,bhs,bshp->bhpn', bh, jnp.exp(a_last - acum), xdt)
        return h, y

    h, y = lax.scan(step, h0, tuple(to_chunks(t, chunk) for t in (x, dt, Bm, Cm)))
    return from_chunks(y), h


def token_mixer(xn, p, conv_a_buf, s_a, s_b, conv_c_buf, s_c):
    f32 = jnp.float32
    bsz, L, _ = xn.shape
    (qkv_a, z_a, beta_a, dec_a, q_b, k_b, v_b, lr_b, r_b,
     z_c, xbc_c, dt_c, gates) = split_cols(xn @ p['w_in'], IN_SPLITS)

    qkv_a, conv_a_new = causal_conv(qkv_a, conv_a_buf, p['gdn_conv_w'])
    q_a, k_a, v_a = split_cols(jax.nn.silu(qkv_a.astype(f32)), (GDN_QK, GDN_QK, GDN_V))
    q_a = l2norm(q_a.reshape(bsz, L, GDN_HEADS, GDN_DK)) * (GDN_DK ** -0.5)
    k_a = l2norm(k_a.reshape(bsz, L, GDN_HEADS, GDN_DK))
    v_a = v_a.reshape(bsz, L, GDN_HEADS, GDN_DV)
    beta_a = jax.nn.sigmoid(beta_a.astype(f32))
    g_a = -jnp.exp(p['gdn_a_log'].astype(f32)) * jax.nn.softplus(dec_a.astype(f32) + p['gdn_dt_bias'].astype(f32))

    q_b = q_b.astype(f32).reshape(bsz, L, GLA_HEADS, GLA_DK) * (GLA_DK ** -0.5)
    k_b = k_b.astype(f32).reshape(bsz, L, GLA_HEADS, GLA_DK)
    v_b = v_b.astype(f32).reshape(bsz, L, GLA_HEADS, GLA_DV)
    la_b = (jax.nn.log_sigmoid((lr_b @ p['gla_w_gate'] + p['gla_b_gate']).astype(f32)) / GLA_TAU
            ).reshape(bsz, L, GLA_HEADS, GLA_DK)

    xbc_c, conv_c_new = causal_conv(xbc_c, conv_c_buf, p['ssd_conv_w'])
    xbc_c = jax.nn.silu((xbc_c + p['ssd_conv_b']).astype(f32))
    x_c, b_c, c_c = split_cols(xbc_c, (SSD_INNER, SSD_BC, SSD_BC))
    x_c = x_c.reshape(bsz, L, SSD_HEADS, SSD_HEADDIM)
    b_c = b_c.reshape(bsz, L, SSD_GROUPS, SSD_STATE)
    c_c = c_c.reshape(bsz, L, SSD_GROUPS, SSD_STATE)
    dt = jax.nn.softplus(dt_c.astype(f32) + p['ssd_dt_bias'].astype(f32))
    A = -jnp.exp(p['ssd_a_log'].astype(f32))

    chunk = min(CHUNK, L)
    Lp = -(-L // chunk) * chunk

    def pad(t):
        return jnp.pad(t, [(0, 0), (0, Lp - L)] + [(0, 0)] * (t.ndim - 2))

    o_a, s_a_new = gated_delta_rule(pad(q_a), pad(k_a), pad(v_a), pad(beta_a), pad(g_a), s_a.astype(f32), chunk)
    o_b, s_b_new = gla_recurrence(pad(q_b), pad(k_b), pad(v_b), pad(la_b), s_b.astype(f32), chunk)
    y_c, s_c_new = ssd_recurrence(pad(x_c), pad(dt), A, pad(b_c), pad(c_c), s_c.astype(f32), chunk)

    o_a = (rms_norm(o_a[:, :L], p['gdn_norm_w'])
           * jax.nn.silu(z_a.astype(f32).reshape(bsz, L, GDN_HEADS, GDN_DV))).reshape(bsz, L, GDN_V)
    o_b = (rms_norm(o_b[:, :L], p['gla_norm_w'])
           * jax.nn.silu(r_b.astype(f32).reshape(bsz, L, GLA_HEADS, GLA_DV))).reshape(bsz, L, GLA_V)
    y_c = (y_c[:, :L] + p['ssd_d'].astype(f32)[:, None] * x_c).reshape(bsz, L, SSD_INNER)
    y_c = y_c * jax.nn.silu(z_c.astype(f32))
    y_c = rms_norm(y_c.reshape(bsz, L, SSD_NORM_GROUPS, SSD_INNER // SSD_NORM_GROUPS),
                   p['ssd_norm_w'].reshape(SSD_NORM_GROUPS, SSD_INNER // SSD_NORM_GROUPS)).reshape(bsz, L, SSD_INNER)

    g_a_br, g_b_br, g_c_br = jnp.split(jax.nn.sigmoid(gates.astype(f32)), N_BRANCH, axis=-1)
    merged = (g_a_br * (o_a @ p['w_branch_gdn']) + g_b_br * (o_b @ p['w_branch_gla'])
              + g_c_br * (y_c @ p['w_branch_ssd']))
    out = (merged @ p['w_out']).astype(xn.dtype)
    new_state = (conv_a_new.astype(conv_a_buf.dtype), s_a_new.astype(s_a.dtype), s_b_new.astype(s_b.dtype),
                 conv_c_new.astype(conv_c_buf.dtype), s_c_new.astype(s_c.dtype))
    return out, new_state


def decoder_layer(x, c, p, st):
    mod = jax.nn.silu(c) @ p['w_ada'] + p['b_ada']
    sh1, sc1, gt1, sh2, sc2, gt2, sh3, sc3, gt3 = jnp.split(mod[:, None, :], N_MOD, axis=-1)
    h = rms_norm(x, p['norm1']) * (1.0 + sc1) + sh1
    x = x + 0.5 * gt1 * swiglu(h, p['ffn1_wg'], p['ffn1_wu'], p['ffn1_wd'])
    h = rms_norm(x, p['norm2']) * (1.0 + sc2) + sh2
    m, st = token_mixer(h, p, *st)
    x = x + gt2 * m
    h = rms_norm(x, p['norm3']) * (1.0 + sc3) + sh3
    x = x + 0.5 * gt3 * swiglu(h, p['ffn2_wg'], p['ffn2_wu'], p['ffn2_wd'])
    return x, st


def run_trunk(x, c, states, layer_params, final_norm):
    per_layer = []
    for l in range(DEPTH):
        x, st = decoder_layer(x, c, layer_params[l], tuple(s[l] for s in states))
        per_layer.append(st)
    new_states = tuple(jnp.stack([st[i] for st in per_layer]) for i in range(len(states)))
    return rms_norm(x, final_norm), new_states


def setup_inputs(seed: int = 0) -> dict:
    key = jax.random.key(seed)
    ks = jax.random.split(key, 48)
    f32 = jnp.float32
    L, D = DEPTH, D_MODEL

    def nrm(k, shape, scale):
        return scale * jax.random.normal(k, shape, f32)

    def gain(k, shape):
        return 1.0 + nrm(k, shape, 0.02)

    def dt_bias(k, shape):
        dt = jnp.exp(jax.random.uniform(k, shape, f32, math.log(1e-3), math.log(1e-1)))
        return dt + jnp.log(-jnp.expm1(-dt))

    def a_log(k, shape):
        return jnp.log(jax.random.uniform(k, shape, f32, 1.0, 16.0))

    return {
        "x_prompt": nrm(ks[0], (BATCH, SEQ, D), 1.0),
        "x_sample": nrm(ks[1], (DEC_BATCH, DEC_SEQ, D), 1.0),
        "state_gdn_conv": nrm(ks[2], (L, DEC_BATCH, CONV_WIDTH - 1, GDN_CONV_DIM), 1.0),
        "state_gdn": nrm(ks[3], (L, DEC_BATCH, GDN_HEADS, GDN_DK, GDN_DV), 0.1),
        "state_gla": nrm(ks[4], (L, DEC_BATCH, GLA_HEADS, GLA_DK, GLA_DV), 0.1),
        "state_ssd_conv": nrm(ks[5], (L, DEC_BATCH, CONV_WIDTH - 1, SSD_CONV_DIM), 1.0),
        "state_ssd": nrm(ks[6], (L, DEC_BATCH, SSD_HEADS, SSD_HEADDIM, SSD_STATE), 0.1),
        "c_prompt": nrm(ks[7], (BATCH, D), 1.0),
        "c_sample": nrm(ks[8], (DEC_BATCH, D), 1.0),
        "w_ada": nrm(ks[9], (L, D, N_MOD * D), 0.5 * D ** -0.5),
        "b_ada": nrm(ks[10], (L, N_MOD * D), 0.02),
        "norm1": gain(ks[11], (L, D)),
        "norm2": gain(ks[12], (L, D)),
        "norm3": gain(ks[13], (L, D)),
        "ffn1_wg": nrm(ks[14], (L, D, D_FF), D ** -0.5),
        "ffn1_wu": nrm(ks[15], (L, D, D_FF), D ** -0.5),
        "ffn1_wd": nrm(ks[16], (L, D_FF, D), D_FF ** -0.5),
        "ffn2_wg": nrm(ks[17], (L, D, D_FF), D ** -0.5),
        "ffn2_wu": nrm(ks[18], (L, D, D_FF), D ** -0.5),
        "ffn2_wd": nrm(ks[19], (L, D_FF, D), D_FF ** -0.5),
        "w_in": nrm(ks[20], (L, D, IN_TOTAL), D ** -0.5),
        "gdn_conv_w": nrm(ks[21], (L, CONV_WIDTH, GDN_CONV_DIM), CONV_WIDTH ** -0.5),
        "gdn_a_log": a_log(ks[22], (L, GDN_HEADS)),
        "gdn_dt_bias": dt_bias(ks[23], (L, GDN_HEADS)),
        "gdn_norm_w": gain(ks[24], (L, GDN_DV)),
        "gla_w_gate": nrm(ks[25], (L, GLA_RANK, GLA_QK), GLA_RANK ** -0.5),
        "gla_b_gate": nrm(ks[26], (L, GLA_QK), 0.02),
        "gla_norm_w": gain(ks[27], (L, GLA_DV)),
        "ssd_conv_w": nrm(ks[28], (L, CONV_WIDTH, SSD_CONV_DIM), CONV_WIDTH ** -0.5),
        "ssd_conv_b": nrm(ks[29], (L, SSD_CONV_DIM), 0.02),
        "ssd_a_log": a_log(ks[30], (L, SSD_HEADS)),
        "ssd_dt_bias": dt_bias(ks[31], (L, SSD_HEADS)),
        "ssd_d": gain(ks[32], (L, SSD_HEADS)),
        "ssd_norm_w": gain(ks[33], (L, SSD_INNER)),
        "w_branch_gdn": nrm(ks[34], (L, GDN_V, D), GDN_V ** -0.5),
        "w_branch_gla": nrm(ks[35], (L, GLA_V, D), GLA_V ** -0.5),
        "w_branch_ssd": nrm(ks[36], (L, SSD_INNER, D), SSD_INNER ** -0.5),
        "w_out": nrm(ks[37], (L, D, D), D ** -0.5),
        "final_norm": gain(ks[38], (D,)),
    }


def reference(x_prompt, x_sample, state_gdn_conv, state_gdn, state_gla, state_ssd_conv, state_ssd,
              c_prompt, c_sample, w_ada, b_ada, norm1, norm2, norm3,
              ffn1_wg, ffn1_wu, ffn1_wd, ffn2_wg, ffn2_wu, ffn2_wd,
              w_in, gdn_conv_w, gdn_a_log, gdn_dt_bias, gdn_norm_w,
              gla_w_gate, gla_b_gate, gla_norm_w,
              ssd_conv_w, ssd_conv_b, ssd_a_log, ssd_dt_bias, ssd_d, ssd_norm_w,
              w_branch_gdn, w_branch_gla, w_branch_ssd, w_out, final_norm):
    layer_params = [dict(w_ada=w_ada[l], b_ada=b_ada[l], norm1=norm1[l], norm2=norm2[l], norm3=norm3[l],
                         ffn1_wg=ffn1_wg[l], ffn1_wu=ffn1_wu[l], ffn1_wd=ffn1_wd[l],
                         ffn2_wg=ffn2_wg[l], ffn2_wu=ffn2_wu[l], ffn2_wd=ffn2_wd[l],
                         w_in=w_in[l], gdn_conv_w=gdn_conv_w[l], gdn_a_log=gdn_a_log[l],
                         gdn_dt_bias=gdn_dt_bias[l], gdn_norm_w=gdn_norm_w[l],
                         gla_w_gate=gla_w_gate[l], gla_b_gate=gla_b_gate[l], gla_norm_w=gla_norm_w[l],
                         ssd_conv_w=ssd_conv_w[l], ssd_conv_b=ssd_conv_b[l], ssd_a_log=ssd_a_log[l],
                         ssd_dt_bias=ssd_dt_bias[l], ssd_d=ssd_d[l], ssd_norm_w=ssd_norm_w[l],
                         w_branch_gdn=w_branch_gdn[l], w_branch_gla=w_branch_gla[l],
                         w_branch_ssd=w_branch_ssd[l], w_out=w_out[l])
                    for l in range(DEPTH)]
    sample_states = (state_gdn_conv, state_gdn, state_gla, state_ssd_conv, state_ssd)
    nb = x_prompt.shape[0]
    prompt_states = tuple(jnp.zeros((s.shape[0], nb) + s.shape[2:], x_prompt.dtype) for s in sample_states)
    y_prompt, (p_gdn_conv, p_gdn, p_gla, p_ssd_conv, p_ssd) = run_trunk(
        x_prompt, c_prompt, prompt_states, layer_params, final_norm)
    y_sample, (s_gdn_conv, s_gdn, s_gla, s_ssd_conv, s_ssd) = run_trunk(
        x_sample, c_sample, sample_states, layer_params, final_norm)
    return (y_prompt, y_sample, p_gdn_conv, p_gdn, p_gla, p_ssd_conv, p_ssd,
            s_gdn_conv, s_gdn, s_gla, s_ssd_conv, s_ssd)
```

```cpp
#define MK_N_LAUNCHES 1
#define REPMASK 0
#include <hip/hip_runtime.h>
#include <cstdio>
#include <cstdint>

#define LAS __attribute__((address_space(3)))
typedef unsigned short bf16_t;
typedef short bf16x8 __attribute__((ext_vector_type(8)));
typedef float f32x4 __attribute__((ext_vector_type(4)));
typedef float f32x2 __attribute__((ext_vector_type(2)));
typedef unsigned u32x4 __attribute__((ext_vector_type(4)));
typedef unsigned u32x2 __attribute__((ext_vector_type(2)));

constexpr int D = 2048, NB = 4, SEQ = 2048, NPT = NB * SEQ  , NS = 128  , MT = NPT + NS  , MP = 8448  ;
constexpr int NCR = NB + NS;
constexpr int FF = 5504, NMOD = 9 * D;
constexpr int NIN = 18496, PW = 18432  , NINP = 18688  , SW = 64  ;
constexpr int P_QKVA = 0, P_ZA = 3072, P_QB = 4096, P_KB = 4608, P_VB = 5120, P_RB = 6144, P_ZC = 7168, P_XBC = 9216, P_GATES = 12288;
constexpr int S_BETA = 0, S_DEC = 8, S_LR = 16, S_DT = 32;
constexpr int NCHUNK = 32, CH = 64;
constexpr float EPS = 1e-6f;

__device__ __forceinline__ unsigned f2bf(float f) { unsigned u = __builtin_bit_cast(unsigned, f); return (u + 0x7fffu + ((u >> 16) & 1u)) >> 16; }
__device__ __forceinline__ unsigned pk2(float lo, float hi) { return f2bf(lo) | (f2bf(hi) << 16); }
__device__ __forceinline__ float bf2f(unsigned short b) { return __builtin_bit_cast(float, ((unsigned)b) << 16); }
__device__ __forceinline__ float bflo(unsigned w) { return __builtin_bit_cast(float, w << 16); }
__device__ __forceinline__ float bfhi(unsigned w) { return __builtin_bit_cast(float, w & 0xffff0000u); }
__device__ __forceinline__ float fast_rcp(float x) { return __builtin_amdgcn_rcpf(x); }
__device__ __forceinline__ float sigmoidf_(float x) { return fast_rcp(1.f + __expf(-x)); }
__device__ __forceinline__ float siluf_(float x) { return x * sigmoidf_(x); }
__device__ __forceinline__ float softplusf_(float x) { return fmaxf(x, 0.f) + __logf(1.f + __expf(-fabsf(x))); }
__device__ __forceinline__ float logsigmoidf_(float x) { return fminf(x, 0.f) - __logf(1.f + __expf(-fabsf(x))); }
__device__ __forceinline__ float wave_sum(float v) {
#pragma unroll
    for (int o = 1; o < 64; o <<= 1) v += __shfl_xor(v, o);
    return v;
}
__device__ __forceinline__ int ltid() { int t = threadIdx.x; asm volatile("" : "+v"(t)); return t; }
#define LBAR() do { asm volatile("s_waitcnt lgkmcnt(0)" ::: "memory"); __builtin_amdgcn_s_barrier(); asm volatile("" ::: "memory"); } while (0)
__device__ __forceinline__ float vload_f32(const float* p) { asm volatile("" : "+v"(p)); return *p; }
__device__ __forceinline__ void st16_asm(bf16_t* p, unsigned v) { asm volatile("global_store_short %0, %1, off" :: "v"(p), "v"(v) : "memory"); }
__device__ __forceinline__ u32x4 ld16_asm(const void* p) { u32x4 r; asm volatile("global_load_dwordx4 %0, %1, off" : "=v"(r) : "v"(p) : "memory"); return r; }
__device__ __forceinline__ float ld4_asm(const void* p) { float r; asm volatile("global_load_dword %0, %1, off" : "=v"(r) : "v"(p) : "memory"); return r; }
#define VMW_CASE(n) case n: asm volatile("s_waitcnt vmcnt(" #n ")" ::: "memory"); break;
__device__ __forceinline__ void wait_vm(int n) {
    switch (n) { VMW_CASE(0) VMW_CASE(4) VMW_CASE(7) VMW_CASE(8) VMW_CASE(9) VMW_CASE(11) VMW_CASE(12) VMW_CASE(14) VMW_CASE(15) VMW_CASE(16) VMW_CASE(17) VMW_CASE(18) VMW_CASE(19) VMW_CASE(20) VMW_CASE(22) VMW_CASE(23) VMW_CASE(24) VMW_CASE(25) VMW_CASE(26) VMW_CASE(27) VMW_CASE(28) VMW_CASE(30) VMW_CASE(33) VMW_CASE(34) VMW_CASE(36) VMW_CASE(42)
      default: asm volatile("s_waitcnt vmcnt(0)" ::: "memory"); break; }
}
#define LDS_WAIT() asm volatile("s_waitcnt lgkmcnt(0)" ::: "memory")
#define VM_WAIT() asm volatile("s_waitcnt vmcnt(0)" ::: "memory")

namespace pg8 {
constexpr int BM = 256, BK = 64, HALF = 128, HTB = HALF * BK * 2, STAGE_BYTES = 8 * HTB, NXCD = 8, WGM = 8;
__host__ __device__ __forceinline__ int lds_byte(int r, int c) { const int st = (r >> 4) * 2 + (c >> 5), rr = r & 15, cc = c & 31, ob = rr * 64 + cc * 2; return st * 1024 + (ob ^ (((ob >> 9) & 1) << 5)); }
__host__ __device__ __forceinline__ void stage_rc(int b, int& R, int& C) { const int st = b / 1024, sb = b % 1024, swz = sb ^ (((sb >> 9) & 1) << 5); R = (st >> 1) * 16 + swz / 64; C = (st & 1) * 32 + (swz % 64) / 2; }
__host__ __device__ __forceinline__ int perm32(int rho) { const int n = rho >> 4, i = rho & 15; return 8 * (i >> 2) + 4 * n + (i & 3); }

struct Unit { int pm, pn, k0, nt, seg; };
struct Gemm { const bf16_t* A; const bf16_t* Bt; int K; };

struct Sched {
    int nM, nN, nwg, G, c, nseg, nt;
    int nmini, mini_last_nt;
    __device__ __forceinline__ void init(int nM_, int nN_, int G_, int c_, int K) { nM = nM_; nN = nN_; nwg = nM * nN; G = G_; c = c_; nseg = 1; nt = K / BK; nmini = 0; mini_last_nt = 4; }
    __device__ __forceinline__ bool next(int i, Unit& u) const {
        const int ui = (nseg == 1) ? i : i / 3, sg = (nseg == 1) ? 0 : i - 3 * ui;
        const long L = (long)ui * G + c;
        if (L >= nwg) {
            const int mi = (int)(L - nwg); if (mi >= nmini) return false;
            const int chunk = mi / nN; u.pm = nM; u.pn = mi - chunk * nN; u.k0 = chunk * 4 * BK; u.nt = (mi + nN >= nmini) ? mini_last_nt : 4; u.seg = 1; return true;
        }
        int wgid = (int)L; { const int q = nwg / NXCD, r = nwg % NXCD, xcd = wgid % NXCD, off = wgid / NXCD; wgid = (xcd < r ? xcd * (q + 1) : r * (q + 1) + (xcd - r) * q) + off; }
        const int nig = WGM * nN, gid = wgid / nig, fm = gid * WGM, gsz = (nM - fm) < WGM ? (nM - fm) : WGM;
        u.pm = fm + ((wgid % nig) % gsz); u.pn = (wgid % nig) / gsz;
        u.k0 = sg * 1024; u.nt = (nseg == 1) ? nt : (sg == 2 ? 32 : 16); u.seg = sg; return true;
    }
};
__device__ __forceinline__ unsigned cvt_pk_bf16(float lo, float hi) { unsigned r; asm volatile("v_cvt_pk_bf16_f32 %0, %1, %2" : "=v"(r) : "v"(lo), "v"(hi)); return r; }

template <class Epi>
__device__ __forceinline__ void gemm_phase(LAS unsigned char* lds, const Gemm g, const Sched& S, const Epi& E) {
    const int tid = ltid(), wid = __builtin_amdgcn_readfirstlane(tid >> 6), lane = tid & 63, wr = wid >> 2, wc = wid & 3, fr = lane & 15, fq = lane >> 4;
    const int K = g.K;
    unsigned voffA[2], voffB[2];
#pragma unroll
    for (int i = 0; i < 2; ++i) { int R, C; stage_rc(tid * 16 + i * 8192, R, C); const int Rb = Epi::PERM ? ((R & ~31) + perm32(R & 31)) : R;
        voffA[i] = (unsigned)(R * K + C) * 2u; voffB[i] = (unsigned)(Rb * K + C) * 2u; }
    const size_t kstep = (size_t)(BK * 2);
    const size_t hstep = (size_t)HALF * K * 2;
    const size_t tstep = 2 * hstep;
    const unsigned ldsw = (unsigned)wid * 1024u;
    const int aoff = lds_byte(wr * 64 + fr, fq * 8), boff = lds_byte(wc * 32 + fr, fq * 8);
#define PG8_SA(b, h) (((b) * 2 + (h)) * HTB)
#define PG8_SB(b, h) ((4 + (b) * 2 + (h)) * HTB)
#define PG8_STAGE(bufoff, gbase, voff) do { _Pragma("unroll") for (int _i = 0; _i < 2; ++_i) \
        __builtin_amdgcn_global_load_lds((const unsigned*)((const char*)(gbase) + (voff)[_i]), (LAS unsigned*)(lds + (bufoff) + ldsw + _i * 8192), 16, 0, 0); } while (0)
#define PG8_LDA(dst, b, h) do { _Pragma("unroll") for (int m = 0; m < 4; ++m) _Pragma("unroll") for (int k = 0; k < 2; ++k) dst[m][k] = *(const LAS bf16x8*)(lds + PG8_SA(b, h) + aoff + m * 2048 + k * 1024); } while (0)
#define PG8_LDB(dst, b, h) do { _Pragma("unroll") for (int n = 0; n < 2; ++n) _Pragma("unroll") for (int k = 0; k < 2; ++k) dst[n][k] = *(const LAS bf16x8*)(lds + PG8_SB(b, h) + boff + n * 2048 + k * 1024); } while (0)
#define PG8_MMA(ai, bj, At, Bt) do { __builtin_amdgcn_s_setprio(1); _Pragma("unroll") for (int m = 0; m < 4; ++m) _Pragma("unroll") for (int n = 0; n < 2; ++n) _Pragma("unroll") for (int k = 0; k < 2; ++k) \
        acc[ai][bj][m][n] = __builtin_amdgcn_mfma_f32_16x16x32_bf16(Bt[n][k], At[m][k], acc[ai][bj][m][n], 0, 0, 0); __builtin_amdgcn_s_setprio(0); } while (0)
#define PG8_WAIT_V(n) asm volatile("s_waitcnt vmcnt(" #n ")" ::: "memory")
#define PG8_WAIT_L(n) asm volatile("s_waitcnt lgkmcnt(" #n ")" ::: "memory")
#define PG8_BAR __builtin_amdgcn_s_barrier()
#define PG8_SCHED __builtin_amdgcn_sched_barrier(0)
    Unit cur, nxt; int ui = 0;
    if (!S.next(0, cur)) return;
    f32x4 acc[2][2][4][2];
#pragma unroll
    for (int a = 0; a < 2; ++a)
#pragma unroll
        for (int b = 0; b < 2; ++b)
#pragma unroll
            for (int m = 0; m < 4; ++m)
#pragma unroll
                for (int n = 0; n < 2; ++n) acc[a][b][m][n] = (f32x4){0.f, 0.f, 0.f, 0.f};
    bf16x8 At[4][2], B0[2][2], B1[2][2];
    const char* cA = (const char*)g.A + (size_t)cur.pm * tstep + (size_t)cur.k0 * 2; const char* cB = (const char*)g.Bt + (size_t)cur.pn * tstep + (size_t)cur.k0 * 2;
    PG8_STAGE(PG8_SB(0, 0), cB, voffB); PG8_STAGE(PG8_SB(0, 1), cB + hstep, voffB); PG8_STAGE(PG8_SA(0, 0), cA, voffA); PG8_STAGE(PG8_SA(0, 1), cA + hstep, voffA);
    if (wr == 1) PG8_BAR;
    PG8_WAIT_V(2); PG8_BAR;
    PG8_STAGE(PG8_SB(1, 0), cB + kstep, voffB); PG8_STAGE(PG8_SA(1, 0), cA + kstep, voffA); PG8_STAGE(PG8_SB(1, 1), cB + hstep + kstep, voffB);
    PG8_WAIT_V(6); PG8_BAR;
    for (;;) {
        const bool has_next = S.next(ui + 1, nxt);
        const char* nA = has_next ? (const char*)g.A + (size_t)nxt.pm * tstep + (size_t)nxt.k0 * 2 : cA; const char* nB = has_next ? (const char*)g.Bt + (size_t)nxt.pn * tstep + (size_t)nxt.k0 * 2 : cB;
        const int nt = cur.nt;
        for (int t = 0; t < nt; t += 2) {
            const bool last = (t == nt - 2);
            const char* a1 = cA + (size_t)(t + 1) * kstep;
            const char* a2 = last ? nA : cA + (size_t)(t + 2) * kstep; const char* b2 = last ? nB : cB + (size_t)(t + 2) * kstep;
            const char* a3 = a2 + kstep; const char* b3 = b2 + kstep;
            PG8_LDB(B0, 0, 0); PG8_LDB(B1, 0, 1); PG8_SCHED; PG8_LDA(At, 0, 0); PG8_STAGE(PG8_SA(1, 1), a1 + hstep, voffA);
            PG8_WAIT_V(8); PG8_WAIT_L(0); PG8_BAR; PG8_MMA(0, 0, At, B0); PG8_MMA(0, 1, At, B1); PG8_BAR; PG8_SCHED;
            PG8_LDA(At, 0, 1); PG8_STAGE(PG8_SB(0, 0), b2, voffB); PG8_STAGE(PG8_SB(0, 1), b2 + hstep, voffB); PG8_STAGE(PG8_SA(0, 0), a2, voffA);
            PG8_WAIT_V(8); PG8_WAIT_L(0); PG8_BAR; PG8_MMA(1, 0, At, B0); PG8_MMA(1, 1, At, B1); PG8_BAR; PG8_SCHED;
            PG8_LDB(B0, 1, 0); PG8_LDB(B1, 1, 1); PG8_SCHED; PG8_LDA(At, 1, 0); PG8_STAGE(PG8_SA(0, 1), a2 + hstep, voffA);
            PG8_WAIT_V(8); PG8_WAIT_L(0); PG8_BAR; PG8_MMA(0, 0, At, B0); PG8_MMA(0, 1, At, B1); PG8_BAR; PG8_SCHED;
            PG8_LDA(At, 1, 1); PG8_STAGE(PG8_SB(1, 0), b3, voffB); PG8_STAGE(PG8_SB(1, 1), b3 + hstep, voffB); PG8_STAGE(PG8_SA(1, 0), a3, voffA);
            PG8_WAIT_V(8); PG8_WAIT_L(0); PG8_BAR; PG8_MMA(1, 0, At, B0); PG8_MMA(1, 1, At, B1); PG8_BAR; PG8_SCHED;
        }
        if (wr == 0) PG8_BAR;
        E(acc, cur, wr, wc, fr, fq);
        if (!has_next) break;
#pragma unroll
        for (int a = 0; a < 2; ++a)
#pragma unroll
            for (int b = 0; b < 2; ++b)
#pragma unroll
                for (int m = 0; m < 4; ++m)
#pragma unroll
                    for (int n = 0; n < 2; ++n) acc[a][b][m][n] = (f32x4){0.f, 0.f, 0.f, 0.f};
        cur = nxt; cA = nA; cB = nB; ++ui;
        if (wr == 1) PG8_BAR;
    }
    PG8_WAIT_V(0);
    PG8_BAR;
#undef PG8_SA
#undef PG8_SB
#undef PG8_STAGE
#undef PG8_LDA
#undef PG8_LDB
#undef PG8_MMA
#undef PG8_WAIT_V
#undef PG8_WAIT_L
#undef PG8_BAR
#undef PG8_SCHED
}
}

#define XB_TMO      128
#define XB_XCNT(j)  (256  + 64 * (j))
#define XB_XSUB(j)  (1280 + 64 * (j))
#define XB_XGEN(j)  (2304 + 64 * (j))
#define XB_TOP      3328
#define XB_TOPGEN   3392
#define XCD_BAR_WORDS 3456
#define XB_SPIN_CAP (1u << 18)
__device__ __forceinline__ unsigned xb_ld(unsigned* p)              { return __hip_atomic_load(p, __ATOMIC_RELAXED, __HIP_MEMORY_SCOPE_AGENT); }
__device__ __forceinline__ unsigned xb_add(unsigned* p, unsigned v) { return __hip_atomic_fetch_add(p, v, __ATOMIC_RELAXED, __HIP_MEMORY_SCOPE_AGENT); }
__device__ __forceinline__ unsigned xb_xcc_id() { return (unsigned)__builtin_amdgcn_s_getreg((3 << 11) | 20) & 0xFu; }
#define XB_SPIN(cond, bar) do { unsigned _sp = 0; while (cond) { __builtin_amdgcn_s_sleep(1); \
    if ((++_sp & 255u) == 0u) { if (xb_ld(&(bar)[XB_TMO])) break; if (_sp > XB_SPIN_CAP) { atomicAdd(&(bar)[XB_TMO], 1u); break; } } } } while (0)
struct XcdBarrier { unsigned* bar; unsigned x; volatile LAS unsigned* st; };
__device__ __forceinline__ XcdBarrier xcd_barrier_post(unsigned* bar, volatile LAS unsigned* st) {
    XcdBarrier b; b.bar = bar; b.x = xb_xcc_id(); b.st = st;
    if (threadIdx.x == 0) (void)xb_add(&bar[XB_XCNT(b.x)], 1u);
    return b;
}
__device__ __forceinline__ void xcd_barrier_complete(unsigned* bar, unsigned x, unsigned& nloc, unsigned& nx) {
    const unsigned G = gridDim.x * gridDim.y * gridDim.z;
    unsigned sum, cnt, mine, sp = 0u;
    for (;;) {
        sum = 0u; cnt = 0u; mine = 0u;
#pragma unroll
        for (unsigned j = 0; j < 16; ++j) { const unsigned c = xb_ld(&bar[XB_XCNT(j)]); sum += c; cnt += (c > 0u) ? 1u : 0u; mine = (j == x) ? c : mine; }
        if (sum == G) break;
        __builtin_amdgcn_s_sleep(1);
        if ((++sp & 255u) == 0u) { if (xb_ld(&bar[XB_TMO])) break; if (sp > XB_SPIN_CAP) { atomicAdd(&bar[XB_TMO], 1u); break; } }
    }
    nloc = mine > 0u ? mine : 1u; nx = cnt > 0u ? cnt : 1u;
}
__device__ __forceinline__ void xcd_barrier(const XcdBarrier& b) {
    asm volatile("s_waitcnt vmcnt(0)" ::: "memory");
    __syncthreads();
    if (threadIdx.x == 0) {
        unsigned* bar = b.bar;
        __builtin_amdgcn_s_waitcnt(0);
        unsigned nloc = b.st[0], nx = b.st[1];
        if (nloc == 0u) { xcd_barrier_complete(bar, b.x, nloc, nx); b.st[0] = nloc; b.st[1] = nx; }
        const unsigned old = xb_add(&bar[XB_XSUB(b.x)], 1u);
        const unsigned gen = old / nloc;
        if (old + 1u == (gen + 1u) * nloc) {
            __builtin_amdgcn_fence(__ATOMIC_RELEASE, "agent");
            asm volatile("s_waitcnt vmcnt(0)" ::: "memory");
            const unsigned og = xb_add(&bar[XB_TOP], 1u);
            const unsigned tg = og / nx;
            if (og + 1u == (tg + 1u) * nx) xb_add(&bar[XB_TOPGEN], 1u);
            else XB_SPIN(xb_ld(&bar[XB_TOPGEN]) == tg, bar);
            __builtin_amdgcn_fence(__ATOMIC_ACQUIRE, "agent");
            xb_add(&bar[XB_XGEN(b.x)], 1u);
            asm volatile("s_waitcnt vmcnt(0)" ::: "memory");
        } else {
            XB_SPIN(xb_ld(&bar[XB_XGEN(b.x)]) == gen, bar);
            __builtin_amdgcn_fence(__ATOMIC_ACQUIRE, "agent");
            asm volatile("s_waitcnt vmcnt(0)" ::: "memory");
        }
    }
    __syncthreads();
}

constexpr size_t al(size_t x) { return (x + 0xFFFFFull) & ~(size_t)0xFFFFFull; }
constexpr size_t WS_CTL = 0, CTL_BYTES = 1u << 20;
constexpr size_t SZ_WGU = (size_t)2 * FF * D * 2, SZ_WD = (size_t)D * FF * 2, SZ_WIN = (size_t)NINP * D * 2, SZ_WBR = (size_t)D * 4096 * 2, SZ_WOUT = (size_t)D * D * 2;
constexpr size_t LW_GU1 = 0, LW_D1 = LW_GU1 + al(SZ_WGU), LW_GU2 = LW_D1 + al(SZ_WD), LW_D2 = LW_GU2 + al(SZ_WGU), LW_IN = LW_D2 + al(SZ_WD), LW_BR = LW_IN + al(SZ_WIN), LW_OUT = LW_BR + al(SZ_WBR), LW_SIZE = LW_OUT + al(SZ_WOUT);
constexpr size_t WS_W = WS_CTL + CTL_BYTES;
constexpr size_t WS_MOD = WS_W + 2 * LW_SIZE;
constexpr size_t WS_SC = WS_MOD + al((size_t)2 * NCR * NMOD * 4);
constexpr size_t WS_X = WS_SC + al((size_t)144 * D * 2);
constexpr size_t WS_H = WS_X + al((size_t)MP * D * 4);
constexpr size_t WS_ACT = WS_H + al((size_t)MP * D * 2);
constexpr size_t WS_PROJ = WS_ACT + al((size_t)MP * FF * 2);
constexpr size_t WS_SMALL = WS_PROJ + al((size_t)MP * PW * 2);
constexpr size_t WS_BR = WS_SMALL + al((size_t)MP * SW * 4);
constexpr size_t WS_MRG = WS_BR + al((size_t)MP * 4096 * 2);
constexpr size_t WS_MRGB = WS_MRG + al((size_t)MP * D * 4);
constexpr size_t WS_MIX = WS_MRGB + al((size_t)MP * D * 2);

constexpr int RING_BYTES = 131072, LDS_BYTES = 147456, LDSCTL_OFF = LDS_BYTES - 64;
constexpr int NWAVES = 8, NTHR = 512;

struct Args { const float* in[39]; float* out; unsigned char* ws; int ph_lo, ph_hi; };

__device__ __forceinline__ int map_row(int mode, int n) {
    if (mode == 0) return n;
    if (mode == 1) return ((n >> 7) << 8) + (n & 127);
    if (mode == 2) return ((n >> 7) << 8) + 128 + (n & 127);
    if (n < 4096) return n;
    if (n < 4104) return PW + S_BETA + (n - 4096);
    if (n < 4112) return PW + S_DEC + (n - 4104);
    if (n < 4624) return P_QB + (n - 4112);
    if (n < 5136) return P_KB + (n - 4624);
    if (n < 6160) return P_VB + (n - 5136);
    if (n < 6176) return PW + S_LR + (n - 6160);
    if (n < 7200) return P_RB + (n - 6176);
    if (n < 9248) return P_ZC + (n - 7200);
    if (n < 12320) return P_XBC + (n - 9248);
    if (n < 12352) return PW + S_DT + (n - 12320);
    return P_GATES + (n - 12352);
}
__device__ __forceinline__ void transpose_item(const float* __restrict__ W, int N, bf16_t* __restrict__ WT, int KP, int koff, int mode, LAS float* scr, int kb, int nb, int lane) {
    const int k0 = 64 * kb, n0 = 32 * nb;
#pragma unroll 8
    for (int i = 0; i < 32; ++i) { const int kk = 2 * i + (lane >> 5); scr[kk * 33 + (lane & 31)] = W[(size_t)(k0 + kk) * N + n0 + (lane & 31)]; }
    LDS_WAIT(); asm volatile("" ::: "memory");
    const int c = lane & 7;
#pragma unroll
    for (int j = 0; j < 4; ++j) { const int n = (lane >> 3) + 8 * j; const LAS float* s = scr + (8 * c) * 33 + n;
        u32x4 o; o.x = pk2(s[0 * 33], s[1 * 33]); o.y = pk2(s[2 * 33], s[3 * 33]); o.z = pk2(s[4 * 33], s[5 * 33]); o.w = pk2(s[6 * 33], s[7 * 33]);
        *(u32x4*)(WT + (size_t)map_row(mode, n0 + n) * KP + koff + k0 + 8 * c) = o; }
    LDS_WAIT(); asm volatile("" ::: "memory");
}
struct CvtJob { const float* W; bf16_t* WT; int K, N, KP, koff, mode; };
__device__ __forceinline__ CvtJob cvt_job(const Args& a, int l, int j) {
    unsigned char* lw = a.ws + WS_W + (size_t)l * LW_SIZE;
    CvtJob r;
    switch (j) {
    case 0: r = CvtJob{a.in[14] + (size_t)l * D * FF, (bf16_t*)(lw + LW_GU1), D, FF, D, 0, 1}; break;
    case 1: r = CvtJob{a.in[15] + (size_t)l * D * FF, (bf16_t*)(lw + LW_GU1), D, FF, D, 0, 2}; break;
    case 2: r = CvtJob{a.in[16] + (size_t)l * FF * D, (bf16_t*)(lw + LW_D1), FF, D, FF, 0, 0}; break;
    case 3: r = CvtJob{a.in[17] + (size_t)l * D * FF, (bf16_t*)(lw + LW_GU2), D, FF, D, 0, 1}; break;
    case 4: r = CvtJob{a.in[18] + (size_t)l * D * FF, (bf16_t*)(lw + LW_GU2), D, FF, D, 0, 2}; break;
    case 5: r = CvtJob{a.in[19] + (size_t)l * FF * D, (bf16_t*)(lw + LW_D2), FF, D, FF, 0, 0}; break;
    case 6: r = CvtJob{a.in[20] + (size_t)l * D * NIN, (bf16_t*)(lw + LW_IN), D, NIN, D, 0, 3}; break;
    case 7: r = CvtJob{a.in[34] + (size_t)l * 1024 * D, (bf16_t*)(lw + LW_BR), 1024, D, 4096, 0, 0}; break;
    case 8: r = CvtJob{a.in[35] + (size_t)l * 1024 * D, (bf16_t*)(lw + LW_BR), 1024, D, 4096, 1024, 0}; break;
    case 9: r = CvtJob{a.in[36] + (size_t)l * 2048 * D, (bf16_t*)(lw + LW_BR), 2048, D, 4096, 2048, 0}; break;
    default: r = CvtJob{a.in[37] + (size_t)l * D * D, (bf16_t*)(lw + LW_OUT), D, D, D, 0, 0}; break;
    }
    return r;
}
__device__ __forceinline__ void p0_convert(const Args& a, LAS unsigned char* lds, int vcu, int G) {
    const int tid = ltid(), lane = tid & 63, wave = __builtin_amdgcn_readfirstlane(tid >> 6);
    LAS float* scr = (LAS float*)(lds + wave * 16384);
    const int gw = vcu * NWAVES + wave, NGW = G * NWAVES;
    for (int l = 0; l < 2; ++l)
        for (int j = 0; j < 11; ++j) {
            const CvtJob jb = cvt_job(a, l, j);
            const int nblk = jb.N / 32, nit = (jb.K / 64) * nblk;
            for (int it = gw; it < nit; it += NGW) transpose_item(jb.W, jb.N, jb.WT, jb.KP, jb.koff, jb.mode, scr, it / nblk, it % nblk, lane);
        }
    for (int l = 0; l < 2; ++l) {
        u32x4* p = (u32x4*)(a.ws + WS_W + (size_t)l * LW_SIZE + LW_IN + (size_t)NIN * D * 2);
        const int n16 = (NINP - NIN) * D * 2 / 16;
        for (int i = (vcu * NTHR + tid); i < n16; i += G * NTHR) p[i] = (u32x4){0u, 0u, 0u, 0u};
    }
    {
        const float* cp = a.in[7]; const float* cs = a.in[8]; unsigned* sc = (unsigned*)(a.ws + WS_SC);
        for (int i = vcu * NTHR + tid; i < 144 * D / 2; i += G * NTHR) {
            const int r = i / (D / 2), c2 = (i % (D / 2)) * 2; float v0 = 0.f, v1 = 0.f;
            if (r < NCR) { const float* src = r < NB ? cp + (size_t)r * D : cs + (size_t)(r - NB) * D; v0 = siluf_(src[c2]); v1 = siluf_(src[c2 + 1]); }
            sc[i] = pk2(v0, v1);
        }
    }
}

__device__ __forceinline__ void p1_mod(const Args& a, LAS unsigned char* lds, int vcu, int G) {
    const int tid = ltid(), lane = tid & 63, wave = __builtin_amdgcn_readfirstlane(tid >> 6), c16 = lane & 15, kq = lane >> 4;
    constexpr int BP = 1040, BSZ = 32 * BP, ASZ = 144 * 64, SLOT = BSZ + ASZ;
    const bf16_t* SC = (const bf16_t*)(a.ws + WS_SC);
    const int nunits = 2 * (NMOD / 256);
    for (int u = vcu; u < nunits; u += G) {
        const int l = u / (NMOD / 256), n0 = (u % (NMOD / 256)) * 256;
        const float* W = a.in[9] + (size_t)l * D * NMOD + n0;
        auto issue = [&](int ks) {
            LAS unsigned char* S = lds + (ks % 3) * SLOT;
            const float* wrow = W + (size_t)(ks * 32 + 4 * wave) * NMOD + 4 * lane;
#pragma unroll
            for (int i = 0; i < 4; ++i) __builtin_amdgcn_global_load_lds((const unsigned*)(wrow + (size_t)i * NMOD), (LAS unsigned*)(S + (4 * wave + i) * BP), 16, 0, 0);
            __builtin_amdgcn_global_load_lds((const unsigned*)(SC + (size_t)(16 * wave + (lane >> 2)) * D + ks * 32 + 8 * (lane & 3)), (LAS unsigned*)(S + BSZ + wave * 1024), 16, 0, 0);
            if (wave == 0) __builtin_amdgcn_global_load_lds((const unsigned*)(SC + (size_t)(128 + (lane >> 2)) * D + ks * 32 + 8 * (lane & 3)), (LAS unsigned*)(S + BSZ + 8 * 1024), 16, 0, 0);
        };
        f32x4 acc[9][2];
#pragma unroll
        for (int t = 0; t < 9; ++t) { acc[t][0] = (f32x4){0.f, 0.f, 0.f, 0.f}; acc[t][1] = (f32x4){0.f, 0.f, 0.f, 0.f}; }
        __syncthreads();
        issue(0); issue(1);
#pragma unroll 1
        for (int ks = 0; ks < 64; ++ks) {
            if (ks + 1 < 64) { if (wave == 0) asm volatile("s_waitcnt vmcnt(6)" ::: "memory"); else asm volatile("s_waitcnt vmcnt(5)" ::: "memory"); }
            else asm volatile("s_waitcnt vmcnt(0)" ::: "memory");
            __builtin_amdgcn_s_barrier(); asm volatile("" ::: "memory");
            if (ks + 2 < 64) issue(ks + 2);
            const LAS unsigned char* S = lds + (ks % 3) * SLOT;
            bf16x8 bfr[2];
#pragma unroll
            for (int g = 0; g < 2; ++g) {
                const LAS float* bp = (const LAS float*)(S + (8 * kq) * BP) + 32 * wave + 16 * g + c16;
                float w[8];
#pragma unroll
                for (int j = 0; j < 8; ++j) w[j] = bp[j * (BP / 4)];
                u32x4 p; p.x = pk2(w[0], w[1]); p.y = pk2(w[2], w[3]); p.z = pk2(w[4], w[5]); p.w = pk2(w[6], w[7]);
                bfr[g] = __builtin_bit_cast(bf16x8, p);
            }
#pragma unroll
            for (int t = 0; t < 9; ++t) {
                const bf16x8 af = *(const LAS bf16x8*)(S + BSZ + (16 * t + c16) * 64 + kq * 16);
                acc[t][0] = __builtin_amdgcn_mfma_f32_16x16x32_bf16(af, bfr[0], acc[t][0], 0, 0, 0);
                acc[t][1] = __builtin_amdgcn_mfma_f32_16x16x32_bf16(af, bfr[1], acc[t][1], 0, 0, 0);
            }
        }
        const float* bias = a.in[10] + (size_t)l * NMOD + n0 + 32 * wave;
        float* mod = (float*)(a.ws + WS_MOD) + (size_t)l * NCR * NMOD + n0 + 32 * wave;
        const float b0 = bias[c16], b1 = bias[16 + c16];
#pragma unroll
        for (int t = 0; t < 9; ++t)
#pragma unroll
            for (int j = 0; j < 4; ++j) { const int r = 16 * t + 4 * kq + j;
                if (r < NCR) { mod[(size_t)r * NMOD + c16] = acc[t][0][j] + b0; mod[(size_t)r * NMOD + 16 + c16] = acc[t][1][j] + b1; } }
    }
    __syncthreads();
}

__device__ __forceinline__ int cond_row(int m) { return m < NPT ? (m >> 11) : NB + (m - NPT); }
__device__ __forceinline__ void norm_mod_phase(const Args& a, int vcu, int G, int layer, int which  , bool first) {
    const int tid = ltid(), lane = tid & 63, wave = __builtin_amdgcn_readfirstlane(tid >> 6);
    const int gw = vcu * NWAVES + wave, NGW = G * NWAVES;
    float* X = (float*)(a.ws + WS_X); bf16_t* H = (bf16_t*)(a.ws + WS_H);
    const float* nw = a.in[11 + which] + (size_t)layer * D;
    const float* modl = (const float*)(a.ws + WS_MOD) + (size_t)layer * NCR * NMOD;
    for (int m = gw; m < MP; m += NGW) {
        u32x4* hrow = (u32x4*)(H + (size_t)m * D);
        if (m >= MT) {
#pragma unroll
            for (int j = 0; j < 4; ++j) hrow[64 * j + lane] = (u32x4){0u, 0u, 0u, 0u};
            continue;
        }
        const float* xr = first ? (m < NPT ? a.in[0] + (size_t)m * D : a.in[1] + (size_t)(m - NPT) * D) : X + (size_t)m * D;
        f32x4 v[8]; float s = 0.f;
#pragma unroll
        for (int j = 0; j < 4; ++j) {
            v[2 * j] = *(const f32x4*)(xr + 512 * j + 8 * lane); v[2 * j + 1] = *(const f32x4*)(xr + 512 * j + 8 * lane + 4);
            s += (v[2 * j].x * v[2 * j].x + v[2 * j].y * v[2 * j].y) + (v[2 * j].z * v[2 * j].z + v[2 * j].w * v[2 * j].w);
            s += (v[2 * j + 1].x * v[2 * j + 1].x + v[2 * j + 1].y * v[2 * j + 1].y) + (v[2 * j + 1].z * v[2 * j + 1].z + v[2 * j + 1].w * v[2 * j + 1].w);
        }
        if (first) {
            float* xo = X + (size_t)m * D;
#pragma unroll
            for (int j = 0; j < 4; ++j) { *(f32x4*)(xo + 512 * j + 8 * lane) = v[2 * j]; *(f32x4*)(xo + 512 * j + 8 * lane + 4) = v[2 * j + 1]; }
        }
        const float rstd = 1.0f / sqrtf(wave_sum(s) * (1.f / D) + EPS);
        const float* mr = modl + (size_t)cond_row(m) * NMOD + (size_t)(3 * which) * D;
#pragma unroll
        for (int j = 0; j < 4; ++j) {
            const int c = 512 * j + 8 * lane;
            const f32x4 w0 = *(const f32x4*)(nw + c), w1 = *(const f32x4*)(nw + c + 4);
            const f32x4 sh0 = *(const f32x4*)(mr + c), sh1 = *(const f32x4*)(mr + c + 4);
            const f32x4 sc0 = *(const f32x4*)(mr + D + c), sc1 = *(const f32x4*)(mr + D + c + 4);
            const f32x4 y0 = v[2 * j] * rstd * w0 * (sc0 + 1.0f) + sh0, y1 = v[2 * j + 1] * rstd * w1 * (sc1 + 1.0f) + sh1;
            u32x4 o; o.x = pk2(y0.x, y0.y); o.y = pk2(y0.z, y0.w); o.z = pk2(y1.x, y1.y); o.w = pk2(y1.z, y1.w);
            hrow[64 * j + lane] = o;
        }
    }
}
__device__ __forceinline__ void final_norm_phase(const Args& a, int vcu, int G) {
    const int tid = ltid(), lane = tid & 63, wave = __builtin_amdgcn_readfirstlane(tid >> 6);
    const int gw = vcu * NWAVES + wave, NGW = G * NWAVES;
    const float* X = (const float*)(a.ws + WS_X); const float* nw = a.in[38];
    for (int m = gw; m < MT; m += NGW) {
        const float* xr = X + (size_t)m * D; float* yo = a.out + (size_t)m * D;
        f32x4 v[8]; float s = 0.f;
#pragma unroll
        for (int j = 0; j < 8; ++j) { v[j] = *(const f32x4*)(xr + 256 * j + 4 * lane); s += (v[j].x * v[j].x + v[j].y * v[j].y) + (v[j].z * v[j].z + v[j].w * v[j].w); }
        const float rstd = 1.0f / sqrtf(wave_sum(s) * (1.f / D) + EPS);
#pragma unroll
        for (int j = 0; j < 8; ++j) { const f32x4 w = *(const f32x4*)(nw + 256 * j + 4 * lane); *(f32x4*)(yo + 256 * j + 4 * lane) = v[j] * rstd * w; }
    }
}

using pg8::Unit;
struct EpiSwiglu {
    static constexpr bool PERM = true;
    bf16_t* ACT;
    __device__ __forceinline__ void operator()(const f32x4 (&acc)[2][2][4][2], const Unit& u, int wr, int wc, int fr, int fq) const {
        const int row0 = u.pm * 256 + wr * 64 + fr, f0 = u.pn * 128 + wc * 32 + 8 * fq;
#pragma unroll
        for (int ai = 0; ai < 2; ++ai)
#pragma unroll
            for (int m = 0; m < 4; ++m) {
                const f32x4 g0 = acc[ai][0][m][0], g1 = acc[ai][0][m][1], u0 = acc[ai][1][m][0], u1 = acc[ai][1][m][1];
                float o[8];
#pragma unroll
                for (int j = 0; j < 4; ++j) { o[j] = siluf_(g0[j]) * u0[j]; o[4 + j] = siluf_(g1[j]) * u1[j]; }
                u32x4 w; w.x = pg8::cvt_pk_bf16(o[0], o[1]); w.y = pg8::cvt_pk_bf16(o[2], o[3]); w.z = pg8::cvt_pk_bf16(o[4], o[5]); w.w = pg8::cvt_pk_bf16(o[6], o[7]);
                *(u32x4*)(ACT + (size_t)(row0 + ai * 128 + m * 16) * FF + f0) = w;
            }
    }
};
struct EpiResid {
    static constexpr bool PERM = false;
    float* X; const float* gate; float scale;
    __device__ __forceinline__ void operator()(const f32x4 (&acc)[2][2][4][2], const Unit& u, int wr, int wc, int fr, int fq) const {
        const int row0 = u.pm * 256 + wr * 64 + fr, col0 = u.pn * 256 + wc * 32 + 4 * fq;
        if (u.seg == 0) {
            const float* gr = gate + (size_t)(u.pm >> 3) * NMOD + col0;
            f32x4 gv[2][2];
#pragma unroll
            for (int bj = 0; bj < 2; ++bj)
#pragma unroll
                for (int n = 0; n < 2; ++n) gv[bj][n] = *(const f32x4*)(gr + bj * 128 + n * 16) * scale;
#pragma unroll
            for (int ai = 0; ai < 2; ++ai)
#pragma unroll
                for (int m = 0; m < 4; ++m) { float* rowp = X + (size_t)(row0 + ai * 128 + m * 16) * D + col0;
#pragma unroll
                    for (int bj = 0; bj < 2; ++bj)
#pragma unroll
                        for (int n = 0; n < 2; ++n) { f32x4* p = (f32x4*)(rowp + bj * 128 + n * 16); *p = *p + gv[bj][n] * acc[ai][bj][m][n]; } }
        } else {
#pragma unroll
            for (int m = 0; m < 4; ++m) { const int r = row0 + m * 16;
                const float* gr = gate + (size_t)(NB + (r - NPT)) * NMOD + col0; float* rowp = X + (size_t)r * D + col0;
#pragma unroll
                for (int bj = 0; bj < 2; ++bj)
#pragma unroll
                    for (int n = 0; n < 2; ++n) { const f32x4 v = *(const f32x4*)(gr + bj * 128 + n * 16) * scale * acc[0][bj][m][n]; float* p = rowp + bj * 128 + n * 16;
#pragma unroll
                        for (int j = 0; j < 4; ++j) __hip_atomic_fetch_add(p + j, v[j], __ATOMIC_RELAXED, __HIP_MEMORY_SCOPE_AGENT); } }
        }
    }
};
struct EpiWin {
    static constexpr bool PERM = true;
    bf16_t* PROJ; float* SMALL;
    __device__ __forceinline__ void operator()(const f32x4 (&acc)[2][2][4][2], const Unit& u, int wr, int wc, int fr, int fq) const {
        const int row0 = u.pm * 256 + wr * 64 + fr;
        if (u.pn < PW / 256) {
            const int col0 = u.pn * 256 + wc * 32 + 8 * fq;
#pragma unroll
            for (int ai = 0; ai < 2; ++ai)
#pragma unroll
                for (int m = 0; m < 4; ++m) { bf16_t* rowp = PROJ + (size_t)(row0 + ai * 128 + m * 16) * PW + col0;
#pragma unroll
                    for (int bj = 0; bj < 2; ++bj) { const f32x4 v0 = acc[ai][bj][m][0], v1 = acc[ai][bj][m][1];
                        u32x4 w; w.x = pg8::cvt_pk_bf16(v0[0], v0[1]); w.y = pg8::cvt_pk_bf16(v0[2], v0[3]); w.z = pg8::cvt_pk_bf16(v1[0], v1[1]); w.w = pg8::cvt_pk_bf16(v1[2], v1[3]);
                        *(u32x4*)(rowp + bj * 128) = w; } }
        } else if (wc < 2) {
            const int col0 = wc * 32 + 8 * fq;
#pragma unroll
            for (int ai = 0; ai < 2; ++ai)
#pragma unroll
                for (int m = 0; m < 4; ++m) { float* rowp = SMALL + (size_t)(row0 + ai * 128 + m * 16) * SW + col0;
                    *(f32x4*)(rowp) = acc[ai][0][m][0]; *(f32x4*)(rowp + 4) = acc[ai][0][m][1]; }
        }
    }
};
struct EpiBranch {
    static constexpr bool PERM = false;
    float* MRG; bf16_t* MRGB; const bf16_t* PROJ;
    __device__ __forceinline__ void operator()(const f32x4 (&acc)[2][2][4][2], const Unit& u, int wr, int wc, int fr, int fq) const {
        const int row0 = u.pm * 256 + wr * 64 + fr, col0 = u.pn * 256 + wc * 32 + 4 * fq;
#pragma unroll
        for (int ai = 0; ai < 2; ++ai)
#pragma unroll
            for (int m = 0; m < 4; ++m) { const size_t r = (size_t)(row0 + ai * 128 + m * 16);
#pragma unroll
                for (int bj = 0; bj < 2; ++bj)
#pragma unroll
                    for (int n = 0; n < 2; ++n) { const int c = col0 + bj * 128 + n * 16;
                        const u32x2 gw = *(const u32x2*)(PROJ + r * PW + P_GATES + u.seg * D + c);
                        f32x4 gv; gv.x = sigmoidf_(bflo(gw.x)); gv.y = sigmoidf_(bfhi(gw.x)); gv.z = sigmoidf_(bflo(gw.y)); gv.w = sigmoidf_(bfhi(gw.y));
                        f32x4 v = gv * acc[ai][bj][m][n];
                        f32x4* mp = (f32x4*)(MRG + r * D + c);
                        if (u.seg > 0) v = v + *mp;
                        if (u.seg < 2) *mp = v;
                        else { u32x2 w; w.x = pg8::cvt_pk_bf16(v.x, v.y); w.y = pg8::cvt_pk_bf16(v.z, v.w); *(u32x2*)(MRGB + r * D + c) = w; } }
                asm volatile("" ::: "memory"); }
    }
};

__device__ __forceinline__ void skinny_gemm(const Args& a, LAS unsigned char* lds, int vcu, int G, const bf16_t* A, int lda, const bf16_t* Bt, int ldb, int nseg, int klen0, int klen1, int klen2,
                                            int mode, float* X, const float* gate, float scale, bf16_t* MRGB, const bf16_t* PROJ) {
    const int tid = ltid(), lane = tid & 63, wave = __builtin_amdgcn_readfirstlane(tid >> 6), c16 = lane & 15, kq = lane >> 4;
    LAS float* red = (LAS float*)lds;
    for (int w = vcu; w < 256; w += G) {
        const int n0 = 16 * (w >> 1), r0 = NPT + 64 * (w & 1);
        float gsum[4] = {0.f, 0.f, 0.f, 0.f};
        int kbase = 0;
        for (int sg = 0; sg < nseg; ++sg) {
            const int klen = sg == 0 ? klen0 : (sg == 1 ? klen1 : klen2);
            f32x4 acc[4];
#pragma unroll
            for (int t = 0; t < 4; ++t) acc[t] = (f32x4){0.f, 0.f, 0.f, 0.f};
            const int nks = klen / 32;
            const bf16_t* bp = Bt + (size_t)(n0 + c16) * ldb + kbase + 8 * kq;
            const bf16_t* ap = A + (size_t)(r0 + c16) * lda + kbase + 8 * kq;
#pragma unroll 1
            for (int ks = wave; ks < nks; ks += 4 * NWAVES) {
                bf16x8 bq[4], aq[4][4];
#pragma unroll
                for (int q = 0; q < 4; ++q) {
                    const int kk = ks + q * NWAVES, k0 = (kk < nks ? kk : 0) * 32;
                    bq[q] = *(const bf16x8*)(bp + k0);
#pragma unroll
                    for (int t = 0; t < 4; ++t) aq[q][t] = *(const bf16x8*)(ap + (size_t)(16 * t) * lda + k0);
                }
#pragma unroll
                for (int q = 0; q < 4; ++q) {
                    if (ks + q * NWAVES < nks) {
#pragma unroll
                        for (int t = 0; t < 4; ++t) acc[t] = __builtin_amdgcn_mfma_f32_16x16x32_bf16(bq[q], aq[q][t], acc[t], 0, 0, 0);
                    }
                }
            }
#pragma unroll
            for (int t = 0; t < 4; ++t) *(LAS f32x4*)(red + ((wave * 64 + 16 * t + c16) * 16 + 4 * kq)) = acc[t];
            __syncthreads();
            if (tid < 256) {
                const int r = tid >> 2, c4 = (tid & 3) * 4;
                f32x4 s = (f32x4){0.f, 0.f, 0.f, 0.f};
#pragma unroll
                for (int wv = 0; wv < 8; ++wv) s = s + *(const LAS f32x4*)(red + ((wv * 64 + r) * 16 + c4));
                if (mode == 1) {
                    const u32x2 gw = *(const u32x2*)(PROJ + (size_t)(r0 + r) * PW + P_GATES + sg * D + n0 + c4);
                    gsum[0] += sigmoidf_(bflo(gw.x)) * s.x; gsum[1] += sigmoidf_(bfhi(gw.x)) * s.y; gsum[2] += sigmoidf_(bflo(gw.y)) * s.z; gsum[3] += sigmoidf_(bfhi(gw.y)) * s.w;
                } else { gsum[0] += s.x; gsum[1] += s.y; gsum[2] += s.z; gsum[3] += s.w; }
            }
            __syncthreads();
            kbase += klen;
        }
        if (tid < 256) {
            const int r = r0 + (tid >> 2), c = n0 + (tid & 3) * 4;
            if (mode == 0) {
                const f32x4 gv = *(const f32x4*)(gate + (size_t)cond_row(r) * NMOD + c) * scale;
                f32x4* p = (f32x4*)(X + (size_t)r * D + c);
                *p = *p + gv * (f32x4){gsum[0], gsum[1], gsum[2], gsum[3]};
            } else {
                u32x2 o; o.x = pk2(gsum[0], gsum[1]); o.y = pk2(gsum[2], gsum[3]); *(u32x2*)(MRGB + (size_t)r * D + c) = o;
            }
        }
    }
}

constexpr size_t WS_GQKV = WS_MIX;
constexpr size_t WS_GB = WS_GQKV + al((size_t)MP * 3072 * 2);
constexpr size_t WS_LA = WS_GB + al((size_t)MP * 16 * 4);
constexpr size_t WS_XBC = WS_LA + al((size_t)MP * 512 * 4);
constexpr size_t WS_DT = WS_XBC + al((size_t)MP * 3072 * 2);
constexpr int NGU = NB * NCHUNK * 8, NLU = NB * NCHUNK * 4, NSU = NB * NCHUNK * 32, NSG = NB * NCHUNK * 4;
constexpr size_t WS_G_WK = WS_DT + al((size_t)MP * 32 * 4);
constexpr size_t WS_G_QD = WS_G_WK + al((size_t)NGU * 8192 * 2);
constexpr size_t WS_G_KDT = WS_G_QD + al((size_t)NGU * 8192 * 2);
constexpr size_t WS_G_QKD = WS_G_KDT + al((size_t)NGU * 8192 * 2);
constexpr size_t WS_G_UT = WS_G_QKD + al((size_t)NGU * 4096 * 2);
constexpr size_t WS_G_EGL = WS_G_UT + al((size_t)NGU * 8192 * 4);
constexpr size_t WS_L_QB = WS_G_EGL + al((size_t)NGU * 4);
constexpr size_t WS_L_ATT = WS_L_QB + al((size_t)NLU * 8192 * 2);
constexpr size_t WS_L_KDT = WS_L_ATT + al((size_t)NLU * 4096 * 2);
constexpr size_t WS_L_VT = WS_L_KDT + al((size_t)NLU * 8192 * 2);
constexpr size_t WS_L_EBL = WS_L_VT + al((size_t)NLU * 16384 * 2);
constexpr size_t WS_S_MH = WS_L_EBL + al((size_t)NLU * 128 * 4);
constexpr size_t WS_S_XDTT = WS_S_MH + al((size_t)NSU * 4096 * 2);
constexpr size_t WS_S_XDT2T = WS_S_XDTT + al((size_t)NSU * 4096 * 2);
constexpr size_t WS_S_EA = WS_S_XDT2T + al((size_t)NSU * 4096 * 2);
constexpr size_t WS_S_EAL = WS_S_EA + al((size_t)NSU * 64 * 4);
constexpr size_t WS_S_BT = WS_S_EAL + al((size_t)NSU * 4);
constexpr size_t WS_OA = WS_S_BT + al((size_t)NSG * 8192 * 2);
constexpr size_t WS_OB = WS_OA + al((size_t)MP * 1024 * 2);
constexpr size_t WS_YC = WS_OB + al((size_t)MP * 1024 * 2);
constexpr size_t WS_END = WS_YC + al((size_t)MP * 2048 * 2);

constexpr size_t O_YP = 0, O_YS = O_YP + (size_t)NPT * D, O_PGC = O_YS + (size_t)NS * D, O_PG = O_PGC + (size_t)2 * NB * 3 * 3072, O_PL = O_PG + (size_t)2 * NB * 8 * 16384,
                 O_PSC = O_PL + (size_t)2 * NB * 4 * 32768, O_PS = O_PSC + (size_t)2 * NB * 3 * 3072, O_SGC = O_PS + (size_t)2 * NB * 32 * 8192, O_SG = O_SGC + (size_t)2 * NS * 3 * 3072,
                 O_SL = O_SG + (size_t)2 * NS * 8 * 16384, O_SSC = O_SL + (size_t)2 * NS * 4 * 32768, O_SS = O_SSC + (size_t)2 * NS * 3 * 3072, O_END = O_SS + (size_t)2 * NS * 32 * 8192;

__device__ __forceinline__ void unpack8(const u32x4 w, float (&f)[8]) { f[0] = bflo(w.x); f[1] = bfhi(w.x); f[2] = bflo(w.y); f[3] = bfhi(w.y); f[4] = bflo(w.z); f[5] = bfhi(w.z); f[6] = bflo(w.w); f[7] = bfhi(w.w); }
__device__ __forceinline__ u32x4 pack8(const float (&f)[8]) { u32x4 w; w.x = pk2(f[0], f[1]); w.y = pk2(f[2], f[3]); w.z = pk2(f[4], f[5]); w.w = pk2(f[6], f[7]); return w; }

__device__ __forceinline__ void store8f(float* p, const float (&f)[8]) { *(f32x4*)p = (f32x4){f[0], f[1], f[2], f[3]}; *(f32x4*)(p + 4) = (f32x4){f[4], f[5], f[6], f[7]}; }
__device__ __forceinline__ void load8f(const float* p, float (&f)[8]) { const f32x4 a = *(const f32x4*)p, b = *(const f32x4*)(p + 4); f[0] = a.x; f[1] = a.y; f[2] = a.z; f[3] = a.w; f[4] = b.x; f[5] = b.y; f[6] = b.z; f[7] = b.w; }
template <int KIND  >
__device__ __forceinline__ u32x4 conv_out(const float (&w)[4][8], const float (&bias)[8], const float (&p3)[8], const float (&p2)[8], const float (&p1)[8], const float (&raw)[8]) {
    float y[8]; float ss = 0.f;
#pragma unroll
    for (int i = 0; i < 8; ++i) { float v = p3[i] * w[0][i] + p2[i] * w[1][i] + p1[i] * w[2][i] + raw[i] * w[3][i]; if (KIND == 3) v += bias[i]; v = siluf_(v); y[i] = v; ss += v * v; }
    if (KIND < 2) {
        ss += __shfl_xor(ss, 1); ss += __shfl_xor(ss, 2); ss += __shfl_xor(ss, 4); ss += __shfl_xor(ss, 8);
        const float r = (1.0f / sqrtf(ss + EPS)) * (KIND == 0 ? 0.08838834764831845f : 1.0f);
#pragma unroll
        for (int i = 0; i < 8; ++i) y[i] *= r;
    }
    return pack8(y);
}
constexpr int M1_T = 32;
template <int KIND>
__device__ __forceinline__ void m1_strip(const Args& a, int layer, int slab  , int strip, int lane) {
    constexpr bool SSD = (KIND == 3);
    const bf16_t* PROJ = (const bf16_t*)(a.ws + WS_PROJ) + (SSD ? P_XBC : P_QKVA);
    bf16_t* OUT = (bf16_t*)(a.ws + (SSD ? WS_XBC : WS_GQKV));
    const float* cw = (SSD ? a.in[28] : a.in[21]) + (size_t)layer * 4 * 3072;
    const int ch = slab * 512 + lane * 8;
    float w[4][8], bias[8];
#pragma unroll
    for (int j = 0; j < 4; ++j) load8f(cw + j * 3072 + ch, w[j]);
    if (SSD) load8f(a.in[29] + (size_t)layer * 3072 + ch, bias); else { for (int i = 0; i < 8; ++i) bias[i] = 0.f; }
    const int m0 = strip * M1_T, t0 = m0 & (SEQ - 1), b = m0 >> 11;
    float p1[8], p2[8], p3[8], raw[8];
    if (t0 == 0) { for (int i = 0; i < 8; ++i) { p1[i] = 0.f; p2[i] = 0.f; p3[i] = 0.f; } }
    else { unpack8(*(const u32x4*)(PROJ + (size_t)(m0 - 1) * PW + ch), p1); unpack8(*(const u32x4*)(PROJ + (size_t)(m0 - 2) * PW + ch), p2); unpack8(*(const u32x4*)(PROJ + (size_t)(m0 - 3) * PW + ch), p3); }
    float* cso = a.out + (SSD ? O_PSC : O_PGC) + ((size_t)layer * NB + b) * 3 * 3072 + ch;
    u32x4 rw[8], rn[8];
#pragma unroll
    for (int j = 0; j < 8; ++j) rw[j] = *(const u32x4*)(PROJ + (size_t)(m0 + j) * PW + ch);
#pragma unroll
    for (int tg = 0; tg < M1_T; tg += 8) {
        if (tg + 8 < M1_T) {
#pragma unroll
            for (int j = 0; j < 8; ++j) rn[j] = *(const u32x4*)(PROJ + (size_t)(m0 + tg + 8 + j) * PW + ch);
        }
#pragma unroll
        for (int j = 0; j < 8; ++j) {
            const int t = tg + j, m = m0 + t;
            unpack8(rw[j], raw);
            *(u32x4*)(OUT + (size_t)m * 3072 + ch) = conv_out<KIND>(w, bias, p3, p2, p1, raw);
            if (t0 + t >= SEQ - 3) store8f(cso + (size_t)(t0 + t - (SEQ - 3)) * 3072, raw);
#pragma unroll
            for (int i = 0; i < 8; ++i) { p3[i] = p2[i]; p2[i] = p1[i]; p1[i] = raw[i]; }
        }
#pragma unroll
        for (int j = 0; j < 8; ++j) rw[j] = rn[j];
    }
}
template <int KIND>
__device__ __forceinline__ void m1_samp(const Args& a, int layer, int slab, int grp, int lane) {
    constexpr bool SSD = (KIND == 3);
    const bf16_t* PROJ = (const bf16_t*)(a.ws + WS_PROJ) + (SSD ? P_XBC : P_QKVA);
    bf16_t* OUT = (bf16_t*)(a.ws + (SSD ? WS_XBC : WS_GQKV));
    const float* cw = (SSD ? a.in[28] : a.in[21]) + (size_t)layer * 4 * 3072;
    const int ch = slab * 512 + lane * 8;
    float w[4][8], bias[8];
#pragma unroll
    for (int j = 0; j < 4; ++j) load8f(cw + j * 3072 + ch, w[j]);
    if (SSD) load8f(a.in[29] + (size_t)layer * 3072 + ch, bias); else { for (int i = 0; i < 8; ++i) bias[i] = 0.f; }
#pragma unroll 1
    for (int q0 = 0; q0 < 16; q0 += 2) {
        float p1[2][8], p2[2][8], p3[2][8]; u32x4 rw[2];
#pragma unroll
        for (int q = 0; q < 2; ++q) {
            const int s = grp * 16 + q0 + q;
            const float* st = (SSD ? a.in[5] : a.in[2]) + ((size_t)layer * NS + s) * 3 * 3072 + ch;
            load8f(st, p3[q]); load8f(st + 3072, p2[q]); load8f(st + 6144, p1[q]);
            rw[q] = *(const u32x4*)(PROJ + (size_t)(NPT + s) * PW + ch);
        }
#pragma unroll
        for (int q = 0; q < 2; ++q) {
            const int s = grp * 16 + q0 + q, m = NPT + s;
            float* so = a.out + (SSD ? O_SSC : O_SGC) + ((size_t)layer * NS + s) * 3 * 3072 + ch;
            float raw[8]; unpack8(rw[q], raw);
            *(u32x4*)(OUT + (size_t)m * 3072 + ch) = conv_out<KIND>(w, bias, p3[q], p2[q], p1[q], raw);
            store8f(so, p2[q]); store8f(so + 3072, p1[q]); store8f(so + 6144, raw);
        }
    }
}
__device__ __forceinline__ void m1_phase(const Args& a, int vcu, int G, int layer) {
    const int tid = ltid(), lane = tid & 63, wave = __builtin_amdgcn_readfirstlane(tid >> 6);
    const int gw = vcu * NWAVES + wave, NGW = G * NWAVES;
    constexpr int NSTRIP = NPT / M1_T, NT_P = 12 * NSTRIP, NT_S = 12 * (NS / 16);
#pragma unroll 1
    for (int task = gw; task < NT_P + NT_S; task += NGW) {
        const bool samp = task >= NT_P; const int tk = samp ? task - NT_P : task;
        const int slab12 = tk % 12, idx = tk / 12, slab = slab12 % 6;
#ifndef M1_NO_STRIP
        if (!samp) {
            if (slab12 >= 6) m1_strip<3>(a, layer, slab, idx, lane);
            else if (slab < 2) m1_strip<0>(a, layer, slab, idx, lane);
            else if (slab < 4) m1_strip<1>(a, layer, slab, idx, lane);
            else m1_strip<2>(a, layer, slab, idx, lane);
        }
#endif
#ifndef M1_NO_SAMP
        if (samp) {
            if (slab12 >= 6) m1_samp<3>(a, layer, slab, idx, lane);
            else if (slab < 2) m1_samp<0>(a, layer, slab, idx, lane);
            else if (slab < 4) m1_samp<1>(a, layer, slab, idx, lane);
            else m1_samp<2>(a, layer, slab, idx, lane);
        }
#endif
    }
#ifndef M1_NO_SCALAR
    const float* SMALL = (const float*)(a.ws + WS_SMALL); float* GB = (float*)(a.ws + WS_GB); float* LA = (float*)(a.ws + WS_LA); float* DT = (float*)(a.ws + WS_DT);
    const float* Wg = a.in[25] + (size_t)layer * 16 * 512; const float* bg = a.in[26] + (size_t)layer * 512;
#pragma unroll 1
    for (int task = gw; task < MT / 2; task += NGW) {
        float bgv[8];
        load8f(bg + lane * 8, bgv);
        const float alog = lane < 8 ? -__expf(a.in[22][layer * 8 + lane]) : 0.f, dtb = lane < 8 ? a.in[23][layer * 8 + lane] : 0.f, sdb = lane < 32 ? a.in[31][layer * 32 + lane] : 0.f;
        f32x4 lrv[2][4]; float sb[2], sd[2], sdt[2];
#pragma unroll
        for (int q = 0; q < 2; ++q) {
            const float* sm = SMALL + (size_t)(task * 2 + q) * SW;
#pragma unroll
            for (int i = 0; i < 4; ++i) lrv[q][i] = *(const f32x4*)(sm + S_LR + 4 * i);
            sb[q] = sm[S_BETA + (lane & 7)]; sd[q] = sm[S_DEC + (lane & 7)]; sdt[q] = sm[S_DT + (lane & 31)];
        }
        float acc[2][8];
#pragma unroll
        for (int q = 0; q < 2; ++q)
#pragma unroll
            for (int i = 0; i < 8; ++i) acc[q][i] = bgv[i];
#pragma unroll
        for (int r4 = 0; r4 < 4; ++r4) {
            float wg[4][8];
#pragma unroll
            for (int rr = 0; rr < 4; ++rr) load8f(Wg + (4 * r4 + rr) * 512 + lane * 8, wg[rr]);
#pragma unroll
            for (int rr = 0; rr < 4; ++rr)
#pragma unroll
                for (int q = 0; q < 2; ++q) { const float lr = lrv[q][r4][rr];
#pragma unroll
                    for (int i = 0; i < 8; ++i) acc[q][i] += lr * wg[rr][i]; }
            asm volatile("" ::: "memory");
        }
#pragma unroll
        for (int q = 0; q < 2; ++q) {
            const int m = task * 2 + q;
            if (lane < 8) { GB[(size_t)m * 16 + lane] = sigmoidf_(sb[q]); GB[(size_t)m * 16 + 8 + lane] = alog * softplusf_(sd[q] + dtb); }
            if (lane < 32) DT[(size_t)m * 32 + lane] = softplusf_(sdt[q] + sdb);
#pragma unroll
            for (int i = 0; i < 8; ++i) acc[q][i] = logsigmoidf_(acc[q][i]) * (1.0f / 16.0f);
            store8f(LA + (size_t)m * 512 + lane * 8, acc[q]);
            asm volatile("" ::: "memory");
        }
    }
#endif
}

__device__ __forceinline__ void tile_g2l(const bf16_t* g, size_t gp, LAS bf16_t* l, int lp, int R, int C, int tid) {
    const int cpr = C / 8, n = R * cpr;
    for (int i = tid; i < n; i += NTHR) { const int r = i / cpr, c = (i % cpr) * 8; *(LAS u32x4*)(l + r * lp + c) = *(const u32x4*)(g + (size_t)r * gp + c); }
}
__device__ __forceinline__ bf16x8 frag(const LAS bf16_t* l, int lp, int r0, int k0, int lane) { return *(const LAS bf16x8*)(l + (r0 + (lane & 15)) * lp + k0 + 8 * (lane >> 4)); }
#define MFMA16(a, b, c) __builtin_amdgcn_mfma_f32_16x16x32_bf16((a), (b), (c), 0, 0, 0)
template <bool TO_LDS, bool TO_GLB>
__device__ __forceinline__ void transpose_scale(const LAS bf16_t* src, int sp, int C, const LAS float* sc, LAS bf16_t* dl, int dp, bf16_t* dg, int tid) {
    const int npass = C / 128;
    const int spair = tid & 31, cg = tid >> 5;
    const float s0 = sc ? sc[2 * spair] : 1.f, s1 = sc ? sc[2 * spair + 1] : 1.f;
    for (int p = 0; p < npass; ++p) {
        const int c0 = p * 128 + cg * 8;
        float a[8], b[8];
        unpack8(*(const LAS u32x4*)(src + (2 * spair) * sp + c0), a); unpack8(*(const LAS u32x4*)(src + (2 * spair + 1) * sp + c0), b);
#pragma unroll
        for (int i = 0; i < 8; ++i) {
            const unsigned w = pk2(a[i] * s0, b[i] * s1);
            if (TO_LDS) *(LAS unsigned*)(dl + (c0 + i) * dp + 2 * spair) = w;
            if (TO_GLB) *(unsigned*)(dg + (size_t)(c0 + i) * 64 + 2 * spair) = w;
        }
    }
}

__device__ __forceinline__ void m2_gdn_unit(const Args& a, LAS unsigned char* lds, int uid) {
    const int tid = ltid(), lane = tid & 63, wave = __builtin_amdgcn_readfirstlane(tid >> 6), c16 = lane & 15, kq = lane >> 4;
    const int h = uid & 7, bc = uid >> 3, m0 = bc * 64;
    LAS bf16_t* Kt = (LAS bf16_t*)(lds);
    LAS bf16_t* Qt = (LAS bf16_t*)(lds + 18432);
    LAS bf16_t* Vt = (LAS bf16_t*)(lds + 36864);
    LAS float* Lm = (LAS float*)(lds + 55296);
    LAS float* Tm = (LAS float*)(lds + 72704);
    LAS bf16_t* VBT = (LAS bf16_t*)(lds + 90112);
    LAS bf16_t* KBT = (LAS bf16_t*)(lds + 110592);
    LAS float* sm = (LAS float*)(lds + 131072);
    LAS float* s_gc = sm, *s_beta = sm + 64, *s_eg = sm + 128, *s_egl = sm + 192, *s_bk = sm + 256;
    LAS bf16_t* Tb = Qt; LAS float* Ys = (LAS float*)Vt;
    const bf16_t* GQKV = (const bf16_t*)(a.ws + WS_GQKV); const float* GB = (const float*)(a.ws + WS_GB);
    bf16_t* G_WK = (bf16_t*)(a.ws + WS_G_WK) + (size_t)uid * 8192; bf16_t* G_QD = (bf16_t*)(a.ws + WS_G_QD) + (size_t)uid * 8192; bf16_t* G_KDT = (bf16_t*)(a.ws + WS_G_KDT) + (size_t)uid * 8192;
    bf16_t* G_QKD = (bf16_t*)(a.ws + WS_G_QKD) + (size_t)uid * 4096; float* G_UT = (float*)(a.ws + WS_G_UT) + (size_t)uid * 8192; float* G_EGL = (float*)(a.ws + WS_G_EGL);
    tile_g2l(GQKV + (size_t)m0 * 3072 + h * 128, 3072, Qt, 144, 64, 128, tid);
    tile_g2l(GQKV + (size_t)m0 * 3072 + 1024 + h * 128, 3072, Kt, 144, 64, 128, tid);
    tile_g2l(GQKV + (size_t)m0 * 3072 + 2048 + h * 128, 3072, Vt, 144, 64, 128, tid);
    if (wave == 0) {
        const float beta = GB[(size_t)(m0 + lane) * 16 + h], g = GB[(size_t)(m0 + lane) * 16 + 8 + h];
        float gc = g;
#pragma unroll
        for (int o = 1; o < 64; o <<= 1) { const float v = __shfl_up(gc, o); if (lane >= o) gc += v; }
        const float gl = __shfl(gc, 63);
        s_gc[lane] = gc; s_beta[lane] = beta; s_eg[lane] = __expf(gc); s_egl[lane] = __expf(gl - gc); s_bk[lane] = beta * __expf(gc);
        G_EGL[(size_t)uid * 64 + lane] = __expf(gl);
    }
    LBAR();
    for (int i = tid; i < 1024; i += NTHR) { const int r = i >> 4, c = (i & 15) * 8; float f[8]; unpack8(*(const LAS u32x4*)(Qt + r * 144 + c), f); const float e = s_eg[r];
#pragma unroll
        for (int j = 0; j < 8; ++j) f[j] *= e;
        *(u32x4*)(G_QD + r * 128 + c) = pack8(f); }
    transpose_scale<true, false>(Vt, 144, 128, s_beta, VBT, 80, nullptr, tid);
    transpose_scale<true, false>(Kt, 144, 128, s_bk, KBT, 80, nullptr, tid);
    transpose_scale<false, true>(Kt, 144, 128, s_egl, nullptr, 0, G_KDT, tid);
    {
        const int ti = wave >> 1;
#pragma unroll
        for (int jj = 0; jj < 2; ++jj) {
            const int tj = (wave & 1) * 2 + jj;
            f32x4 akk = (f32x4){0.f, 0.f, 0.f, 0.f}, aqk = (f32x4){0.f, 0.f, 0.f, 0.f};
            if (tj <= ti) {
#pragma unroll
                for (int ks = 0; ks < 4; ++ks) {
                    const bf16x8 bk = frag(Kt, 144, 16 * tj, 32 * ks, lane);
                    akk = MFMA16(frag(Kt, 144, 16 * ti, 32 * ks, lane), bk, akk);
                    aqk = MFMA16(frag(Qt, 144, 16 * ti, 32 * ks, lane), bk, aqk);
                }
            }
            const int s = 16 * tj + c16; const float gcs = s_gc[s];
#pragma unroll
            for (int j = 0; j < 4; ++j) {
                const int t = 16 * ti + 4 * kq + j; const float dec = __expf(fminf(s_gc[t] - gcs, 0.f));
                Lm[t * 68 + s] = (s < t) ? s_beta[t] * dec * akk[j] : 0.f;
                G_QKD[t * 64 + s] = (bf16_t)f2bf((s <= t) ? aqk[j] * dec : 0.f);
            }
        }
    }
    LBAR();
    if (wave < 4 && lane < 16) {
        float Tc[16]; const int o = 16 * wave;
#pragma unroll
        for (int t = 0; t < 16; ++t) {
            float acc = (t == lane) ? 1.f : 0.f;
#pragma unroll
            for (int s = 0; s < t; ++s) acc -= Lm[(o + t) * 68 + o + s] * Tc[s];
            Tc[t] = acc; Tm[(o + t) * 68 + o + lane] = acc;
        }
    }
    LBAR();
    for (int d = 1; d < 4; ++d) {
        const int np = 4 - d;
        for (int o = tid; o < np * 256; o += NTHR) {
            const int p = o >> 8, r = (o >> 4) & 15, c = o & 15, i = d + p, j = p;
            float acc = 0.f;
            for (int mm = 16 * j; mm < 16 * i; ++mm) acc += Lm[(16 * i + r) * 68 + mm] * Tm[mm * 68 + 16 * j + c];
            Ys[p * 272 + r * 17 + c] = acc;
        }
        LBAR();
        for (int o = tid; o < np * 256; o += NTHR) {
            const int p = o >> 8, r = (o >> 4) & 15, c = o & 15, i = d + p, j = p;
            float acc = 0.f;
#pragma unroll
            for (int mm = 0; mm < 16; ++mm) acc += Tm[(16 * i + r) * 68 + 16 * i + mm] * Ys[p * 272 + mm * 17 + c];
            Tm[(16 * i + r) * 68 + 16 * j + c] = -acc;
        }
        LBAR();
    }
    for (int i = tid; i < 2048; i += NTHR) { const int r = i >> 5, c = (i & 31) * 2;
        const float v0 = (c <= r) ? Tm[r * 68 + c] : 0.f, v1 = (c + 1 <= r) ? Tm[r * 68 + c + 1] : 0.f;
        *(LAS unsigned*)(Tb + r * 80 + c) = pk2(v0, v1); }
    LBAR();
    {
#pragma unroll
        for (int ti = 0; ti < 4; ++ti) {
            f32x4 acc = (f32x4){0.f, 0.f, 0.f, 0.f};
#pragma unroll
            for (int ks = 0; ks < 2; ++ks) acc = MFMA16(frag(Tb, 80, 16 * ti, 32 * ks, lane), frag(VBT, 80, 16 * wave, 32 * ks, lane), acc);
            *(f32x4*)(G_UT + (size_t)(16 * wave + c16) * 64 + 16 * ti + 4 * kq) = acc;
        }
#pragma unroll
        for (int tt = 0; tt < 4; ++tt) {
            f32x4 acc = (f32x4){0.f, 0.f, 0.f, 0.f};
#pragma unroll
            for (int ks = 0; ks < 2; ++ks) acc = MFMA16(frag(KBT, 80, 16 * wave, 32 * ks, lane), frag(Tb, 80, 16 * tt, 32 * ks, lane), acc);
            u32x2 w; w.x = pk2(acc[0], acc[1]); w.y = pk2(acc[2], acc[3]);
            *(u32x2*)(G_WK + (size_t)(16 * tt + c16) * 128 + 16 * wave + 4 * kq) = w;
        }
    }
    LBAR();
}

__device__ __forceinline__ void m2_gla_unit(const Args& a, LAS unsigned char* lds, int uid) {
    const int tid = ltid(), lane = tid & 63, wave = __builtin_amdgcn_readfirstlane(tid >> 6), c16 = lane & 15, kq = lane >> 4;
    const int h = uid & 3, bc = uid >> 2, m0 = bc * 64;
    LAS bf16_t* Qt = (LAS bf16_t*)(lds);
    LAS bf16_t* Kt = (LAS bf16_t*)(lds + 18432);
    LAS bf16_t* Vt = (LAS bf16_t*)(lds + 36864);
    LAS float* Bm = (LAS float*)(lds + 70656);
    LAS float* tot = (LAS float*)(lds + 104448);
    const bf16_t* PROJ = (const bf16_t*)(a.ws + WS_PROJ); const float* LA = (const float*)(a.ws + WS_LA);
    bf16_t* L_QB = (bf16_t*)(a.ws + WS_L_QB) + (size_t)uid * 8192; bf16_t* L_ATT = (bf16_t*)(a.ws + WS_L_ATT) + (size_t)uid * 4096; bf16_t* L_KDT = (bf16_t*)(a.ws + WS_L_KDT) + (size_t)uid * 8192;
    bf16_t* L_VT = (bf16_t*)(a.ws + WS_L_VT) + (size_t)uid * 16384; float* L_EBL = (float*)(a.ws + WS_L_EBL) + (size_t)uid * 128;
    tile_g2l(PROJ + (size_t)m0 * PW + P_QB + h * 128, PW, Qt, 144, 64, 128, tid);
    tile_g2l(PROJ + (size_t)m0 * PW + P_KB + h * 128, PW, Kt, 144, 64, 128, tid);
    tile_g2l(PROJ + (size_t)m0 * PW + P_VB + h * 256, PW, Vt, 264, 64, 256, tid);
    const int d = tid & 127, seg = tid >> 7;
    float bl[16];
    {
        float run = 0.f;
#pragma unroll
        for (int i = 0; i < 16; ++i) { run += LA[(size_t)(m0 + 16 * seg + i) * 512 + h * 128 + d]; bl[i] = run; }
        tot[seg * 128 + d] = run;
    }
    LBAR();
    {
        float off = 0.f;
        for (int s2 = 0; s2 < seg; ++s2) off += tot[s2 * 128 + d];
#pragma unroll
        for (int i = 0; i < 16; ++i) Bm[(16 * seg + i) * 132 + d] = bl[i] + off;
    }
    LBAR();
    transpose_scale<false, true>(Vt, 264, 256, nullptr, nullptr, 0, L_VT, tid);
    {
        const int spair = tid & 31, cg = tid >> 5, c0 = cg * 8;
        float k0[8], k1[8];
        unpack8(*(const LAS u32x4*)(Kt + (2 * spair) * 144 + c0), k0); unpack8(*(const LAS u32x4*)(Kt + (2 * spair + 1) * 144 + c0), k1);
#pragma unroll
        for (int i = 0; i < 8; ++i) {
            const float bL = Bm[63 * 132 + c0 + i];
            const unsigned w = pk2(k0[i] * __expf(bL - Bm[(2 * spair) * 132 + c0 + i]), k1[i] * __expf(bL - Bm[(2 * spair + 1) * 132 + c0 + i]));
            *(unsigned*)(L_KDT + (size_t)(c0 + i) * 64 + 2 * spair) = w;
        }
        if (tid < 128) L_EBL[tid] = __expf(Bm[63 * 132 + tid]);
    }
    LBAR();
    for (int i = tid; i < 1024; i += NTHR) { const int r = i >> 4, c = (i & 15) * 8; float q[8], k[8];
        unpack8(*(const LAS u32x4*)(Qt + r * 144 + c), q); unpack8(*(const LAS u32x4*)(Kt + r * 144 + c), k);
#pragma unroll
        for (int j = 0; j < 8; ++j) { const float bb = Bm[r * 132 + c + j]; q[j] *= 0.08838834764831845f * __expf(bb); k[j] *= __expf(-bb); }
        const u32x4 qw = pack8(q); *(LAS u32x4*)(Qt + r * 144 + c) = qw; *(u32x4*)(L_QB + r * 128 + c) = qw; *(LAS u32x4*)(Kt + r * 144 + c) = pack8(k); }
    LBAR();
    {
        const int ti = wave >> 1;
#pragma unroll
        for (int jj = 0; jj < 2; ++jj) {
            const int tj = (wave & 1) * 2 + jj;
            f32x4 acc = (f32x4){0.f, 0.f, 0.f, 0.f};
            if (tj <= ti) {
#pragma unroll
                for (int ks = 0; ks < 4; ++ks) acc = MFMA16(frag(Qt, 144, 16 * ti, 32 * ks, lane), frag(Kt, 144, 16 * tj, 32 * ks, lane), acc);
            }
            const int s = 16 * tj + c16;
#pragma unroll
            for (int j = 0; j < 4; ++j) { const int t = 16 * ti + 4 * kq + j; L_ATT[t * 64 + s] = (bf16_t)f2bf((s <= t) ? acc[j] : 0.f); }
        }
    }
    LBAR();
}

__device__ __forceinline__ void m2_ssd_unit(const Args& a, LAS unsigned char* lds, int uid, int layer) {
    const int tid = ltid(), lane = tid & 63, wave = __builtin_amdgcn_readfirstlane(tid >> 6), c16 = lane & 15, kq = lane >> 4;
    const int g = uid & 3, bc = uid >> 2, m0 = bc * 64;
    LAS bf16_t* Bt_ = (LAS bf16_t*)(lds);
    LAS bf16_t* Ct_ = (LAS bf16_t*)(lds + 18432);
    LAS bf16_t* Xt = (LAS bf16_t*)(lds + 36864);
    LAS float* CB = (LAS float*)(lds + 103424);
    LAS float* s_dt = (LAS float*)(lds + 120832);
    LAS float* s_ac = s_dt + 512;
    LAS float* s_e2 = s_ac + 512;
    const bf16_t* XBC = (const bf16_t*)(a.ws + WS_XBC); const float* DT = (const float*)(a.ws + WS_DT);
    tile_g2l(XBC + (size_t)m0 * 3072 + 2048 + g * 128, 3072, Bt_, 144, 64, 128, tid);
    tile_g2l(XBC + (size_t)m0 * 3072 + 2560 + g * 128, 3072, Ct_, 144, 64, 128, tid);
    tile_g2l(XBC + (size_t)m0 * 3072 + g * 512, 3072, Xt, 520, 64, 512, tid);
    {
        const int hh = wave, hd = g * 8 + hh, su = (bc * 32 + hd);
        const float dt = DT[(size_t)(m0 + lane) * 32 + hd], A = -__expf(a.in[30][layer * 32 + hd]);
        float ac = dt * A;
#pragma unroll
        for (int o = 1; o < 64; o <<= 1) { const float v = __shfl_up(ac, o); if (lane >= o) ac += v; }
        const float al_ = __shfl(ac, 63);
        s_dt[hh * 64 + lane] = dt; s_ac[hh * 64 + lane] = ac; s_e2[hh * 64 + lane] = __expf(al_ - ac);
        ((float*)(a.ws + WS_S_EA))[(size_t)su * 64 + lane] = __expf(ac);
        if (lane == 0) ((float*)(a.ws + WS_S_EAL))[su] = __expf(al_);
    }
    LBAR();
    {
        const int ti = wave >> 1;
#pragma unroll
        for (int jj = 0; jj < 2; ++jj) {
            const int tj = (wave & 1) * 2 + jj;
            f32x4 acc = (f32x4){0.f, 0.f, 0.f, 0.f};
            if (tj <= ti) {
#pragma unroll
                for (int ks = 0; ks < 4; ++ks) acc = MFMA16(frag(Ct_, 144, 16 * ti, 32 * ks, lane), frag(Bt_, 144, 16 * tj, 32 * ks, lane), acc);
            }
#pragma unroll
            for (int j = 0; j < 4; ++j) CB[(16 * ti + 4 * kq + j) * 68 + 16 * tj + c16] = acc[j];
        }
    }
    transpose_scale<false, true>(Bt_, 144, 128, nullptr, nullptr, 0, (bf16_t*)(a.ws + WS_S_BT) + (size_t)uid * 8192, tid);
    {
        const int spair = tid & 31, cg = tid >> 5;
        for (int p = 0; p < 4; ++p) {
            const int c0 = p * 128 + cg * 8, hh = c0 >> 6, pp = c0 & 63; const size_t su = (size_t)(bc * 32 + g * 8 + hh);
            float x0[8], x1[8];
            unpack8(*(const LAS u32x4*)(Xt + (2 * spair) * 520 + c0), x0); unpack8(*(const LAS u32x4*)(Xt + (2 * spair + 1) * 520 + c0), x1);
            const float d0 = s_dt[hh * 64 + 2 * spair], d1 = s_dt[hh * 64 + 2 * spair + 1], e0 = s_e2[hh * 64 + 2 * spair], e1 = s_e2[hh * 64 + 2 * spair + 1];
            bf16_t* o1 = (bf16_t*)(a.ws + WS_S_XDTT) + su * 4096; bf16_t* o2 = (bf16_t*)(a.ws + WS_S_XDT2T) + su * 4096;
#pragma unroll
            for (int i = 0; i < 8; ++i) {
                const float v0 = x0[i] * d0, v1 = x1[i] * d1;
                *(unsigned*)(o1 + (pp + i) * 64 + 2 * spair) = pk2(v0, v1);
                *(unsigned*)(o2 + (pp + i) * 64 + 2 * spair) = pk2(v0 * e0, v1 * e1);
            }
        }
    }
    LBAR();
    for (int i = tid; i < 8 * 2048; i += NTHR) {
        const int hh = i >> 11, r = (i >> 5) & 63, c = (i & 31) * 2; const size_t su = (size_t)(bc * 32 + g * 8 + hh);
        const float at = s_ac[hh * 64 + r];
        const float v0 = (c <= r) ? CB[r * 68 + c] * __expf(fminf(at - s_ac[hh * 64 + c], 0.f)) : 0.f;
        const float v1 = (c + 1 <= r) ? CB[r * 68 + c + 1] * __expf(fminf(at - s_ac[hh * 64 + c + 1], 0.f)) : 0.f;
        *(unsigned*)((bf16_t*)(a.ws + WS_S_MH) + su * 4096 + r * 64 + c) = pk2(v0, v1);
    }
    LBAR();
}
__device__ __forceinline__ void m2_phase(const Args& a, LAS unsigned char* lds, int vcu, int G, int layer) {
    for (int u = vcu; u < NGU + NLU + NSG; u += G) {
        if (u < NGU) m2_gdn_unit(a, lds, u);
        else if (u < NGU + NLU) m2_gla_unit(a, lds, u - NGU);
        else m2_ssd_unit(a, lds, u - NGU - NLU, layer);
    }
}

#define LD16(p) (*(const u32x4*)(p))

__device__ __forceinline__ void scan_gdn_unit(const Args& a, LAS unsigned char* lds, int unit, int layer) {
    const int tid = ltid(), lane = tid & 63, wave = __builtin_amdgcn_readfirstlane(tid >> 6), c16 = lane & 15, kq = lane >> 4;
    const int j = unit & 3, h = (unit >> 2) & 7, b = unit >> 5;
    constexpr int OFF_P = 0, OFF_KDT = 36864, BUFSZ = 57344;
    LAS bf16_t* St = (LAS bf16_t*)(lds + 2 * BUFSZ);
    LAS bf16_t* wT = (LAS bf16_t*)(lds + 2 * BUFSZ + 9216);
    const bf16_t* G_WK = (const bf16_t*)(a.ws + WS_G_WK); const bf16_t* G_QD = (const bf16_t*)(a.ws + WS_G_QD); const bf16_t* G_KDT = (const bf16_t*)(a.ws + WS_G_KDT);
    const bf16_t* G_QKD = (const bf16_t*)(a.ws + WS_G_QKD); const float* G_UT = (const float*)(a.ws + WS_G_UT); const float* G_EGL = (const float*)(a.ws + WS_G_EGL);
    bf16_t* OA = (bf16_t*)(a.ws + WS_OA);
    struct Regs { u32x4 r[6]; u32x4 rx[2]; float egl; };
    auto issue = [&](Regs& R, int c) {
        const size_t uid = (size_t)((b * 32 + c) * 8 + h);
        const bf16_t* wk = G_WK + uid * 8192; const bf16_t* qd = G_QD + uid * 8192; const bf16_t* kdt = G_KDT + uid * 8192; const bf16_t* qkd = G_QKD + uid * 4096;
        R.r[0] = LD16(wk + (size_t)tid * 8); R.r[1] = LD16(wk + (size_t)(tid + 512) * 8);
        R.r[2] = LD16(qd + (size_t)tid * 8); R.r[3] = LD16(qd + (size_t)(tid + 512) * 8);
        R.r[4] = LD16(kdt + (size_t)tid * 8); R.r[5] = LD16(kdt + (size_t)(tid + 512) * 8);
        {
            const char* p0 = wave < 4 ? (const char*)(G_UT + uid * 8192 + (size_t)(32 * j + c16) * 64 + 16 * wave + 4 * kq) : (const char*)(qkd + (size_t)(16 * (wave - 4) + c16) * 64 + 8 * kq);
            const size_t st = wave < 4 ? (size_t)16 * 64 * 4 : (size_t)32 * 2;
            R.rx[0] = LD16(p0); R.rx[1] = LD16(p0 + st);
        }
        R.egl = G_EGL[uid * 64 + lane];
    };
    auto commit = [&](const Regs& R, int buf) {
        LAS unsigned char* B = lds + buf * BUFSZ;
        *(LAS u32x4*)(B + OFF_P + ((tid >> 4) * 144 + (tid & 15) * 8) * 2) = R.r[0]; *(LAS u32x4*)(B + OFF_P + (((tid + 512) >> 4) * 144 + (tid & 15) * 8) * 2) = R.r[1];
        *(LAS u32x4*)(B + OFF_P + ((64 + (tid >> 4)) * 144 + (tid & 15) * 8) * 2) = R.r[2]; *(LAS u32x4*)(B + OFF_P + ((64 + ((tid + 512) >> 4)) * 144 + (tid & 15) * 8) * 2) = R.r[3];
        *(LAS u32x4*)(B + OFF_KDT + ((tid >> 3) * 80 + (tid & 7) * 8) * 2) = R.r[4]; *(LAS u32x4*)(B + OFF_KDT + (((tid + 512) >> 3) * 80 + (tid & 7) * 8) * 2) = R.r[5];
    };
    f32x4 Sreg[2] = {(f32x4){0.f, 0.f, 0.f, 0.f}, (f32x4){0.f, 0.f, 0.f, 0.f}};
#pragma unroll
    for (int tj = 0; tj < 2; ++tj) *(LAS u32x2*)(St + (16 * tj + c16) * 144 + 16 * wave + 4 * kq) = (u32x2){0u, 0u};
    Regs RA, RB, RC;
    issue(RA, 0); commit(RA, 0);
    u32x4 cx[2] = {RA.rx[0], RA.rx[1]}; float cegl = RA.egl;
    issue(RB, 1); issue(RC, 2); issue(RA, 3);
    auto step = [&](int c, Regs& Rn) {
        LBAR();
        const LAS unsigned char* B = lds + (c & 1) * BUFSZ;
        const LAS bf16_t* P = (const LAS bf16_t*)(B + OFF_P); const LAS bf16_t* KDT = (const LAS bf16_t*)(B + OFF_KDT);
        f32x4 p[2] = {(f32x4){0.f, 0.f, 0.f, 0.f}, (f32x4){0.f, 0.f, 0.f, 0.f}};
#pragma unroll
        for (int ks = 0; ks < 4; ++ks) {
            const bf16x8 af = frag(P, 144, 16 * wave, 32 * ks, lane);
#pragma unroll
            for (int tj = 0; tj < 2; ++tj) p[tj] = MFMA16(af, frag(St, 144, 16 * tj, 32 * ks, lane), p[tj]);
        }
        if (wave < 4) {
#pragma unroll
            for (int tj = 0; tj < 2; ++tj) { const f32x4 w = __builtin_bit_cast(f32x4, cx[tj]) - p[tj]; u32x2 o; o.x = pk2(w[0], w[1]); o.y = pk2(w[2], w[3]); *(LAS u32x2*)(wT + (16 * tj + c16) * 80 + 16 * wave + 4 * kq) = o; }
        }
        LBAR();
        if (wave >= 4) {
            const int ti = wave - 4;
#pragma unroll
            for (int ks = 0; ks < 2; ++ks) {
                const bf16x8 af = __builtin_bit_cast(bf16x8, cx[ks]);
#pragma unroll
                for (int tj = 0; tj < 2; ++tj) p[tj] = MFMA16(af, frag(wT, 80, 16 * tj, 32 * ks, lane), p[tj]);
            }
        }
#pragma unroll
        for (int tj = 0; tj < 2; ++tj) Sreg[tj] = Sreg[tj] * cegl;
#pragma unroll
        for (int ks = 0; ks < 2; ++ks) {
            const bf16x8 af = frag(KDT, 80, 16 * wave, 32 * ks, lane);
#pragma unroll
            for (int tj = 0; tj < 2; ++tj) Sreg[tj] = MFMA16(af, frag(wT, 80, 16 * tj, 32 * ks, lane), Sreg[tj]);
        }
#pragma unroll
        for (int tj = 0; tj < 2; ++tj) { u32x2 o; o.x = pk2(Sreg[tj][0], Sreg[tj][1]); o.y = pk2(Sreg[tj][2], Sreg[tj][3]); *(LAS u32x2*)(St + (16 * tj + c16) * 144 + 16 * wave + 4 * kq) = o; }
        if (c + 1 < NCHUNK) { commit(Rn, (c + 1) & 1); cx[0] = Rn.rx[0]; cx[1] = Rn.rx[1]; cegl = Rn.egl; if (c + 4 < NCHUNK) issue(Rn, c + 4); }
        if (wave >= 4) {
            bf16_t* op = OA + ((size_t)b * SEQ + c * 64 + 16 * (wave - 4) + 4 * kq) * 1024 + h * 128 + 32 * j + c16;
#pragma unroll
            for (int tj = 0; tj < 2; ++tj)
#pragma unroll
                for (int i = 0; i < 4; ++i) st16_asm(op + (size_t)i * 1024 + 16 * tj, f2bf(p[tj][i]));
        }
    };
#pragma unroll
    for (int c = 0; c < NCHUNK - 2; c += 3) { step(c, RB); step(c + 1, RC); step(c + 2, RA); }
    step(NCHUNK - 2, RB); step(NCHUNK - 1, RC);
    float* so = a.out + O_PG + (((size_t)layer * NB + b) * 8 + h) * 16384;
#pragma unroll
    for (int tj = 0; tj < 2; ++tj)
#pragma unroll
        for (int i = 0; i < 4; ++i) so[(size_t)(16 * wave + 4 * kq + i) * 128 + 32 * j + 16 * tj + c16] = Sreg[tj][i];
    LBAR();
}

__device__ __forceinline__ void scan_gla_unit(const Args& a, LAS unsigned char* lds, int unit, int layer) {
    const int tid = ltid(), lane = tid & 63, wave = __builtin_amdgcn_readfirstlane(tid >> 6), c16 = lane & 15, kq = lane >> 4;
    const int j = unit & 7, h = (unit >> 3) & 3, b = unit >> 5;
    constexpr int OFF_ATT = 0, OFF_QB = 10240, OFF_KDT = 28672, OFF_VT = 49152, OFF_EBL = 54272, BUFSZ = 54784;
    LAS bf16_t* St0 = (LAS bf16_t*)(lds + 2 * BUFSZ);
    const bf16_t* L_QB = (const bf16_t*)(a.ws + WS_L_QB); const bf16_t* L_ATT = (const bf16_t*)(a.ws + WS_L_ATT); const bf16_t* L_KDT = (const bf16_t*)(a.ws + WS_L_KDT);
    const bf16_t* L_VT = (const bf16_t*)(a.ws + WS_L_VT); const float* L_EBL = (const float*)(a.ws + WS_L_EBL);
    bf16_t* OB = (bf16_t*)(a.ws + WS_OB);
    struct Regs { u32x4 r[7]; };
    auto issue = [&](Regs& R, int c) {
        const size_t uid = (size_t)((b * 32 + c) * 4 + h);
        const bf16_t* att = L_ATT + uid * 4096; const bf16_t* qb = L_QB + uid * 8192; const bf16_t* kdt = L_KDT + uid * 8192; const bf16_t* vt = L_VT + uid * 16384 + (size_t)(32 * j) * 64;
        R.r[0] = LD16(att + (size_t)tid * 8);
        R.r[1] = LD16(qb + (size_t)tid * 8); R.r[2] = LD16(qb + (size_t)(tid + 512) * 8);
        R.r[3] = LD16(kdt + (size_t)tid * 8); R.r[4] = LD16(kdt + (size_t)(tid + 512) * 8);
        R.r[5] = LD16(vt + (size_t)(tid & 255) * 8);
        R.r[6] = LD16((const bf16_t*)(L_EBL + uid * 128) + (size_t)(tid & 31) * 8);
    };
    auto commit = [&](const Regs& R, int buf) {
        LAS unsigned char* B = lds + buf * BUFSZ;
        *(LAS u32x4*)(B + OFF_ATT + ((tid >> 3) * 80 + (tid & 7) * 8) * 2) = R.r[0];
        *(LAS u32x4*)(B + OFF_QB + ((tid >> 4) * 144 + (tid & 15) * 8) * 2) = R.r[1]; *(LAS u32x4*)(B + OFF_QB + (((tid + 512) >> 4) * 144 + (tid & 15) * 8) * 2) = R.r[2];
        *(LAS u32x4*)(B + OFF_KDT + ((tid >> 3) * 80 + (tid & 7) * 8) * 2) = R.r[3]; *(LAS u32x4*)(B + OFF_KDT + (((tid + 512) >> 3) * 80 + (tid & 7) * 8) * 2) = R.r[4];
        if (tid < 256) *(LAS u32x4*)(B + OFF_VT + ((tid >> 3) * 80 + (tid & 7) * 8) * 2) = R.r[5];
        if (tid < 32) *(LAS u32x4*)(B + OFF_EBL + tid * 16) = R.r[6];
    };
    f32x4 Sreg[2] = {(f32x4){0.f, 0.f, 0.f, 0.f}, (f32x4){0.f, 0.f, 0.f, 0.f}};
#pragma unroll
    for (int tj = 0; tj < 2; ++tj) *(LAS u32x2*)(St0 + (16 * tj + c16) * 144 + 16 * wave + 4 * kq) = (u32x2){0u, 0u};
    Regs RA, RB, RC;
    issue(RA, 0); commit(RA, 0); issue(RB, 1); issue(RC, 2); issue(RA, 3);
    auto step = [&](int c, Regs& Rn) {
        LBAR();
        const LAS unsigned char* B = lds + (c & 1) * BUFSZ;
        const LAS bf16_t* ATT = (const LAS bf16_t*)(B + OFF_ATT); const LAS bf16_t* QB = (const LAS bf16_t*)(B + OFF_QB); const LAS bf16_t* KDT = (const LAS bf16_t*)(B + OFF_KDT);
        const LAS bf16_t* VT = (const LAS bf16_t*)(B + OFF_VT); const LAS float* EBL = (const LAS float*)(B + OFF_EBL);
        const LAS bf16_t* Sc = St0 + (c & 1) * (32 * 144); LAS bf16_t* Sn = St0 + ((c + 1) & 1) * (32 * 144);
        f32x4 oo;
        {
            const int ti = wave >> 1, tj = wave & 1;
            f32x4 o = (f32x4){0.f, 0.f, 0.f, 0.f};
#pragma unroll
            for (int ks = 0; ks < 2; ++ks) o = MFMA16(frag(ATT, 80, 16 * ti, 32 * ks, lane), frag(VT, 80, 16 * tj, 32 * ks, lane), o);
#pragma unroll
            for (int ks = 0; ks < 4; ++ks) o = MFMA16(frag(QB, 144, 16 * ti, 32 * ks, lane), frag(Sc, 144, 16 * tj, 32 * ks, lane), o);
            oo = o;
        }
        {
            const f32x4 e = *(const LAS f32x4*)(EBL + 16 * wave + 4 * kq);
#pragma unroll
            for (int tj = 0; tj < 2; ++tj) Sreg[tj] = Sreg[tj] * e;
#pragma unroll
            for (int ks = 0; ks < 2; ++ks) {
                const bf16x8 af = frag(KDT, 80, 16 * wave, 32 * ks, lane);
#pragma unroll
                for (int tj = 0; tj < 2; ++tj) Sreg[tj] = MFMA16(af, frag(VT, 80, 16 * tj, 32 * ks, lane), Sreg[tj]);
            }
#pragma unroll
            for (int tj = 0; tj < 2; ++tj) { u32x2 o; o.x = pk2(Sreg[tj][0], Sreg[tj][1]); o.y = pk2(Sreg[tj][2], Sreg[tj][3]); *(LAS u32x2*)(Sn + (16 * tj + c16) * 144 + 16 * wave + 4 * kq) = o; }
        }
        if (c + 1 < NCHUNK) { commit(Rn, (c + 1) & 1); if (c + 4 < NCHUNK) issue(Rn, c + 4); }
        {
            bf16_t* op = OB + ((size_t)b * SEQ + c * 64 + 16 * (wave >> 1) + 4 * kq) * 1024 + h * 256 + 32 * j + 16 * (wave & 1) + c16;
#pragma unroll
            for (int i = 0; i < 4; ++i) st16_asm(op + (size_t)i * 1024, f2bf(oo[i]));
        }
    };
#pragma unroll
    for (int c = 0; c < NCHUNK - 2; c += 3) { step(c, RB); step(c + 1, RC); step(c + 2, RA); }
    step(NCHUNK - 2, RB); step(NCHUNK - 1, RC);
    float* so = a.out + O_PL + (((size_t)layer * NB + b) * 4 + h) * 32768;
#pragma unroll
    for (int tj = 0; tj < 2; ++tj)
#pragma unroll
        for (int i = 0; i < 4; ++i) so[(size_t)(16 * wave + 4 * kq + i) * 256 + 32 * j + 16 * tj + c16] = Sreg[tj][i];
    LBAR();
}

template <int DUMMY>
__device__ __forceinline__ void scan_ssd_unit(const Args& a, LAS unsigned char* lds, int unit, int layer) {
    const int tid = ltid(), lane = tid & 63, wave = __builtin_amdgcn_readfirstlane(tid >> 6), c16 = lane & 15, kq = lane >> 4;
    const int h = unit & 31, b = unit >> 5, g = h >> 3;
    constexpr int OFF_MH = 0, OFF_X1 = 10240, OFF_X2 = 20480, OFF_BT = 30720, OFF_EA = 51200, BUFSZ = 51456;
    LAS bf16_t* Hs0 = (LAS bf16_t*)(lds + 2 * BUFSZ);
    const bf16_t* S_MH = (const bf16_t*)(a.ws + WS_S_MH); const bf16_t* S_X1 = (const bf16_t*)(a.ws + WS_S_XDTT); const bf16_t* S_X2 = (const bf16_t*)(a.ws + WS_S_XDT2T);
    const bf16_t* S_BT = (const bf16_t*)(a.ws + WS_S_BT); const float* S_EA = (const float*)(a.ws + WS_S_EA); const float* S_EAL = (const float*)(a.ws + WS_S_EAL);
    const bf16_t* XBC = (const bf16_t*)(a.ws + WS_XBC); bf16_t* YC = (bf16_t*)(a.ws + WS_YC);
    struct Regs { u32x4 r[6]; bf16x8 rc[4]; };
    const int ti = wave >> 1;
    auto issue = [&](Regs& R, int c) {
        const size_t su = (size_t)((b * 32 + c) * 32 + h), sg = (size_t)((b * 32 + c) * 4 + g);
        R.r[0] = LD16(S_MH + su * 4096 + (size_t)tid * 8); R.r[1] = LD16(S_X1 + su * 4096 + (size_t)tid * 8); R.r[2] = LD16(S_X2 + su * 4096 + (size_t)tid * 8);
        R.r[3] = LD16(S_BT + sg * 8192 + (size_t)tid * 8); R.r[4] = LD16(S_BT + sg * 8192 + (size_t)(tid + 512) * 8);
        R.r[5] = LD16((const bf16_t*)(S_EA + su * 64) + (size_t)(tid & 15) * 8);
        const bf16_t* cr = XBC + ((size_t)b * SEQ + c * 64 + 16 * ti + c16) * 3072 + 2560 + g * 128 + 8 * kq;
#pragma unroll
        for (int ks = 0; ks < 4; ++ks) { if (DUMMY != 2) R.rc[ks] = *(const bf16x8*)(cr + 32 * ks); else R.rc[ks] = __builtin_bit_cast(bf16x8, R.r[ks]); }
    };
    auto commit = [&](const Regs& R, int buf) {
        LAS unsigned char* B = lds + buf * BUFSZ;
        const int o = ((tid >> 3) * 80 + (tid & 7) * 8) * 2;
        *(LAS u32x4*)(B + OFF_MH + o) = R.r[0]; *(LAS u32x4*)(B + OFF_X1 + o) = R.r[1]; *(LAS u32x4*)(B + OFF_X2 + o) = R.r[2];
        *(LAS u32x4*)(B + OFF_BT + o) = R.r[3]; *(LAS u32x4*)(B + OFF_BT + (((tid + 512) >> 3) * 80 + (tid & 7) * 8) * 2) = R.r[4];
        if (tid < 16) *(LAS u32x4*)(B + OFF_EA + tid * 16) = R.r[5];
    };
    f32x4 Hreg[4];
#pragma unroll
    for (int tp = 0; tp < 4; ++tp) { Hreg[tp] = (f32x4){0.f, 0.f, 0.f, 0.f}; *(LAS u32x2*)(Hs0 + (16 * tp + c16) * 144 + 16 * wave + 4 * kq) = (u32x2){0u, 0u}; }
    Regs RA, RB;
    issue(RA, 0); commit(RA, 0);
    bf16x8 cc[4] = {RA.rc[0], RA.rc[1], RA.rc[2], RA.rc[3]};
    issue(RB, 1); issue(RA, 2);
    auto step = [&](int c, Regs& Rn) {
        LBAR();
        const LAS unsigned char* B = lds + (c & 1) * BUFSZ;
        const LAS bf16_t* MH = (const LAS bf16_t*)(B + OFF_MH); const LAS bf16_t* X1 = (const LAS bf16_t*)(B + OFF_X1); const LAS bf16_t* X2 = (const LAS bf16_t*)(B + OFF_X2);
        const LAS bf16_t* BT = (const LAS bf16_t*)(B + OFF_BT); const LAS float* EA = (const LAS float*)(B + OFF_EA);
        const LAS bf16_t* Hc = Hs0 + (c & 1) * (64 * 144); LAS bf16_t* Hn = Hs0 + ((c + 1) & 1) * (64 * 144);
        f32x4 yy[2];
        {
            const f32x4 ea = *(const LAS f32x4*)(EA + 16 * ti + 4 * kq);
#pragma unroll
            for (int q = 0; q < 2; ++q) {
                const int tp = 2 * (wave & 1) + q;
                f32x4 y1 = (f32x4){0.f, 0.f, 0.f, 0.f}, y2 = (f32x4){0.f, 0.f, 0.f, 0.f};
#pragma unroll
                for (int ks = 0; ks < 2; ++ks) y1 = MFMA16(frag(MH, 80, 16 * ti, 32 * ks, lane), frag(X1, 80, 16 * tp, 32 * ks, lane), y1);
#pragma unroll
                for (int ks = 0; ks < 4; ++ks) y2 = MFMA16(cc[ks], frag(Hc, 144, 16 * tp, 32 * ks, lane), y2);
                yy[q] = y1 + ea * y2;
            }
        }
        const float ceal = EA[63];
#pragma unroll
        for (int tp = 0; tp < 4; ++tp) Hreg[tp] = Hreg[tp] * ceal;
#pragma unroll
        for (int ks = 0; ks < 2; ++ks) {
            const bf16x8 af = frag(BT, 80, 16 * wave, 32 * ks, lane);
#pragma unroll
            for (int tp = 0; tp < 4; ++tp) Hreg[tp] = MFMA16(af, frag(X2, 80, 16 * tp, 32 * ks, lane), Hreg[tp]);
        }
#pragma unroll
        for (int tp = 0; tp < 4; ++tp) { u32x2 o; o.x = pk2(Hreg[tp][0], Hreg[tp][1]); o.y = pk2(Hreg[tp][2], Hreg[tp][3]); *(LAS u32x2*)(Hn + (16 * tp + c16) * 144 + 16 * wave + 4 * kq) = o; }
        if (c + 1 < NCHUNK) { commit(Rn, (c + 1) & 1); cc[0] = Rn.rc[0]; cc[1] = Rn.rc[1]; cc[2] = Rn.rc[2]; cc[3] = Rn.rc[3]; if (c + 3 < NCHUNK) issue(Rn, c + 3); }
        {
            bf16_t* yp = YC + ((size_t)b * SEQ + c * 64 + 16 * ti + 4 * kq) * 2048 + h * 64 + 32 * (wave & 1) + c16;
#pragma unroll
            for (int q = 0; q < 2; ++q)
#pragma unroll
                for (int i = 0; i < 4; ++i) { if (DUMMY != 1) st16_asm(yp + (size_t)i * 2048 + 16 * q, f2bf(yy[q][i])); else asm volatile("" :: "v"(yy[q][i])); }
        }
    };
#pragma unroll
    for (int c = 0; c < NCHUNK; c += 2) { step(c, RB); step(c + 1, RA); }
    float* so = a.out + O_PS + (((size_t)layer * NB + b) * 32 + h) * 8192;
#pragma unroll
    for (int tp = 0; tp < 4; ++tp) { if (DUMMY == 0) *(f32x4*)(so + (size_t)(16 * tp + c16) * 128 + 16 * wave + 4 * kq) = Hreg[tp]; else asm volatile("" :: "v"(Hreg[tp])); }
    LBAR();
}

__device__ __forceinline__ void samp_gdn_loop(const Args& a, LAS unsigned char* lds, int u0, int ustride, int layer) {
    const int tid = ltid();
    LAS float* sk = (LAS float*)lds, *sq = sk + 128, *sv = sk + 256, *sw = sk + 384, *red = sk + 512;
    const int dv = 4 * (tid & 31), dkb = tid >> 5;
    if (u0 >= 1024) return;
    f32x4 S[8], Sn[8];
    { const int h = u0 & 7, s = u0 >> 3; const float* Sin = a.in[3] + (((size_t)layer * NS + s) * 8 + h) * 16384;
#pragma unroll
      for (int i = 0; i < 8; ++i) S[i] = *(const f32x4*)(Sin + (size_t)(8 * dkb + i) * 128 + dv); }
#pragma unroll 1
    for (int unit = u0; unit < 1024; unit += ustride) {
        const int h = unit & 7, s = unit >> 3, m = NPT + s, un = unit + ustride;
        if (un < 1024) { const int hn = un & 7, sn = un >> 3; const float* Sin = a.in[3] + (((size_t)layer * NS + sn) * 8 + hn) * 16384;
#pragma unroll
            for (int i = 0; i < 8; ++i) Sn[i] = *(const f32x4*)(Sin + (size_t)(8 * dkb + i) * 128 + dv); }
        const bf16_t* GQKV = (const bf16_t*)(a.ws + WS_GQKV) + (size_t)m * 3072; const float* GB = (const float*)(a.ws + WS_GB) + (size_t)m * 16;
        float* Sout = a.out + O_SG + (((size_t)layer * NS + s) * 8 + h) * 16384;
        if (tid < 128) { sq[tid] = bf2f(GQKV[h * 128 + tid]); sk[tid] = bf2f(GQKV[1024 + h * 128 + tid]); sv[tid] = bf2f(GQKV[2048 + h * 128 + tid]); }
        const float beta = GB[h], eg = __expf(GB[8 + h]);
        LBAR();
        f32x4 part = (f32x4){0.f, 0.f, 0.f, 0.f};
#pragma unroll
        for (int i = 0; i < 8; ++i) part = part + S[i] * sk[8 * dkb + i];
        *(LAS f32x4*)(red + dkb * 128 + dv) = part;
        LBAR();
        if (tid < 128) { float ks = 0.f;
#pragma unroll
            for (int i = 0; i < 16; ++i) ks += red[i * 128 + tid];
            sw[tid] = beta * (sv[tid] - eg * ks); }
        LBAR();
        const f32x4 w = *(const LAS f32x4*)(sw + dv);
        part = (f32x4){0.f, 0.f, 0.f, 0.f};
#pragma unroll
        for (int i = 0; i < 8; ++i) { S[i] = S[i] * eg + w * sk[8 * dkb + i]; __builtin_nontemporal_store(S[i], (f32x4*)(Sout + (size_t)(8 * dkb + i) * 128 + dv)); part = part + S[i] * sq[8 * dkb + i]; }
        *(LAS f32x4*)(red + dkb * 128 + dv) = part;
        LBAR();
        if (tid < 128) { float o = 0.f;
#pragma unroll
            for (int i = 0; i < 16; ++i) o += red[i * 128 + tid];
            ((bf16_t*)(a.ws + WS_OA))[(size_t)m * 1024 + h * 128 + tid] = (bf16_t)f2bf(o); }
        LBAR();
#pragma unroll
        for (int i = 0; i < 8; ++i) S[i] = Sn[i];
    }
}
__device__ __forceinline__ void samp_gla_loop(const Args& a, LAS unsigned char* lds, int u0, int ustride, int layer) {
    const int tid = ltid();
    LAS float* sk = (LAS float*)lds, *sq = sk + 128, *se = sk + 256, *sv = sk + 384, *red = sk + 640;
    const int dv = 4 * (tid & 63), dkb = tid >> 6;
    if (u0 >= 512) return;
    f32x4 S[16], Sn[16];
    { const int h = u0 & 3, s = u0 >> 2; const float* Sin = a.in[4] + (((size_t)layer * NS + s) * 4 + h) * 32768;
#pragma unroll
      for (int i = 0; i < 16; ++i) S[i] = *(const f32x4*)(Sin + (size_t)(16 * dkb + i) * 256 + dv); }
#pragma unroll 1
    for (int unit = u0; unit < 512; unit += ustride) {
        const int h = unit & 3, s = unit >> 2, m = NPT + s, un = unit + ustride;
        if (un < 512) { const int hn = un & 3, sn = un >> 2; const float* Sin = a.in[4] + (((size_t)layer * NS + sn) * 4 + hn) * 32768;
#pragma unroll
            for (int i = 0; i < 16; ++i) Sn[i] = *(const f32x4*)(Sin + (size_t)(16 * dkb + i) * 256 + dv); }
        const bf16_t* PR = (const bf16_t*)(a.ws + WS_PROJ) + (size_t)m * PW; const float* LA = (const float*)(a.ws + WS_LA) + (size_t)m * 512;
        float* Sout = a.out + O_SL + (((size_t)layer * NS + s) * 4 + h) * 32768;
        if (tid < 128) { sq[tid] = bf2f(PR[P_QB + h * 128 + tid]) * 0.08838834764831845f; sk[tid] = bf2f(PR[P_KB + h * 128 + tid]); se[tid] = __expf(LA[h * 128 + tid]); }
        if (tid < 256) sv[tid] = bf2f(PR[P_VB + h * 256 + tid]);
        LBAR();
        const f32x4 v = *(const LAS f32x4*)(sv + dv);
        f32x4 part = (f32x4){0.f, 0.f, 0.f, 0.f};
#pragma unroll
        for (int i = 0; i < 16; ++i) { const int dk = 16 * dkb + i; S[i] = S[i] * se[dk] + v * sk[dk]; __builtin_nontemporal_store(S[i], (f32x4*)(Sout + (size_t)dk * 256 + dv)); part = part + S[i] * sq[dk]; }
        *(LAS f32x4*)(red + dkb * 256 + dv) = part;
        LBAR();
        if (tid < 256) { float o = 0.f;
#pragma unroll
            for (int i = 0; i < 8; ++i) o += red[i * 256 + tid];
            ((bf16_t*)(a.ws + WS_OB))[(size_t)m * 1024 + h * 256 + tid] = (bf16_t)f2bf(o); }
        LBAR();
#pragma unroll
        for (int i = 0; i < 16; ++i) S[i] = Sn[i];
    }
}
__device__ __forceinline__ void samp_ssd_loop(const Args& a, int u0, int ustride, int layer) {
    const int tid = ltid(), lane = tid & 63, wave = __builtin_amdgcn_readfirstlane(tid >> 6);
    const int n = 4 * (lane & 31), pb = 32 * (lane >> 5);
#pragma unroll 1
    for (int unit = u0; unit < 512; unit += ustride) {
        const int g = unit & 3, s = unit >> 2, m = NPT + s, h = g * 8 + wave;
        const bf16_t* XB = (const bf16_t*)(a.ws + WS_XBC) + (size_t)m * 3072; const float dt = ((const float*)(a.ws + WS_DT))[(size_t)m * 32 + h];
        const float dA = __expf(dt * -__expf(a.in[30][layer * 32 + h]));
        const float* Hin = a.in[6] + (((size_t)layer * NS + s) * 32 + h) * 8192 + (size_t)pb * 128 + n; float* Hout = a.out + O_SS + (((size_t)layer * NS + s) * 32 + h) * 8192 + (size_t)pb * 128 + n;
        const u32x2 bw = *(const u32x2*)(XB + 2048 + g * 128 + n), cw = *(const u32x2*)(XB + 2560 + g * 128 + n);
        const f32x4 Bv = (f32x4){bflo(bw.x), bfhi(bw.x), bflo(bw.y), bfhi(bw.y)} * dt, Cv = (f32x4){bflo(cw.x), bfhi(cw.x), bflo(cw.y), bfhi(cw.y)};
        bf16_t* YC = (bf16_t*)(a.ws + WS_YC) + (size_t)m * 2048 + h * 64 + pb;
        f32x4 hv[8], hn8[8];
#pragma unroll
        for (int i = 0; i < 8; ++i) hv[i] = *(const f32x4*)(Hin + (size_t)i * 128);
#pragma unroll
        for (int i0 = 0; i0 < 32; i0 += 8) {
            if (i0 + 8 < 32) {
#pragma unroll
                for (int i = 0; i < 8; ++i) hn8[i] = *(const f32x4*)(Hin + (size_t)(i0 + 8 + i) * 128);
            }
            const u32x4 xw = *(const u32x4*)(XB + h * 64 + pb + i0);
            float xs[8]; unpack8(xw, xs);
#pragma unroll
            for (int i = 0; i < 8; ++i) {
                const f32x4 hnew = hv[i] * dA + Bv * xs[i]; __builtin_nontemporal_store(hnew, (f32x4*)(Hout + (size_t)(i0 + i) * 128));
                float y = (hnew.x * Cv.x + hnew.y * Cv.y) + (hnew.z * Cv.z + hnew.w * Cv.w);
                y += __shfl_xor(y, 1); y += __shfl_xor(y, 2); y += __shfl_xor(y, 4); y += __shfl_xor(y, 8); y += __shfl_xor(y, 16);
                if ((lane & 31) == 0) YC[i0 + i] = (bf16_t)f2bf(y);
            }
#pragma unroll
            for (int i = 0; i < 8; ++i) hv[i] = hn8[i];
        }
    }
}
#ifndef REPMASK
#define REPMASK 0
#endif
__device__ __forceinline__ void m3_phase(const Args& a, LAS unsigned char* lds, int vcu, int G, int layer) {
    for (int rep = 0; rep < 1 + ((REPMASK >> 16) & 1); ++rep)
    for (int u = vcu; u < 256; u += G) {
        if (u < 128) { scan_gdn_unit(a, lds, u, layer); scan_gla_unit(a, lds, u, layer); }
        else { scan_ssd_unit<0>(a, lds, u - 128, layer); if ((REPMASK >> 20) & 1) scan_ssd_unit<0>(a, lds, u - 128, layer); if ((REPMASK >> 21) & 1) scan_ssd_unit<1>(a, lds, u - 128, layer); if ((REPMASK >> 22) & 1) scan_ssd_unit<2>(a, lds, u - 128, layer); }
    }
    for (int rep = 0; rep < 1 + ((REPMASK >> 17) & 1); ++rep) {
    samp_gdn_loop(a, lds, vcu, G, layer);
    samp_gla_loop(a, lds, vcu, G, layer);
    samp_ssd_loop(a, vcu, G, layer);
    }
}

__device__ __forceinline__ void m4_phase(const Args& a, int vcu, int G, int layer) {
    const int tid = ltid(), lane = tid & 63, wave = __builtin_amdgcn_readfirstlane(tid >> 6);
    const int gw = vcu * NWAVES + wave, NGW = G * NWAVES;
    const bf16_t* PROJ = (const bf16_t*)(a.ws + WS_PROJ); const bf16_t* OA = (const bf16_t*)(a.ws + WS_OA); const bf16_t* OB = (const bf16_t*)(a.ws + WS_OB); const bf16_t* YC = (const bf16_t*)(a.ws + WS_YC);
    const bf16_t* XBC = (const bf16_t*)(a.ws + WS_XBC); bf16_t* BR = (bf16_t*)(a.ws + WS_BR);
    const float* gnw = a.in[24] + (size_t)layer * 128; const float* lnw = a.in[27] + (size_t)layer * 256; const float* snw = a.in[33] + (size_t)layer * 2048; const float* sd = a.in[32] + (size_t)layer * 32;
#pragma unroll 1
    for (int m = gw; m < MT; m += NGW) {
        const bf16_t* pr = PROJ + (size_t)m * PW;
        u32x4 l_oa[2], l_za[2], l_ob[2], l_rb[2], l_yc[4], l_xc[4], l_zc[4];
#pragma unroll
        for (int it = 0; it < 2; ++it) { const int ch = it * 512 + lane * 8;
            l_oa[it] = *(const u32x4*)(OA + (size_t)m * 1024 + ch); l_za[it] = *(const u32x4*)(pr + P_ZA + ch);
            l_ob[it] = *(const u32x4*)(OB + (size_t)m * 1024 + ch); l_rb[it] = *(const u32x4*)(pr + P_RB + ch); }
#pragma unroll
        for (int it = 0; it < 4; ++it) { const int ch = it * 512 + lane * 8;
            l_yc[it] = *(const u32x4*)(YC + (size_t)m * 2048 + ch); l_xc[it] = *(const u32x4*)(XBC + (size_t)m * 3072 + ch); l_zc[it] = *(const u32x4*)(pr + P_ZC + ch); }
#pragma unroll
        for (int it = 0; it < 2; ++it) {
            const int ch = it * 512 + lane * 8; float o[8], z[8];
            unpack8(l_oa[it], o); unpack8(l_za[it], z);
            float ss = 0.f;
#pragma unroll
            for (int i = 0; i < 8; ++i) ss += o[i] * o[i];
            ss += __shfl_xor(ss, 1); ss += __shfl_xor(ss, 2); ss += __shfl_xor(ss, 4); ss += __shfl_xor(ss, 8);
            const float r = 1.0f / sqrtf(ss * (1.f / 128.f) + EPS);
            const f32x4 w0 = *(const f32x4*)(gnw + (ch & 127)), w1 = *(const f32x4*)(gnw + (ch & 127) + 4);
#pragma unroll
            for (int i = 0; i < 4; ++i) { o[i] = o[i] * r * w0[i] * siluf_(z[i]); o[4 + i] = o[4 + i] * r * w1[i] * siluf_(z[4 + i]); }
            *(u32x4*)(BR + (size_t)m * 4096 + ch) = pack8(o);
        }
#pragma unroll
        for (int it = 0; it < 2; ++it) {
            const int ch = it * 512 + lane * 8; float o[8], z[8];
            unpack8(l_ob[it], o); unpack8(l_rb[it], z);
            float ss = 0.f;
#pragma unroll
            for (int i = 0; i < 8; ++i) ss += o[i] * o[i];
            ss += __shfl_xor(ss, 1); ss += __shfl_xor(ss, 2); ss += __shfl_xor(ss, 4); ss += __shfl_xor(ss, 8); ss += __shfl_xor(ss, 16);
            const float r = 1.0f / sqrtf(ss * (1.f / 256.f) + EPS);
            const f32x4 w0 = *(const f32x4*)(lnw + (ch & 255)), w1 = *(const f32x4*)(lnw + (ch & 255) + 4);
#pragma unroll
            for (int i = 0; i < 4; ++i) { o[i] = o[i] * r * w0[i] * siluf_(z[i]); o[4 + i] = o[4 + i] * r * w1[i] * siluf_(z[4 + i]); }
            *(u32x4*)(BR + (size_t)m * 4096 + 1024 + ch) = pack8(o);
        }
#pragma unroll
        for (int it = 0; it < 4; ++it) {
            const int ch = it * 512 + lane * 8; float y[8], x[8], z[8];
            unpack8(l_yc[it], y); unpack8(l_xc[it], x); unpack8(l_zc[it], z);
            const float dd = sd[ch >> 6]; float ss = 0.f;
#pragma unroll
            for (int i = 0; i < 8; ++i) { y[i] = (y[i] + dd * x[i]) * siluf_(z[i]); ss += y[i] * y[i]; }
            ss = wave_sum(ss);
            const float r = 1.0f / sqrtf(ss * (1.f / 512.f) + EPS);
            const f32x4 w0 = *(const f32x4*)(snw + ch), w1 = *(const f32x4*)(snw + ch + 4);
#pragma unroll
            for (int i = 0; i < 4; ++i) { y[i] = y[i] * r * w0[i]; y[4 + i] = y[4 + i] * r * w1[i]; }
            *(u32x4*)(BR + (size_t)m * 4096 + 2048 + ch) = pack8(y);
        }
    }
}

#ifndef MK_N_LAUNCHES
#define MK_N_LAUNCHES 1
#endif
constexpr int PH_PER_LAYER = 14, N_PHASES = 2 + 2 * PH_PER_LAYER + 1;
constexpr int CW_BAR = 4096;

#define AS4 __attribute__((address_space(4)))
__device__ __forceinline__ Args load_args() {
    Args r;
#if defined(__HIP_DEVICE_COMPILE__)
    const AS4 Args* ap = (const AS4 Args*)__builtin_amdgcn_kernarg_segment_ptr(); asm volatile("" : "+s"(ap));
    for (int i = 0; i < 39; ++i) r.in[i] = ap->in[i]; r.out = ap->out; r.ws = ap->ws; r.ph_lo = ap->ph_lo; r.ph_hi = ap->ph_hi;
#else
    r = Args{};
#endif
    return r;
}
#define LAYER_PTRS unsigned char* lw = a.ws + WS_W + (size_t)layer * LW_SIZE; const float* modl = (const float*)(a.ws + WS_MOD) + (size_t)layer * NCR * NMOD; \
    float* X = (float*)(a.ws + WS_X); const bf16_t* H = (const bf16_t*)(a.ws + WS_H); bf16_t* ACT = (bf16_t*)(a.ws + WS_ACT); bf16_t* PROJ = (bf16_t*)(a.ws + WS_PROJ); float* SMALL = (float*)(a.ws + WS_SMALL); \
    bf16_t* BR = (bf16_t*)(a.ws + WS_BR); float* MRG = (float*)(a.ws + WS_MRG); bf16_t* MRGB = (bf16_t*)(a.ws + WS_MRGB); (void)lw; (void)modl; (void)X; (void)H; (void)ACT; (void)PROJ; (void)SMALL; (void)BR; (void)MRG; (void)MRGB;
#define PHASE_FN __device__ __forceinline__ void
PHASE_FN ph_gateup(LAS unsigned char* lds, int G, int bx, int layer, int which) {
    const Args a = load_args(); LAYER_PTRS
    pg8::Gemm g{H, (const bf16_t*)(lw + (which ? LW_GU2 : LW_GU1)), D}; pg8::Sched S; S.init(MP / 256, 2 * FF / 256, G, bx, D);
    EpiSwiglu E{ACT}; pg8::gemm_phase<EpiSwiglu>(lds, g, S, E);
}
PHASE_FN ph_down(LAS unsigned char* lds, int vcu, int G, int bx, int layer, int which) {
    const Args a = load_args(); LAYER_PTRS
    const bf16_t* W = (const bf16_t*)(lw + (which ? LW_D2 : LW_D1)); const float* gate = modl + (which ? 8 : 2) * D;
    pg8::Gemm g{ACT, W, FF}; pg8::Sched S; S.init(NPT / 256, D / 256, G, bx, FF);
    EpiResid E{X, gate, 0.5f}; pg8::gemm_phase<EpiResid>(lds, g, S, E);
    skinny_gemm(a, lds, vcu, G, ACT, FF, W, FF, 1, FF, 0, 0, 0, X, gate, 0.5f, nullptr, nullptr);
}
PHASE_FN ph_win(LAS unsigned char* lds, int G, int bx, int layer) {
    const Args a = load_args(); LAYER_PTRS
    pg8::Gemm g{H, (const bf16_t*)(lw + LW_IN), D}; pg8::Sched S; S.init(MP / 256, NINP / 256, G, bx, D);
    EpiWin E{PROJ, SMALL}; pg8::gemm_phase<EpiWin>(lds, g, S, E);
}
PHASE_FN ph_branch(LAS unsigned char* lds, int vcu, int G, int bx, int layer) {
    const Args a = load_args(); LAYER_PTRS
    pg8::Gemm g{BR, (const bf16_t*)(lw + LW_BR), 4096}; pg8::Sched S; S.init(NPT / 256, D / 256, G, bx, 4096);
    S.nseg = 3;
    EpiBranch E{MRG, MRGB, PROJ}; pg8::gemm_phase<EpiBranch>(lds, g, S, E);
    skinny_gemm(a, lds, vcu, G, BR, 4096, (const bf16_t*)(lw + LW_BR), 4096, 3, 1024, 1024, 2048, 1, nullptr, nullptr, 0.f, MRGB, PROJ);
    if ((REPMASK >> 23) & 1) { skinny_gemm(a, lds, vcu, G, BR, 4096, (const bf16_t*)(lw + LW_BR), 4096, 3, 1024, 1024, 2048, 1, nullptr, nullptr, 0.f, MRGB, PROJ); skinny_gemm(a, lds, vcu, G, BR, 4096, (const bf16_t*)(lw + LW_BR), 4096, 3, 1024, 1024, 2048, 1, nullptr, nullptr, 0.f, MRGB, PROJ); skinny_gemm(a, lds, vcu, G, BR, 4096, (const bf16_t*)(lw + LW_BR), 4096, 3, 1024, 1024, 2048, 1, nullptr, nullptr, 0.f, MRGB, PROJ); }
}
PHASE_FN ph_out(LAS unsigned char* lds, int vcu, int G, int bx, int layer) {
    const Args a = load_args(); LAYER_PTRS
    pg8::Gemm g{MRGB, (const bf16_t*)(lw + LW_OUT), D}; pg8::Sched S; S.init(NPT / 256, D / 256, G, bx, D);
    EpiResid E{X, modl + 5 * D, 1.0f}; pg8::gemm_phase<EpiResid>(lds, g, S, E);
    skinny_gemm(a, lds, vcu, G, MRGB, D, (const bf16_t*)(lw + LW_OUT), D, 1, D, 0, 0, 0, X, modl + 5 * D, 1.0f, nullptr, nullptr);
}

__global__ void __launch_bounds__(NTHR, 2) mk_fwd(Args a0) {
    extern __shared__ __attribute__((aligned(16))) unsigned char lds_raw[];
    LAS unsigned char* lds = (LAS unsigned char*)lds_raw;
    const int G = gridDim.x, bx = blockIdx.x, vcu = (G % 8 == 0) ? (bx % 8) * (G / 8) + bx / 8 : bx;
    const int lo = a0.ph_lo, hi = a0.ph_hi;
    if (threadIdx.x < 16) ((LAS unsigned*)(lds + LDSCTL_OFF))[threadIdx.x] = 0u;
    __syncthreads();
    XcdBarrier bar; bar.bar = (unsigned*)(a0.ws + WS_CTL) + CW_BAR; bar.x = 0; bar.st = (volatile LAS unsigned*)(lds + LDSCTL_OFF);
    if (hi - lo > 1) bar = xcd_barrier_post((unsigned*)(a0.ws + WS_CTL) + CW_BAR, (volatile LAS unsigned*)(lds + LDSCTL_OFF));
#ifndef ONLY_PH
#define ONLY_PH -1
#endif
#define IN(k) ((ONLY_PH < 0 || ONLY_PH == (((k) < 2 || (k) == N_PHASES - 1) ? (k) : 2 + ((k) - 2) % PH_PER_LAYER)) && lo <= (k) && (k) < hi)
#ifndef REPMASK
#define REPMASK 0
#endif
#define REP(j) if ((REPMASK >> (j)) & 1)
#define SEAM(k) do { if (IN(k) && IN((k) + 1)) xcd_barrier(bar); } while (0)
    if (IN(0)) { const Args a = load_args(); p0_convert(a, lds, vcu, G); REP(14) p0_convert(a, lds, vcu, G); } SEAM(0);
    if (IN(1)) { const Args a = load_args(); p1_mod(a, lds, vcu, G); REP(15) p1_mod(a, lds, vcu, G); } SEAM(1);
    for (int layer = 0; layer < 2; ++layer) {
        const int pb = 2 + layer * PH_PER_LAYER;
        if (IN(pb + 0)) { const Args a = load_args(); norm_mod_phase(a, vcu, G, layer, 0, layer == 0); REP(0) norm_mod_phase(a, vcu, G, layer, 0, layer == 0); } SEAM(pb + 0);
        if (IN(pb + 1)) { ph_gateup(lds, G, bx, layer, 0); REP(1) ph_gateup(lds, G, bx, layer, 0); } SEAM(pb + 1);
        if (IN(pb + 2)) ph_down(lds, vcu, G, bx, layer, 0); SEAM(pb + 2);
        if (IN(pb + 3)) { const Args a = load_args(); norm_mod_phase(a, vcu, G, layer, 1, false); REP(3) norm_mod_phase(a, vcu, G, layer, 1, false); } SEAM(pb + 3);
        if (IN(pb + 4)) { ph_win(lds, G, bx, layer); REP(4) ph_win(lds, G, bx, layer); } SEAM(pb + 4);
        if (IN(pb + 5)) { const Args a = load_args(); m1_phase(a, vcu, G, layer); REP(5) m1_phase(a, vcu, G, layer); } SEAM(pb + 5);
        if (IN(pb + 6)) { const Args a = load_args(); m2_phase(a, lds, vcu, G, layer); REP(6) m2_phase(a, lds, vcu, G, layer); } SEAM(pb + 6);
        if (IN(pb + 7)) { const Args a = load_args(); m3_phase(a, lds, vcu, G, layer); REP(7) m3_phase(a, lds, vcu, G, layer); } SEAM(pb + 7);
        if (IN(pb + 8)) { const Args a = load_args(); m4_phase(a, vcu, G, layer); REP(8) m4_phase(a, vcu, G, layer); } SEAM(pb + 8);
        if (IN(pb + 9)) { ph_branch(lds, vcu, G, bx, layer); REP(9) ph_branch(lds, vcu, G, bx, layer); } SEAM(pb + 9);
        if (IN(pb + 10)) ph_out(lds, vcu, G, bx, layer); SEAM(pb + 10);
        if (IN(pb + 11)) { const Args a = load_args(); norm_mod_phase(a, vcu, G, layer, 2, false); REP(11) norm_mod_phase(a, vcu, G, layer, 2, false); } SEAM(pb + 11);
        if (IN(pb + 12)) ph_gateup(lds, G, bx, layer, 1); SEAM(pb + 12);
        if (IN(pb + 13)) ph_down(lds, vcu, G, bx, layer, 1); SEAM(pb + 13);
    }
    if (IN(N_PHASES - 1)) { const Args a = load_args(); final_norm_phase(a, vcu, G); }
#undef IN
#undef SEAM
}

extern "C" void kernel_launch(void* const* d_in, const int* in_sizes, int n_in, void* d_out, int out_size, void* d_ws, size_t ws_size, hipStream_t stream) {
    static int grid = 0;
    if (grid == 0) {
        if (n_in != 39 || (size_t)out_size != O_END || ws_size < WS_END) {
            fprintf(stderr, "kernel_launch: built for 39 inputs, %zu outputs, >= %zu bytes of workspace; got n_in %d, out %d, ws %zu; nothing launched\n", (size_t)O_END, (size_t)WS_END, n_in, out_size, ws_size);
            grid = -1; return; }
        int dev = 0, cus = 0, per_cu = 0;
        if (hipGetDevice(&dev) != hipSuccess || hipDeviceGetAttribute(&cus, hipDeviceAttributeMultiprocessorCount, dev) != hipSuccess) { grid = -1; return; }
        if (hipFuncSetAttribute((const void*)mk_fwd, hipFuncAttributeMaxDynamicSharedMemorySize, LDS_BYTES) != hipSuccess) { fprintf(stderr, "kernel_launch: hipFuncSetAttribute failed\n"); grid = -1; return; }
        if (hipOccupancyMaxActiveBlocksPerMultiprocessor(&per_cu, (const void*)mk_fwd, NTHR, LDS_BYTES) != hipSuccess || per_cu < 1)
            fprintf(stderr, "kernel_launch: note: occupancy query reports %d workgroups per CU\n", per_cu);
        (void)hipGetLastError();
        grid = cus;
    }
    if (grid < 0) return;
    if (hipMemsetAsync((char*)d_ws + WS_CTL, 0, CTL_BYTES, stream) != hipSuccess) { fprintf(stderr, "kernel_launch: memset failed\n"); return; }
    Args a{};
    for (int i = 0; i < 39; ++i) a.in[i] = (const float*)d_in[i];
    a.out = (float*)d_out; a.ws = (unsigned char*)d_ws;
#if MK_N_LAUNCHES == 1
    a.ph_lo = 0; a.ph_hi = N_PHASES;
    hipLaunchKernelGGL(mk_fwd, dim3(grid), dim3(NTHR), LDS_BYTES, stream, a);
#else
    for (int p = 0; p < N_PHASES; ++p) { a.ph_lo = p; a.ph_hi = p + 1; hipLaunchKernelGGL(mk_fwd, dim3(grid), dim3(NTHR), LDS_BYTES, stream, a); }
#endif
    const hipError_t le = hipPeekAtLastError();
    if (le != hipSuccess) fprintf(stderr, "kernel_launch: launch failed: %s\n", hipGetErrorName(le));
}
```

```cpp
#define MK_N_LAUNCHES 1
#include <hip/hip_runtime.h>
#include <cstdio>
#include <cstdint>

#define LAS __attribute__((address_space(3)))
typedef unsigned short bf16_t;
typedef short bf16x8 __attribute__((ext_vector_type(8)));
typedef float f32x4 __attribute__((ext_vector_type(4)));
typedef float f32x2 __attribute__((ext_vector_type(2)));
typedef unsigned u32x4 __attribute__((ext_vector_type(4)));
typedef unsigned u32x2 __attribute__((ext_vector_type(2)));

constexpr int D = 2048, NB = 4, SEQ = 2048, NPT = NB * SEQ  , NS = 128  , MT = NPT + NS  , MP = 8448  ;
constexpr int NCR = NB + NS;
constexpr int FF = 5504, NMOD = 9 * D;
constexpr int NIN = 18496, PW = 18432  , NINP = 18688  , SW = 64  ;
constexpr int P_QKVA = 0, P_ZA = 3072, P_QB = 4096, P_KB = 4608, P_VB = 5120, P_RB = 6144, P_ZC = 7168, P_XBC = 9216, P_GATES = 12288;
constexpr int S_BETA = 0, S_DEC = 8, S_LR = 16, S_DT = 32;
constexpr int NCHUNK = 32, CH = 64;
constexpr float EPS = 1e-6f;

typedef __bf16 hwbf16x2 __attribute__((ext_vector_type(2)));
__device__ __forceinline__ unsigned pk2(float lo, float hi) { const f32x2 v = {lo, hi}; return __builtin_bit_cast(unsigned, __builtin_convertvector(v, hwbf16x2)); }
__device__ __forceinline__ unsigned f2bf(float f) { return pk2(f, f) & 0xffffu; }
__device__ __forceinline__ float bf2f(unsigned short b) { return __builtin_bit_cast(float, ((unsigned)b) << 16); }
__device__ __forceinline__ float bflo(unsigned w) { return __builtin_bit_cast(float, w << 16); }
__device__ __forceinline__ float bfhi(unsigned w) { return __builtin_bit_cast(float, w & 0xffff0000u); }
__device__ __forceinline__ float fast_rcp(float x) { return __builtin_amdgcn_rcpf(x); }
__device__ __forceinline__ float sigmoidf_(float x) { return fast_rcp(1.f + __expf(-x)); }
__device__ __forceinline__ float siluf_(float x) { return x * sigmoidf_(x); }
__device__ __forceinline__ float softplusf_(float x) { return fmaxf(x, 0.f) + __logf(1.f + __expf(-fabsf(x))); }
__device__ __forceinline__ float logsigmoidf_(float x) { return fminf(x, 0.f) - __logf(1.f + __expf(-fabsf(x))); }
__device__ __forceinline__ float wave_sum(float v) {
#pragma unroll
    for (int o = 1; o < 64; o <<= 1) v += __shfl_xor(v, o);
    return v;
}
__device__ __forceinline__ int ltid() { int t = threadIdx.x; asm volatile("" : "+v"(t)); return t; }
#define LBAR() do { asm volatile("s_waitcnt lgkmcnt(0)" ::: "memory"); __builtin_amdgcn_s_barrier(); asm volatile("" ::: "memory"); } while (0)
__device__ __forceinline__ float vload_f32(const float* p) { asm volatile("" : "+v"(p)); return *p; }
__device__ __forceinline__ void st16_asm(bf16_t* p, unsigned v) { asm volatile("global_store_short %0, %1, off" :: "v"(p), "v"(v) : "memory"); }
__device__ __forceinline__ u32x4 ld16_asm(const void* p) { u32x4 r; asm volatile("global_load_dwordx4 %0, %1, off" : "=v"(r) : "v"(p) : "memory"); return r; }
__device__ __forceinline__ float ld4_asm(const void* p) { float r; asm volatile("global_load_dword %0, %1, off" : "=v"(r) : "v"(p) : "memory"); return r; }
#define VMW_CASE(n) case n: asm volatile("s_waitcnt vmcnt(" #n ")" ::: "memory"); break;
__device__ __forceinline__ void wait_vm(int n) {
    switch (n) { VMW_CASE(0) VMW_CASE(4) VMW_CASE(7) VMW_CASE(8) VMW_CASE(9) VMW_CASE(11) VMW_CASE(12) VMW_CASE(14) VMW_CASE(15) VMW_CASE(16) VMW_CASE(17) VMW_CASE(18) VMW_CASE(19) VMW_CASE(20) VMW_CASE(22) VMW_CASE(23) VMW_CASE(24) VMW_CASE(25) VMW_CASE(26) VMW_CASE(27) VMW_CASE(28) VMW_CASE(30) VMW_CASE(33) VMW_CASE(34) VMW_CASE(36) VMW_CASE(42)
      default: asm volatile("s_waitcnt vmcnt(0)" ::: "memory"); break; }
}
#define LDS_WAIT() asm volatile("s_waitcnt lgkmcnt(0)" ::: "memory")
#define VM_WAIT() asm volatile("s_waitcnt vmcnt(0)" ::: "memory")

namespace pg8 {
constexpr int BM = 256, BK = 64, HALF = 128, HTB = HALF * BK * 2, STAGE_BYTES = 8 * HTB, NXCD = 8, WGM = 8;
__host__ __device__ __forceinline__ int lds_byte(int r, int c) { const int st = (r >> 4) * 2 + (c >> 5), rr = r & 15, cc = c & 31, ob = rr * 64 + cc * 2; return st * 1024 + (ob ^ (((ob >> 9) & 1) << 5)); }
__host__ __device__ __forceinline__ void stage_rc(int b, int& R, int& C) { const int st = b / 1024, sb = b % 1024, swz = sb ^ (((sb >> 9) & 1) << 5); R = (st >> 1) * 16 + swz / 64; C = (st & 1) * 32 + (swz % 64) / 2; }
__host__ __device__ __forceinline__ int perm32(int rho) { const int n = rho >> 4, i = rho & 15; return 8 * (i >> 2) + 4 * n + (i & 3); }

struct Unit { int pm, pn, k0, nt, seg; };
struct Gemm { const bf16_t* A; const bf16_t* Bt; int K; };

struct Sched {
    int nM, nN, nwg, G, c, nseg, nt;
    int nmini, mini_last_nt;
    __device__ __forceinline__ void init(int nM_, int nN_, int G_, int c_, int K) { nM = nM_; nN = nN_; nwg = nM * nN; G = G_; c = c_; nseg = 1; nt = K / BK; nmini = 0; mini_last_nt = 4; }
    __device__ __forceinline__ bool next(int i, Unit& u) const {
        const int ui = (nseg == 1) ? i : i / 3, sg = (nseg == 1) ? 0 : i - 3 * ui;
        const long L = (long)ui * G + c;
        if (L >= nwg) {
            const int mi = (int)(L - nwg); if (mi >= nmini) return false;
            const int chunk = mi / nN; u.pm = nM; u.pn = mi - chunk * nN; u.k0 = chunk * 4 * BK; u.nt = (mi + nN >= nmini) ? mini_last_nt : 4; u.seg = 1; return true;
        }
        int wgid = (int)L; { const int q = nwg / NXCD, r = nwg % NXCD, xcd = wgid % NXCD, off = wgid / NXCD; wgid = (xcd < r ? xcd * (q + 1) : r * (q + 1) + (xcd - r) * q) + off; }
        const int nig = WGM * nN, gid = wgid / nig, fm = gid * WGM, gsz = (nM - fm) < WGM ? (nM - fm) : WGM;
        u.pm = fm + ((wgid % nig) % gsz); u.pn = (wgid % nig) / gsz;
        u.k0 = sg * 1024; u.nt = (nseg == 1) ? nt : (sg == 2 ? 32 : 16); u.seg = sg; return true;
    }
};
__device__ __forceinline__ unsigned cvt_pk_bf16(float lo, float hi) { unsigned r; asm volatile("v_cvt_pk_bf16_f32 %0, %1, %2" : "=v"(r) : "v"(lo), "v"(hi)); return r; }

template <class Epi>
__device__ __forceinline__ void gemm_phase(LAS unsigned char* lds, const Gemm g, const Sched& S, const Epi& E) {
    const int tid = ltid(), wid = __builtin_amdgcn_readfirstlane(tid >> 6), lane = tid & 63, wr = wid >> 2, wc = wid & 3, fr = lane & 15, fq = lane >> 4;
    const int K = g.K;
    unsigned voffA[2], voffB[2];
#pragma unroll
    for (int i = 0; i < 2; ++i) { int R, C; stage_rc(tid * 16 + i * 8192, R, C); const int Rb = Epi::PERM ? ((R & ~31) + perm32(R & 31)) : R;
        voffA[i] = (unsigned)(R * K + C) * 2u; voffB[i] = (unsigned)(Rb * K + C) * 2u; }
    const size_t kstep = (size_t)(BK * 2);
    const size_t hstep = (size_t)HALF * K * 2;
    const size_t tstep = 2 * hstep;
    const unsigned ldsw = (unsigned)wid * 1024u;
    const int aoff = lds_byte(wr * 64 + fr, fq * 8), boff = lds_byte(wc * 32 + fr, fq * 8);
#define PG8_SA(b, h) (((b) * 2 + (h)) * HTB)
#define PG8_SB(b, h) ((4 + (b) * 2 + (h)) * HTB)
#define PG8_STAGE(bufoff, gbase, voff) do { _Pragma("unroll") for (int _i = 0; _i < 2; ++_i) \
        __builtin_amdgcn_global_load_lds((const unsigned*)((const char*)(gbase) + (voff)[_i]), (LAS unsigned*)(lds + (bufoff) + ldsw + _i * 8192), 16, 0, 0); } while (0)
#define PG8_LDA(dst, b, h) do { _Pragma("unroll") for (int m = 0; m < 4; ++m) _Pragma("unroll") for (int k = 0; k < 2; ++k) dst[m][k] = *(const LAS bf16x8*)(lds + PG8_SA(b, h) + aoff + m * 2048 + k * 1024); } while (0)
#define PG8_LDB(dst, b, h) do { _Pragma("unroll") for (int n = 0; n < 2; ++n) _Pragma("unroll") for (int k = 0; k < 2; ++k) dst[n][k] = *(const LAS bf16x8*)(lds + PG8_SB(b, h) + boff + n * 2048 + k * 1024); } while (0)
#define PG8_MMA(ai, bj, At, Bt) do { __builtin_amdgcn_s_setprio(1); _Pragma("unroll") for (int m = 0; m < 4; ++m) _Pragma("unroll") for (int n = 0; n < 2; ++n) _Pragma("unroll") for (int k = 0; k < 2; ++k) \
        acc[ai][bj][m][n] = __builtin_amdgcn_mfma_f32_16x16x32_bf16(Bt[n][k], At[m][k], acc[ai][bj][m][n], 0, 0, 0); __builtin_amdgcn_s_setprio(0); } while (0)
#define PG8_WAIT_V(n) asm volatile("s_waitcnt vmcnt(" #n ")" ::: "memory")
#define PG8_WAIT_L(n) asm volatile("s_waitcnt lgkmcnt(" #n ")" ::: "memory")
#define PG8_BAR __builtin_amdgcn_s_barrier()
#define PG8_SCHED __builtin_amdgcn_sched_barrier(0)
    Unit cur, nxt; int ui = 0;
    if (!S.next(0, cur)) return;
    f32x4 acc[2][2][4][2];
#pragma unroll
    for (int a = 0; a < 2; ++a)
#pragma unroll
        for (int b = 0; b < 2; ++b)
#pragma unroll
            for (int m = 0; m < 4; ++m)
#pragma unroll
                for (int n = 0; n < 2; ++n) acc[a][b][m][n] = (f32x4){0.f, 0.f, 0.f, 0.f};
    bf16x8 At[4][2], B0[2][2], B1[2][2];
    const char* cA = (const char*)g.A + (size_t)cur.pm * tstep + (size_t)cur.k0 * 2; const char* cB = (const char*)g.Bt + (size_t)cur.pn * tstep + (size_t)cur.k0 * 2;
    PG8_STAGE(PG8_SB(0, 0), cB, voffB); PG8_STAGE(PG8_SB(0, 1), cB + hstep, voffB); PG8_STAGE(PG8_SA(0, 0), cA, voffA); PG8_STAGE(PG8_SA(0, 1), cA + hstep, voffA);
    if (wr == 1) PG8_BAR;
    PG8_WAIT_V(2); PG8_BAR;
    PG8_STAGE(PG8_SB(1, 0), cB + kstep, voffB); PG8_STAGE(PG8_SA(1, 0), cA + kstep, voffA); PG8_STAGE(PG8_SB(1, 1), cB + hstep + kstep, voffB);
    PG8_WAIT_V(6); PG8_BAR;
    for (;;) {
        const bool has_next = S.next(ui + 1, nxt);
        const char* nA = has_next ? (const char*)g.A + (size_t)nxt.pm * tstep + (size_t)nxt.k0 * 2 : cA; const char* nB = has_next ? (const char*)g.Bt + (size_t)nxt.pn * tstep + (size_t)nxt.k0 * 2 : cB;
        const int nt = cur.nt;
        for (int t = 0; t < nt; t += 2) {
            const bool last = (t == nt - 2);
            const char* a1 = cA + (size_t)(t + 1) * kstep;
            const char* a2 = last ? nA : cA + (size_t)(t + 2) * kstep; const char* b2 = last ? nB : cB + (size_t)(t + 2) * kstep;
            const char* a3 = a2 + kstep; const char* b3 = b2 + kstep;
            PG8_LDB(B0, 0, 0); PG8_LDB(B1, 0, 1); PG8_SCHED; PG8_LDA(At, 0, 0); PG8_STAGE(PG8_SA(1, 1), a1 + hstep, voffA);
            PG8_WAIT_V(8); PG8_WAIT_L(0); PG8_BAR; PG8_MMA(0, 0, At, B0); PG8_MMA(0, 1, At, B1); PG8_BAR; PG8_SCHED;
            PG8_LDA(At, 0, 1); PG8_STAGE(PG8_SB(0, 0), b2, voffB); PG8_STAGE(PG8_SB(0, 1), b2 + hstep, voffB); PG8_STAGE(PG8_SA(0, 0), a2, voffA);
            PG8_WAIT_V(8); PG8_WAIT_L(0); PG8_BAR; PG8_MMA(1, 0, At, B0); PG8_MMA(1, 1, At, B1); PG8_BAR; PG8_SCHED;
            PG8_LDB(B0, 1, 0); PG8_LDB(B1, 1, 1); PG8_SCHED; PG8_LDA(At, 1, 0); PG8_STAGE(PG8_SA(0, 1), a2 + hstep, voffA);
            PG8_WAIT_V(8); PG8_WAIT_L(0); PG8_BAR; PG8_MMA(0, 0, At, B0); PG8_MMA(0, 1, At, B1); PG8_BAR; PG8_SCHED;
            PG8_LDA(At, 1, 1); PG8_STAGE(PG8_SB(1, 0), b3, voffB); PG8_STAGE(PG8_SB(1, 1), b3 + hstep, voffB); PG8_STAGE(PG8_SA(1, 0), a3, voffA);
            PG8_WAIT_V(8); PG8_WAIT_L(0); PG8_BAR; PG8_MMA(1, 0, At, B0); PG8_MMA(1, 1, At, B1); PG8_BAR; PG8_SCHED;
        }
        if (wr == 0) PG8_BAR;
        E(acc, cur, wr, wc, fr, fq);
        if (!has_next) break;
#pragma unroll
        for (int a = 0; a < 2; ++a)
#pragma unroll
            for (int b = 0; b < 2; ++b)
#pragma unroll
                for (int m = 0; m < 4; ++m)
#pragma unroll
                    for (int n = 0; n < 2; ++n) acc[a][b][m][n] = (f32x4){0.f, 0.f, 0.f, 0.f};
        cur = nxt; cA = nA; cB = nB; ++ui;
        if (wr == 1) PG8_BAR;
    }
    PG8_WAIT_V(0);
    PG8_BAR;
#undef PG8_SA
#undef PG8_SB
#undef PG8_STAGE
#undef PG8_LDA
#undef PG8_LDB
#undef PG8_MMA
#undef PG8_WAIT_V
#undef PG8_WAIT_L
#undef PG8_BAR
#undef PG8_SCHED
}
}
#define CVT_ALL_IN_P0 1

#define XB_TMO      128
#define XB_XCNT(j)  (256  + 64 * (j))
#define XB_XSUB(j)  (1280 + 64 * (j))
#define XB_XGEN(j)  (2304 + 64 * (j))
#define XB_TOP      3328
#define XB_TOPGEN   3392
#define XCD_BAR_WORDS 3456
#define XB_SPIN_CAP (1u << 18)
__device__ __forceinline__ unsigned xb_ld(unsigned* p)              { return __hip_atomic_load(p, __ATOMIC_RELAXED, __HIP_MEMORY_SCOPE_AGENT); }
__device__ __forceinline__ unsigned xb_add(unsigned* p, unsigned v) { return __hip_atomic_fetch_add(p, v, __ATOMIC_RELAXED, __HIP_MEMORY_SCOPE_AGENT); }
__device__ __forceinline__ unsigned xb_xcc_id() { return (unsigned)__builtin_amdgcn_s_getreg((3 << 11) | 20) & 0xFu; }
#define XB_SPIN(cond, bar) do { unsigned _sp = 0; while (cond) { __builtin_amdgcn_s_sleep(1); \
    if ((++_sp & 255u) == 0u) { if (xb_ld(&(bar)[XB_TMO])) break; if (_sp > XB_SPIN_CAP) { atomicAdd(&(bar)[XB_TMO], 1u); break; } } } } while (0)
struct XcdBarrier { unsigned* bar; unsigned x; volatile LAS unsigned* st; };
__device__ __forceinline__ XcdBarrier xcd_barrier_post(unsigned* bar, volatile LAS unsigned* st) {
    XcdBarrier b; b.bar = bar; b.x = xb_xcc_id(); b.st = st;
    if (threadIdx.x == 0) (void)xb_add(&bar[XB_XCNT(b.x)], 1u);
    return b;
}
__device__ __forceinline__ void xcd_barrier_complete(unsigned* bar, unsigned x, unsigned& nloc, unsigned& nx) {
    const unsigned G = gridDim.x * gridDim.y * gridDim.z;
    unsigned sum, cnt, mine, sp = 0u;
    for (;;) {
        sum = 0u; cnt = 0u; mine = 0u;
#pragma unroll
        for (unsigned j = 0; j < 16; ++j) { const unsigned c = xb_ld(&bar[XB_XCNT(j)]); sum += c; cnt += (c > 0u) ? 1u : 0u; mine = (j == x) ? c : mine; }
        if (sum == G) break;
        __builtin_amdgcn_s_sleep(1);
        if ((++sp & 255u) == 0u) { if (xb_ld(&bar[XB_TMO])) break; if (sp > XB_SPIN_CAP) { atomicAdd(&bar[XB_TMO], 1u); break; } }
    }
    nloc = mine > 0u ? mine : 1u; nx = cnt > 0u ? cnt : 1u;
}
__device__ __forceinline__ void xcd_barrier(const XcdBarrier& b) {
    asm volatile("s_waitcnt vmcnt(0)" ::: "memory");
    __syncthreads();
    if (threadIdx.x == 0) {
        unsigned* bar = b.bar;
        __builtin_amdgcn_s_waitcnt(0);
        unsigned nloc = b.st[0], nx = b.st[1];
        if (nloc == 0u) { xcd_barrier_complete(bar, b.x, nloc, nx); b.st[0] = nloc; b.st[1] = nx; }
        const unsigned old = xb_add(&bar[XB_XSUB(b.x)], 1u);
        const unsigned gen = old / nloc;
        if (old + 1u == (gen + 1u) * nloc) {
            __builtin_amdgcn_fence(__ATOMIC_RELEASE, "agent");
            asm volatile("s_waitcnt vmcnt(0)" ::: "memory");
            const unsigned og = xb_add(&bar[XB_TOP], 1u);
            const unsigned tg = og / nx;
            if (og + 1u == (tg + 1u) * nx) xb_add(&bar[XB_TOPGEN], 1u);
            else XB_SPIN(xb_ld(&bar[XB_TOPGEN]) == tg, bar);
            __builtin_amdgcn_fence(__ATOMIC_ACQUIRE, "agent");
            xb_add(&bar[XB_XGEN(b.x)], 1u);
            asm volatile("s_waitcnt vmcnt(0)" ::: "memory");
        } else {
            XB_SPIN(xb_ld(&bar[XB_XGEN(b.x)]) == gen, bar);
            __builtin_amdgcn_fence(__ATOMIC_ACQUIRE, "agent");
            asm volatile("s_waitcnt vmcnt(0)" ::: "memory");
        }
    }
    __syncthreads();
}

constexpr size_t al(size_t x) { return (x + 0xFFFFFull) & ~(size_t)0xFFFFFull; }
constexpr size_t WS_CTL = 0, CTL_BYTES = 1u << 20;
constexpr size_t SZ_WGU = (size_t)2 * FF * D * 2, SZ_WD = (size_t)D * FF * 2, SZ_WIN = (size_t)NINP * D * 2, SZ_WBR = (size_t)D * 4096 * 2, SZ_WOUT = (size_t)D * D * 2;
constexpr size_t LW_GU1 = 0, LW_D1 = LW_GU1 + al(SZ_WGU), LW_GU2 = LW_D1 + al(SZ_WD), LW_D2 = LW_GU2 + al(SZ_WGU), LW_IN = LW_D2 + al(SZ_WD), LW_BR = LW_IN + al(SZ_WIN), LW_OUT = LW_BR + al(SZ_WBR), LW_SIZE = LW_OUT + al(SZ_WOUT);
constexpr size_t WS_W = WS_CTL + CTL_BYTES;
constexpr size_t WS_MOD = WS_W + 2 * LW_SIZE;
constexpr size_t WS_SC = WS_MOD + al((size_t)2 * NCR * NMOD * 4);
constexpr size_t WS_X = WS_SC + al((size_t)144 * D * 2);
constexpr size_t WS_H = WS_X + al((size_t)MP * D * 4);
constexpr size_t WS_ACT = WS_H + al((size_t)MP * D * 2);
constexpr size_t WS_PROJ = WS_ACT + al((size_t)MP * FF * 2);
constexpr size_t WS_SMALL = WS_PROJ + al((size_t)MP * PW * 2);
constexpr size_t WS_BR = WS_SMALL + al((size_t)MP * SW * 4);
constexpr size_t WS_MRG = WS_BR + al((size_t)MP * 4096 * 2);
constexpr size_t WS_MRGB = WS_MRG + al((size_t)MP * D * 4);
constexpr size_t WS_PART = WS_MRGB + al((size_t)MP * D * 2);
constexpr size_t WS_MIX = WS_PART + al((size_t)21 * NS * D * 4);

constexpr int RING_BYTES = 131072, LDS_BYTES = 147456, LDSCTL_OFF = LDS_BYTES - 64;
constexpr int NWAVES = 8, NTHR = 512;

struct Args { const float* in[39]; float* out; unsigned char* ws; int ph_lo, ph_hi; };

__device__ __forceinline__ int win_col(int n) {
    if (n < 4096) return n;
    if (n < 4104) return PW + S_BETA + (n - 4096);
    if (n < 4112) return PW + S_DEC + (n - 4104);
    if (n < 4624) return P_QB + (n - 4112);
    if (n < 5136) return P_KB + (n - 4624);
    if (n < 6160) return P_VB + (n - 5136);
    if (n < 6176) return PW + S_LR + (n - 6160);
    if (n < 7200) return P_RB + (n - 6176);
    if (n < 9248) return P_ZC + (n - 7200);
    if (n < 12320) return P_XBC + (n - 9248);
    if (n < 12352) return PW + S_DT + (n - 12320);
    return P_GATES + (n - 12352);
}
__device__ __forceinline__ int map_row(int mode, int n) {
    if (mode == 0) return n;
    if (mode == 1) return ((n >> 7) << 8) + (n & 127);
    if (mode == 2) return ((n >> 7) << 8) + 128 + (n & 127);
    return win_col(n);
}
__device__ __forceinline__ void transpose_item(const float* __restrict__ W, int N, bf16_t* __restrict__ WT, int KP, int koff, int mode, LAS float* scr, int kb, int nb, int lane) {
    const int k0 = 64 * kb, n0 = 32 * nb;
    {
        f32x4 v[8];
#pragma unroll
        for (int i = 0; i < 8; ++i) v[i] = __builtin_nontemporal_load((const f32x4*)(W + (size_t)(k0 + 8 * i + (lane >> 3)) * N + n0 + 4 * (lane & 7)));
#pragma unroll
        for (int i = 0; i < 8; ++i) { LAS float* d = scr + (8 * i + (lane >> 3)) * 33 + 4 * (lane & 7); d[0] = v[i].x; d[1] = v[i].y; d[2] = v[i].z; d[3] = v[i].w; }
    }
    LDS_WAIT(); asm volatile("" ::: "memory");
    const int c = lane & 7;
#pragma unroll
    for (int j = 0; j < 4; ++j) { const int n = (lane >> 3) + 8 * j; const LAS float* s = scr + (8 * c) * 33 + n;
        u32x4 o; o.x = pk2(s[0 * 33], s[1 * 33]); o.y = pk2(s[2 * 33], s[3 * 33]); o.z = pk2(s[4 * 33], s[5 * 33]); o.w = pk2(s[6 * 33], s[7 * 33]);
        *(u32x4*)(WT + (size_t)map_row(mode, n0 + n) * KP + koff + k0 + 8 * c) = o; }
    LDS_WAIT(); asm volatile("" ::: "memory");
}
struct CvtJob { const float* W; bf16_t* WT; int K, N, KP, koff, mode; };
__device__ __forceinline__ CvtJob cvt_job(const Args& a, int l, int j) {
    unsigned char* lw = a.ws + WS_W + (size_t)l * LW_SIZE;
    CvtJob r;
    switch (j) {
    case 0: r = CvtJob{a.in[14] + (size_t)l * D * FF, (bf16_t*)(lw + LW_GU1), D, FF, D, 0, 1}; break;
    case 1: r = CvtJob{a.in[15] + (size_t)l * D * FF, (bf16_t*)(lw + LW_GU1), D, FF, D, 0, 2}; break;
    case 2: r = CvtJob{a.in[16] + (size_t)l * FF * D, (bf16_t*)(lw + LW_D1), FF, D, FF, 0, 0}; break;
    case 3: r = CvtJob{a.in[17] + (size_t)l * D * FF, (bf16_t*)(lw + LW_GU2), D, FF, D, 0, 1}; break;
    case 4: r = CvtJob{a.in[18] + (size_t)l * D * FF, (bf16_t*)(lw + LW_GU2), D, FF, D, 0, 2}; break;
    case 5: r = CvtJob{a.in[19] + (size_t)l * FF * D, (bf16_t*)(lw + LW_D2), FF, D, FF, 0, 0}; break;
    case 6: r = CvtJob{a.in[20] + (size_t)l * D * NIN, (bf16_t*)(lw + LW_IN), D, NIN, D, 0, 3}; break;
    case 7: r = CvtJob{a.in[34] + (size_t)l * 1024 * D, (bf16_t*)(lw + LW_BR), 1024, D, 4096, 0, 0}; break;
    case 8: r = CvtJob{a.in[35] + (size_t)l * 1024 * D, (bf16_t*)(lw + LW_BR), 1024, D, 4096, 1024, 0}; break;
    case 9: r = CvtJob{a.in[36] + (size_t)l * 2048 * D, (bf16_t*)(lw + LW_BR), 2048, D, 4096, 2048, 0}; break;
    default: r = CvtJob{a.in[37] + (size_t)l * D * D, (bf16_t*)(lw + LW_OUT), D, D, D, 0, 0}; break;
    }
    return r;
}
__device__ __forceinline__ bool cvt_set_job(int set, int idx, int& l, int& j) {
    if (set == 0) { if (idx >= 5) return false; l = idx == 4 ? 1 : 0; j = idx == 0 ? 0 : (idx == 1 ? 1 : (idx == 2 ? 2 : 6)); return true; }
    if (set == 1) { if (idx >= 5) return false; l = 0; j = idx == 4 ? 5 : 7 + idx; return true; }
    if (set == 2) { if (idx >= 2) return false; l = 0; j = 3 + idx; return true; }
    if (set == 3) { if (idx >= 2) return false; l = 1; j = idx; return true; }
    if (set == 4) { if (idx >= 5) return false; l = 1; j = idx == 0 ? 2 : 6 + idx; return true; }
    if (idx >= 3) return false; l = 1; j = 3 + idx; return true;
}
__device__ __forceinline__ void convert_set(const Args& a, LAS unsigned char* lds, int rank, int nrank, int set) {
    const int tid = ltid(), lane = tid & 63, wave = __builtin_amdgcn_readfirstlane(tid >> 6);
    LAS float* scr = (LAS float*)(lds + wave * 16384);
    const int gw = rank * NWAVES + wave, NGW = nrank * NWAVES;
    for (int idx = 0; idx < 5; ++idx) {
        int l, j; if (!cvt_set_job(set, idx, l, j)) break;
        const CvtJob jb = cvt_job(a, l, j);
        const int nblk = jb.N / 32, nit = (jb.K / 64) * nblk;
        for (int it = gw; it < nit; it += NGW) transpose_item(jb.W, jb.N, jb.WT, jb.KP, jb.koff, jb.mode, scr, it / nblk, it % nblk, lane);
    }
}
__device__ __forceinline__ void p0_convert(const Args& a, LAS unsigned char* lds, int vcu, int G) {
    const int tid = ltid(), lane = tid & 63, wave = __builtin_amdgcn_readfirstlane(tid >> 6);
    LAS float* scr = (LAS float*)(lds + wave * 16384);
    const int gw = vcu * NWAVES + wave, NGW = G * NWAVES;
    {
        constexpr int PER_LAYER = 57664;
#pragma unroll 1
        for (int g = gw; g < 2 * PER_LAYER; g += NGW) {
            const int l = g >= PER_LAYER ? 1 : 0, r = g - l * PER_LAYER;
            int base, inidx, K, N, KP, koff, mode; size_t lwo;
#define QJ(B, I, K_, N_, KP_, KO, MD, LW) { base = B; inidx = I; K = K_; N = N_; KP = KP_; koff = KO; mode = MD; lwo = LW; }
            if (r < 5504) QJ(0, 14, D, FF, D, 0, 1, LW_GU1) else if (r < 11008) QJ(5504, 15, D, FF, D, 0, 2, LW_GU1) else if (r < 16512) QJ(11008, 16, FF, D, FF, 0, 0, LW_D1)
            else if (r < 22016) QJ(16512, 17, D, FF, D, 0, 1, LW_GU2) else if (r < 27520) QJ(22016, 18, D, FF, D, 0, 2, LW_GU2) else if (r < 33024) QJ(27520, 19, FF, D, FF, 0, 0, LW_D2)
            else if (r < 51520) QJ(33024, 20, D, NIN, D, 0, 3, LW_IN)
            else if (r < 52544) QJ(51520, 34, 1024, D, 4096, 0, 0, LW_BR) else if (r < 53568) QJ(52544, 35, 1024, D, 4096, 1024, 0, LW_BR) else if (r < 55616) QJ(53568, 36, 2048, D, 4096, 2048, 0, LW_BR)
            else QJ(55616, 37, D, D, D, 0, 0, LW_OUT)
#undef QJ
            const float* W = nullptr;
#if defined(__HIP_DEVICE_COMPILE__)
            { const __attribute__((address_space(4))) Args* ap = (const __attribute__((address_space(4))) Args*)__builtin_amdgcn_kernarg_segment_ptr(); W = ap->in[inidx] + (size_t)l * K * N; }
#endif
            bf16_t* WT = (bf16_t*)(a.ws + WS_W + (size_t)l * LW_SIZE + lwo);
            const int nblk = N / 32, it = r - base;
            transpose_item(W, N, WT, KP, koff, mode, scr, it / nblk, it % nblk, lane);
        }
    }
    for (int l = 0; l < 2; ++l) {
        u32x4* p = (u32x4*)(a.ws + WS_W + (size_t)l * LW_SIZE + LW_IN + (size_t)NIN * D * 2);
        const int n16 = (NINP - NIN) * D * 2 / 16;
        for (int i = (vcu * NTHR + tid); i < n16; i += G * NTHR) p[i] = (u32x4){0u, 0u, 0u, 0u};
    }
    {
        const float* cp = a.in[7]; const float* cs = a.in[8]; unsigned* sc = (unsigned*)(a.ws + WS_SC);
        for (int i = vcu * NTHR + tid; i < 144 * D / 2; i += G * NTHR) {
            const int r = i / (D / 2), c2 = (i % (D / 2)) * 2; float v0 = 0.f, v1 = 0.f;
            if (r < NCR) { const float* src = r < NB ? cp + (size_t)r * D : cs + (size_t)(r - NB) * D; v0 = siluf_(src[c2]); v1 = siluf_(src[c2 + 1]); }
            sc[i] = pk2(v0, v1);
        }
    }
}

__device__ __forceinline__ void p1_mod(const Args& a, LAS unsigned char* lds, int vcu, int G) {
    const int tid = ltid(), lane = tid & 63, wave = __builtin_amdgcn_readfirstlane(tid >> 6), c16 = lane & 15, kq = lane >> 4;
    constexpr int NC = 144, BP = NC * 4, BSZ = 32 * BP, ASZ = 144 * 64, SLOT = BSZ + ASZ;
    const bf16_t* SC = (const bf16_t*)(a.ws + WS_SC);
    const int nunits = 2 * (NMOD / NC);
    for (int u = vcu; u < nunits; u += G) {
        const int l = u / (NMOD / NC), n0 = (u % (NMOD / NC)) * NC;
        const float* W = a.in[9] + (size_t)l * D * NMOD + n0;
        auto issue = [&](int ks) {
            LAS unsigned char* S = lds + (ks % 5) * SLOT;
#pragma unroll
            for (int i = 0; i < 4; ++i) {
                const int p = wave + 8 * i;
                if (p < 18) {
                    const int o = p * 1024 + 16 * lane, row = o / BP, cb = o - row * BP;
                    __builtin_amdgcn_global_load_lds((const unsigned*)((const char*)(W + (size_t)(ks * 32 + row) * NMOD) + cb), (LAS unsigned*)(S + p * 1024), 16, 0, 2);
                } else if (p < 27) {
                    const int q = p - 18;
                    __builtin_amdgcn_global_load_lds((const unsigned*)(SC + (size_t)(16 * q + (lane >> 2)) * D + ks * 32 + 8 * (lane & 3)), (LAS unsigned*)(S + BSZ + q * 1024), 16, 0, 0);
                }
            }
        };
        f32x4 acc[9][2];
#pragma unroll
        for (int t = 0; t < 9; ++t) { acc[t][0] = (f32x4){0.f, 0.f, 0.f, 0.f}; acc[t][1] = (f32x4){0.f, 0.f, 0.f, 0.f}; }
        __syncthreads();
        issue(0); issue(1); issue(2); issue(3);
#pragma unroll 1
        for (int ks = 0; ks < 64; ++ks) {
            if (ks + 3 < 64) { if (wave < 3) asm volatile("s_waitcnt vmcnt(12)" ::: "memory"); else asm volatile("s_waitcnt vmcnt(9)" ::: "memory"); }
            else if (ks + 2 < 64) { if (wave < 3) asm volatile("s_waitcnt vmcnt(8)" ::: "memory"); else asm volatile("s_waitcnt vmcnt(6)" ::: "memory"); }
            else if (ks + 1 < 64) { if (wave < 3) asm volatile("s_waitcnt vmcnt(4)" ::: "memory"); else asm volatile("s_waitcnt vmcnt(3)" ::: "memory"); }
            else asm volatile("s_waitcnt vmcnt(0)" ::: "memory");
            __builtin_amdgcn_s_barrier(); asm volatile("" ::: "memory");
            if (ks + 4 < 64) issue(ks + 4);
            const LAS unsigned char* S = lds + (ks % 5) * SLOT;
            bf16x8 bfr[2];
#pragma unroll
            for (int g = 0; g < 2; ++g) {
                const int ct = g == 0 ? wave : 8;
                const LAS float* bp = (const LAS float*)(S + (8 * kq) * BP) + 16 * ct + c16;
                float w[8];
#pragma unroll
                for (int j = 0; j < 8; ++j) w[j] = bp[j * (BP / 4)];
                u32x4 p; p.x = pk2(w[0], w[1]); p.y = pk2(w[2], w[3]); p.z = pk2(w[4], w[5]); p.w = pk2(w[6], w[7]);
                bfr[g] = __builtin_bit_cast(bf16x8, p);
            }
#pragma unroll
            for (int t = 0; t < 9; ++t) {
                const bf16x8 af = *(const LAS bf16x8*)(S + BSZ + (16 * t + c16) * 64 + kq * 16);
                acc[t][0] = __builtin_amdgcn_mfma_f32_16x16x32_bf16(af, bfr[0], acc[t][0], 0, 0, 0);
                if (wave == 0) acc[t][1] = __builtin_amdgcn_mfma_f32_16x16x32_bf16(af, bfr[1], acc[t][1], 0, 0, 0);
            }
        }
        const float* bias = a.in[10] + (size_t)l * NMOD + n0;
        float* mod = (float*)(a.ws + WS_MOD) + (size_t)l * NCR * NMOD + n0;
        const float b0 = bias[16 * wave + c16], b1 = bias[128 + c16];
#pragma unroll
        for (int t = 0; t < 9; ++t)
#pragma unroll
            for (int j = 0; j < 4; ++j) { const int r = 16 * t + 4 * kq + j;
                if (r < NCR) { mod[(size_t)r * NMOD + 16 * wave + c16] = acc[t][0][j] + b0; if (wave == 0) mod[(size_t)r * NMOD + 128 + c16] = acc[t][1][j] + b1; } }
    }
    __syncthreads();
}

__device__ __forceinline__ void xb_load8(const bf16_t* p, f32x4& lo, f32x4& hi) { const u32x4 w = *(const u32x4*)p; lo = (f32x4){bflo(w.x), bfhi(w.x), bflo(w.y), bfhi(w.y)}; hi = (f32x4){bflo(w.z), bfhi(w.z), bflo(w.w), bfhi(w.w)}; }
__device__ __forceinline__ void xb_store8(bf16_t* p, const f32x4 lo, const f32x4 hi) { u32x4 w; w.x = pk2(lo.x, lo.y); w.y = pk2(lo.z, lo.w); w.z = pk2(hi.x, hi.y); w.w = pk2(hi.z, hi.w); *(u32x4*)p = w; }
__device__ __forceinline__ int cond_row(int m) { return m < NPT ? (m >> 11) : NB + (m - NPT); }
template <bool FINAL>
__device__ __forceinline__ void sample_rows_norm(const Args& a, LAS unsigned char* lds, int vcu, int G, const float* nw, const float* mr0  , bool first,
                                                 int nch, const float* gate  , float scale) {
    const int tid = ltid(), lane = tid & 63, wave = __builtin_amdgcn_readfirstlane(tid >> 6);
    float* X = (float*)(a.ws + WS_X); bf16_t* H = (bf16_t*)(a.ws + WS_H); const float* PART = (const float*)(a.ws + WS_PART);
    LAS float* red = (LAS float*)lds;
    int v0 = vcu; asm volatile("" : "+s"(v0));
#pragma unroll 1
    for (int s = v0; s < NS; s += G) {
        const int m = NPT + s, c = 4 * tid;
        f32x4 x = first ? *(const f32x4*)(a.in[1] + (size_t)s * D + c) : *(const f32x4*)(X + (size_t)m * D + c);
        if (nch > 0) {
            f32x4 acc = (f32x4){0.f, 0.f, 0.f, 0.f};
#pragma unroll 7
            for (int ch = 0; ch < nch; ++ch) acc = acc + *(const f32x4*)(PART + ((size_t)ch * NS + s) * D + c);
            x = x + *(const f32x4*)(gate + (size_t)(NB + s) * NMOD + c) * scale * acc;
        }
        if (!FINAL) *(f32x4*)(X + (size_t)m * D + c) = x;
        float ss = (x.x * x.x + x.y * x.y) + (x.z * x.z + x.w * x.w);
        ss = wave_sum(ss);
        if (lane == 0) red[wave] = ss;
        __syncthreads();
        float tot = 0.f;
#pragma unroll
        for (int w = 0; w < NWAVES; ++w) tot += red[w];
        __syncthreads();
        const float rstd = 1.0f / sqrtf(tot * (1.f / D) + EPS);
        const f32x4 w4 = *(const f32x4*)(nw + c);
        if (FINAL) *(f32x4*)(a.out + (size_t)m * D + c) = x * rstd * w4;
        else {
            const float* mr = mr0 + (size_t)(NB + s) * NMOD;
            const f32x4 sh = *(const f32x4*)(mr + c), sc = *(const f32x4*)(mr + D + c);
            const f32x4 y = x * rstd * w4 * (sc + 1.0f) + sh;
            u32x2 o; o.x = pk2(y.x, y.y); o.y = pk2(y.z, y.w); *(u32x2*)(H + (size_t)m * D + c) = o;
        }
    }
}
__device__ __forceinline__ void norm_mod_phase(const Args& a, LAS unsigned char* lds, int vcu, int G, int layer, int which  , bool first, int nch, const float* gate, float scale) {
    const int tid = ltid(), lane = tid & 63, wave = __builtin_amdgcn_readfirstlane(tid >> 6);
    const int gw = vcu * NWAVES + wave, NGW = G * NWAVES;
    float* X = (float*)(a.ws + WS_X); bf16_t* H = (bf16_t*)(a.ws + WS_H);
    const float* nw = a.in[11 + which] + (size_t)layer * D;
    const float* modl = (const float*)(a.ws + WS_MOD) + (size_t)layer * NCR * NMOD;
    sample_rows_norm<false>(a, lds, vcu, G, nw, modl + (size_t)(3 * which) * D, first, nch, gate, scale);
    if (!first) {
        for (int m = MT + gw; m < MP; m += NGW) { u32x4* hrow = (u32x4*)(H + (size_t)m * D);
#pragma unroll
            for (int j = 0; j < 4; ++j) hrow[64 * j + lane] = (u32x4){0u, 0u, 0u, 0u}; }
        const bf16_t* XB = (const bf16_t*)X;
        u32x4 cur[4], nxt[4];
        int m = gw;
        if (m < NPT) {
#pragma unroll
            for (int j = 0; j < 4; ++j) cur[j] = *(const u32x4*)(XB + (size_t)m * D + 512 * j + 8 * lane); }
#pragma unroll 1
        while (m < NPT) {
            const int mn = m + NGW;
#pragma unroll
            for (int j = 0; j < 4; ++j) nxt[j] = cur[j];
            if (mn < NPT) {
#pragma unroll
                for (int j = 0; j < 4; ++j) nxt[j] = *(const u32x4*)(XB + (size_t)mn * D + 512 * j + 8 * lane); }
            f32x4 v[8]; float s = 0.f;
#pragma unroll
            for (int j = 0; j < 4; ++j) { const u32x4 w = cur[j];
                v[2 * j] = (f32x4){bflo(w.x), bfhi(w.x), bflo(w.y), bfhi(w.y)}; v[2 * j + 1] = (f32x4){bflo(w.z), bfhi(w.z), bflo(w.w), bfhi(w.w)};
                s += (v[2 * j].x * v[2 * j].x + v[2 * j].y * v[2 * j].y) + (v[2 * j].z * v[2 * j].z + v[2 * j].w * v[2 * j].w);
                s += (v[2 * j + 1].x * v[2 * j + 1].x + v[2 * j + 1].y * v[2 * j + 1].y) + (v[2 * j + 1].z * v[2 * j + 1].z + v[2 * j + 1].w * v[2 * j + 1].w); }
            const float rstd = 1.0f / sqrtf(wave_sum(s) * (1.f / D) + EPS);
            const float* mr = modl + (size_t)cond_row(m) * NMOD + (size_t)(3 * which) * D;
            u32x4* hrow = (u32x4*)(H + (size_t)m * D);
#pragma unroll
            for (int j = 0; j < 4; ++j) {
                const int c = 512 * j + 8 * lane;
                const f32x4 w0 = *(const f32x4*)(nw + c), w1 = *(const f32x4*)(nw + c + 4);
                const f32x4 sh0 = *(const f32x4*)(mr + c), sh1 = *(const f32x4*)(mr + c + 4);
                const f32x4 sc0 = *(const f32x4*)(mr + D + c), sc1 = *(const f32x4*)(mr + D + c + 4);
                const f32x4 y0 = v[2 * j] * rstd * w0 * (sc0 + 1.0f) + sh0, y1 = v[2 * j + 1] * rstd * w1 * (sc1 + 1.0f) + sh1;
                u32x4 o; o.x = pk2(y0.x, y0.y); o.y = pk2(y0.z, y0.w); o.z = pk2(y1.x, y1.y); o.w = pk2(y1.z, y1.w);
                hrow[64 * j + lane] = o;
            }
#pragma unroll
            for (int j = 0; j < 4; ++j) cur[j] = nxt[j];
            m = mn;
        }
        return;
    }
    for (int m = gw; m < MP; m += NGW) {
        u32x4* hrow = (u32x4*)(H + (size_t)m * D);
        if (m >= NPT) {
            if (m >= MT) {
#pragma unroll
                for (int j = 0; j < 4; ++j) hrow[64 * j + lane] = (u32x4){0u, 0u, 0u, 0u};
            }
            continue;
        }
        const float* xr = a.in[0] + (size_t)m * D; bf16_t* xb = (bf16_t*)X + (size_t)m * D;
        f32x4 v[8]; float s = 0.f;
#pragma unroll
        for (int j = 0; j < 4; ++j) {
            if (first) { v[2 * j] = *(const f32x4*)(xr + 512 * j + 8 * lane); v[2 * j + 1] = *(const f32x4*)(xr + 512 * j + 8 * lane + 4); }
            else xb_load8(xb + 512 * j + 8 * lane, v[2 * j], v[2 * j + 1]);
            s += (v[2 * j].x * v[2 * j].x + v[2 * j].y * v[2 * j].y) + (v[2 * j].z * v[2 * j].z + v[2 * j].w * v[2 * j].w);
            s += (v[2 * j + 1].x * v[2 * j + 1].x + v[2 * j + 1].y * v[2 * j + 1].y) + (v[2 * j + 1].z * v[2 * j + 1].z + v[2 * j + 1].w * v[2 * j + 1].w);
        }
        if (first) {
#pragma unroll
            for (int j = 0; j < 4; ++j) xb_store8(xb + 512 * j + 8 * lane, v[2 * j], v[2 * j + 1]);
        }
        const float rstd = 1.0f / sqrtf(wave_sum(s) * (1.f / D) + EPS);
        const float* mr = modl + (size_t)cond_row(m) * NMOD + (size_t)(3 * which) * D;
#pragma unroll
        for (int j = 0; j < 4; ++j) {
            const int c = 512 * j + 8 * lane;
            const f32x4 w0 = *(const f32x4*)(nw + c), w1 = *(const f32x4*)(nw + c + 4);
            const f32x4 sh0 = *(const f32x4*)(mr + c), sh1 = *(const f32x4*)(mr + c + 4);
            const f32x4 sc0 = *(const f32x4*)(mr + D + c), sc1 = *(const f32x4*)(mr + D + c + 4);
            const f32x4 y0 = v[2 * j] * rstd * w0 * (sc0 + 1.0f) + sh0, y1 = v[2 * j + 1] * rstd * w1 * (sc1 + 1.0f) + sh1;
            u32x4 o; o.x = pk2(y0.x, y0.y); o.y = pk2(y0.z, y0.w); o.z = pk2(y1.x, y1.y); o.w = pk2(y1.z, y1.w);
            hrow[64 * j + lane] = o;
        }
    }
}
__device__ __forceinline__ void final_norm_phase(const Args& a, LAS unsigned char* lds, int vcu, int G, int nch, const float* gate, float scale) {
    const int tid = ltid(), lane = tid & 63, wave = __builtin_amdgcn_readfirstlane(tid >> 6);
    const int gw = vcu * NWAVES + wave, NGW = G * NWAVES;
    const float* X = (const float*)(a.ws + WS_X); const float* nw = a.in[38];
    sample_rows_norm<true>(a, lds, vcu, G, nw, nullptr, false, nch, gate, scale);
    for (int m = gw; m < NPT; m += NGW) {
        const bf16_t* xb = (const bf16_t*)X + (size_t)m * D; float* yo = a.out + (size_t)m * D;
        f32x4 v[8]; float s = 0.f;
#pragma unroll
        for (int j = 0; j < 4; ++j) { xb_load8(xb + 512 * j + 8 * lane, v[2 * j], v[2 * j + 1]);
            s += (v[2 * j].x * v[2 * j].x + v[2 * j].y * v[2 * j].y) + (v[2 * j].z * v[2 * j].z + v[2 * j].w * v[2 * j].w);
            s += (v[2 * j + 1].x * v[2 * j + 1].x + v[2 * j + 1].y * v[2 * j + 1].y) + (v[2 * j + 1].z * v[2 * j + 1].z + v[2 * j + 1].w * v[2 * j + 1].w); }
        const float rstd = 1.0f / sqrtf(wave_sum(s) * (1.f / D) + EPS);
#pragma unroll
        for (int j = 0; j < 4; ++j) { const int c = 512 * j + 8 * lane; const f32x4 w0 = *(const f32x4*)(nw + c), w1 = *(const f32x4*)(nw + c + 4);
            *(f32x4*)(yo + c) = v[2 * j] * rstd * w0; *(f32x4*)(yo + c + 4) = v[2 * j + 1] * rstd * w1; }
    }
}

using pg8::Unit;
__device__ __forceinline__ void unpack8(const u32x4 w, float (&f)[8]) { f[0] = bflo(w.x); f[1] = bfhi(w.x); f[2] = bflo(w.y); f[3] = bfhi(w.y); f[4] = bflo(w.z); f[5] = bfhi(w.z); f[6] = bflo(w.w); f[7] = bfhi(w.w); }
struct EpiSwiglu {
    static constexpr bool PERM = true;
    bf16_t* ACT;
    __device__ __forceinline__ void operator()(const f32x4 (&acc)[2][2][4][2], const Unit& u, int wr, int wc, int fr, int fq) const {
        const int row0 = u.pm * 256 + wr * 64 + fr, f0 = u.pn * 128 + wc * 32 + 8 * fq;
#pragma unroll
        for (int ai = 0; ai < 2; ++ai)
#pragma unroll
            for (int m = 0; m < 4; ++m) {
                const f32x4 g0 = acc[ai][0][m][0], g1 = acc[ai][0][m][1], u0 = acc[ai][1][m][0], u1 = acc[ai][1][m][1];
                float o[8];
#pragma unroll
                for (int j = 0; j < 4; ++j) { o[j] = siluf_(g0[j]) * u0[j]; o[4 + j] = siluf_(g1[j]) * u1[j]; }
                u32x4 w; w.x = pg8::cvt_pk_bf16(o[0], o[1]); w.y = pg8::cvt_pk_bf16(o[2], o[3]); w.z = pg8::cvt_pk_bf16(o[4], o[5]); w.w = pg8::cvt_pk_bf16(o[6], o[7]);
                *(u32x4*)(ACT + (size_t)(row0 + ai * 128 + m * 16) * FF + f0) = w;
            }
    }
};
struct EpiResid {
    static constexpr bool PERM = true;
    float* X; const float* gate; float scale; float* PART;
    __device__ __forceinline__ void operator()(const f32x4 (&acc)[2][2][4][2], const Unit& u, int wr, int wc, int fr, int fq) const {
        const int col0 = u.pn * 256 + wc * 32 + 8 * fq;
        if (u.seg == 0) {
            const int row0 = u.pm * 256 + wr * 64 + fr;
            const float* gr = gate + (size_t)(u.pm >> 3) * NMOD + col0;
            f32x4 gv[2][2];
#pragma unroll
            for (int bj = 0; bj < 2; ++bj)
#pragma unroll
                for (int n = 0; n < 2; ++n) gv[bj][n] = *(const f32x4*)(gr + bj * 128 + n * 4) * scale;
#pragma unroll
            for (int ai = 0; ai < 2; ++ai) {
                bf16_t* rowp = (bf16_t*)X + (size_t)(row0 + ai * 128) * D + col0;
                u32x4 xv[4][2];
#pragma unroll
                for (int m = 0; m < 4; ++m)
#pragma unroll
                    for (int bj = 0; bj < 2; ++bj) xv[m][bj] = *(const u32x4*)(rowp + (size_t)(m * 16) * D + bj * 128);
#pragma unroll
                for (int m = 0; m < 4; ++m)
#pragma unroll
                    for (int bj = 0; bj < 2; ++bj) { const u32x4 w = xv[m][bj];
                        const f32x4 lo = (f32x4){bflo(w.x), bfhi(w.x), bflo(w.y), bfhi(w.y)}, hi = (f32x4){bflo(w.z), bfhi(w.z), bflo(w.w), bfhi(w.w)};
                        xb_store8(rowp + (size_t)(m * 16) * D + bj * 128, lo + gv[bj][0] * acc[ai][bj][m][0], hi + gv[bj][1] * acc[ai][bj][m][1]); }
                asm volatile("" ::: "memory");
            }
        } else {
            float* pp = PART + ((size_t)(u.k0 >> 8) * NS + wr * 64 + fr) * D + col0;
#pragma unroll
            for (int m = 0; m < 4; ++m)
#pragma unroll
                for (int bj = 0; bj < 2; ++bj)
#pragma unroll
                    for (int n = 0; n < 2; ++n) *(f32x4*)(pp + (size_t)(m * 16) * D + bj * 128 + n * 4) = acc[0][bj][m][n];
        }
    }
};
struct EpiWin {
    static constexpr bool PERM = true;
    bf16_t* PROJ; float* SMALL;
    __device__ __forceinline__ void operator()(const f32x4 (&acc)[2][2][4][2], const Unit& u, int wr, int wc, int fr, int fq) const {
        const int row0 = u.pm * 256 + wr * 64 + fr;
        if (u.pn < PW / 256) {
            const int col0 = u.pn * 256 + wc * 32 + 8 * fq;
#pragma unroll
            for (int ai = 0; ai < 2; ++ai)
#pragma unroll
                for (int m = 0; m < 4; ++m) { bf16_t* rowp = PROJ + (size_t)(row0 + ai * 128 + m * 16) * PW + col0;
#pragma unroll
                    for (int bj = 0; bj < 2; ++bj) { const f32x4 v0 = acc[ai][bj][m][0], v1 = acc[ai][bj][m][1];
                        u32x4 w; w.x = pg8::cvt_pk_bf16(v0[0], v0[1]); w.y = pg8::cvt_pk_bf16(v0[2], v0[3]); w.z = pg8::cvt_pk_bf16(v1[0], v1[1]); w.w = pg8::cvt_pk_bf16(v1[2], v1[3]);
                        *(u32x4*)(rowp + bj * 128) = w; } }
        } else if (wc < 2) {
            const int col0 = wc * 32 + 8 * fq;
#pragma unroll
            for (int ai = 0; ai < 2; ++ai)
#pragma unroll
                for (int m = 0; m < 4; ++m) { float* rowp = SMALL + (size_t)(row0 + ai * 128 + m * 16) * SW + col0;
                    *(f32x4*)(rowp) = acc[ai][0][m][0]; *(f32x4*)(rowp + 4) = acc[ai][0][m][1]; }
        }
    }
};
struct EpiBranch {
    static constexpr bool PERM = true;
    float* MRG; bf16_t* MRGB; const bf16_t* PROJ;
    __device__ __forceinline__ void operator()(const f32x4 (&acc)[2][2][4][2], const Unit& u, int wr, int wc, int fr, int fq) const {
        const int row0 = u.pm * 256 + wr * 64 + fr, col0 = u.pn * 256 + wc * 32 + 8 * fq;
#pragma unroll
        for (int ai = 0; ai < 2; ++ai) {
            u32x4 gwv[4][2], pv[4][2];
#pragma unroll
            for (int m = 0; m < 4; ++m) { const size_t r = (size_t)(row0 + ai * 128 + m * 16);
#pragma unroll
                for (int bj = 0; bj < 2; ++bj) { const int c = col0 + bj * 128;
                    gwv[m][bj] = *(const u32x4*)(PROJ + r * PW + P_GATES + u.seg * D + c);
                    pv[m][bj] = (u32x4){0u, 0u, 0u, 0u};
                    if (u.seg > 0) pv[m][bj] = *(const u32x4*)(MRGB + r * D + c); } }
#pragma unroll
            for (int m = 0; m < 4; ++m) { const size_t r = (size_t)(row0 + ai * 128 + m * 16);
#pragma unroll
                for (int bj = 0; bj < 2; ++bj) { const int c = col0 + bj * 128;
                    float g[8], p[8]; unpack8(gwv[m][bj], g); unpack8(pv[m][bj], p);
                    f32x4 v0, v1;
#pragma unroll
                    for (int j = 0; j < 4; ++j) { v0[j] = sigmoidf_(g[j]) * acc[ai][bj][m][0][j] + p[j]; v1[j] = sigmoidf_(g[4 + j]) * acc[ai][bj][m][1][j] + p[4 + j]; }
                    u32x4 w; w.x = pg8::cvt_pk_bf16(v0[0], v0[1]); w.y = pg8::cvt_pk_bf16(v0[2], v0[3]); w.z = pg8::cvt_pk_bf16(v1[0], v1[1]); w.w = pg8::cvt_pk_bf16(v1[2], v1[3]);
                    *(u32x4*)(MRGB + r * D + c) = w; } }
            asm volatile("" ::: "memory"); }
    }
};

__device__ __forceinline__ void skinny_gemm(const Args& a, LAS unsigned char* lds, int vcu, int G, const bf16_t* A, int lda, const bf16_t* Bt, int ldb, int nseg, int klen0, int klen1, int klen2,
                                            int mode, float* X, const float* gate, float scale, bf16_t* MRGB, const bf16_t* PROJ) {
    const int tid = ltid(), lane = tid & 63, wave = __builtin_amdgcn_readfirstlane(tid >> 6), c16 = lane & 15, kq = lane >> 4;
    LAS float* red = (LAS float*)lds;
    for (int w = vcu; w < 256; w += G) {
        const int n0 = 16 * (w >> 1), r0 = NPT + 64 * (w & 1);
        float gsum[4] = {0.f, 0.f, 0.f, 0.f};
        int kbase = 0;
        for (int sg = 0; sg < nseg; ++sg) {
            const int klen = sg == 0 ? klen0 : (sg == 1 ? klen1 : klen2);
            f32x4 acc[4];
#pragma unroll
            for (int t = 0; t < 4; ++t) acc[t] = (f32x4){0.f, 0.f, 0.f, 0.f};
            const int nks = klen / 32;
            const bf16_t* bp = Bt + (size_t)(n0 + c16) * ldb + kbase + 8 * kq;
            const bf16_t* ap = A + (size_t)(r0 + c16) * lda + kbase + 8 * kq;
            const int nblk = (nks + 3) >> 2;
#pragma unroll 1
            for (int blk = wave; blk < nblk; blk += NWAVES) {
                bf16x8 bq[4], aq[4][4];
#pragma unroll
                for (int q = 0; q < 4; ++q) {
                    const int kk = blk * 4 + q, k0 = (kk < nks ? kk : 0) * 32;
                    bq[q] = *(const bf16x8*)(bp + k0);
#pragma unroll
                    for (int t = 0; t < 4; ++t) aq[q][t] = *(const bf16x8*)(ap + (size_t)(16 * t) * lda + k0);
                }
#pragma unroll
                for (int q = 0; q < 4; ++q) {
                    if (blk * 4 + q < nks) {
#pragma unroll
                        for (int t = 0; t < 4; ++t) acc[t] = __builtin_amdgcn_mfma_f32_16x16x32_bf16(bq[q], aq[q][t], acc[t], 0, 0, 0);
                    }
                }
            }
#pragma unroll
            for (int t = 0; t < 4; ++t) *(LAS f32x4*)(red + ((wave * 64 + 16 * t + c16) * 16 + 4 * kq)) = acc[t];
            __syncthreads();
            if (tid < 256) {
                const int r = tid >> 2, c4 = (tid & 3) * 4;
                f32x4 s = (f32x4){0.f, 0.f, 0.f, 0.f};
#pragma unroll
                for (int wv = 0; wv < 8; ++wv) s = s + *(const LAS f32x4*)(red + ((wv * 64 + r) * 16 + c4));
                if (mode == 1) {
                    const u32x2 gw = *(const u32x2*)(PROJ + (size_t)(r0 + r) * PW + P_GATES + sg * D + n0 + c4);
                    gsum[0] += sigmoidf_(bflo(gw.x)) * s.x; gsum[1] += sigmoidf_(bfhi(gw.x)) * s.y; gsum[2] += sigmoidf_(bflo(gw.y)) * s.z; gsum[3] += sigmoidf_(bfhi(gw.y)) * s.w;
                } else { gsum[0] += s.x; gsum[1] += s.y; gsum[2] += s.z; gsum[3] += s.w; }
            }
            __syncthreads();
            kbase += klen;
        }
        if (tid < 256) {
            const int r = r0 + (tid >> 2), c = n0 + (tid & 3) * 4;
            if (mode == 0) {
                const f32x4 gv = *(const f32x4*)(gate + (size_t)cond_row(r) * NMOD + c) * scale;
                f32x4* p = (f32x4*)(X + (size_t)r * D + c);
                *p = *p + gv * (f32x4){gsum[0], gsum[1], gsum[2], gsum[3]};
            } else {
                u32x2 o; o.x = pk2(gsum[0], gsum[1]); o.y = pk2(gsum[2], gsum[3]); *(u32x2*)(MRGB + (size_t)r * D + c) = o;
            }
        }
    }
}

__device__ __forceinline__ void skinny_branch(LAS unsigned char* lds, int vcu, int G, const bf16_t* A, const bf16_t* Bt, bf16_t* MRGB, const bf16_t* PROJ) {
    const int tid = ltid(), lane = tid & 63, wave = __builtin_amdgcn_readfirstlane(tid >> 6), c16 = lane & 15, kq = lane >> 4;
    LAS float* red = (LAS float*)lds;
#pragma unroll 1
    for (int w = vcu; w < 256; w += G) {
        const int n0 = 16 * (w >> 1), r0 = NPT + 64 * (w & 1);
        const bf16_t* bp = Bt + (size_t)(n0 + c16) * 4096 + 8 * kq;
        const bf16_t* ap = A + (size_t)(r0 + c16) * 4096 + 8 * kq;
        f32x4 acc[3][4];
#pragma unroll
        for (int sg = 0; sg < 3; ++sg)
#pragma unroll
            for (int t = 0; t < 4; ++t) acc[sg][t] = (f32x4){0.f, 0.f, 0.f, 0.f};
#pragma unroll
        for (int b = 0; b < 4; ++b) {
            const int sg = b < 2 ? b : 2, kb = (wave + 8 * b) * 128;
            bf16x8 bq[4], aq[4][4];
#pragma unroll
            for (int q = 0; q < 4; ++q) {
                bq[q] = *(const bf16x8*)(bp + kb + 32 * q);
#pragma unroll
                for (int t = 0; t < 4; ++t) aq[q][t] = *(const bf16x8*)(ap + (size_t)(16 * t) * 4096 + kb + 32 * q);
            }
#pragma unroll
            for (int q = 0; q < 4; ++q)
#pragma unroll
                for (int t = 0; t < 4; ++t) acc[sg][t] = __builtin_amdgcn_mfma_f32_16x16x32_bf16(bq[q], aq[q][t], acc[sg][t], 0, 0, 0);
        }
#pragma unroll
        for (int sg = 0; sg < 3; ++sg)
#pragma unroll
            for (int t = 0; t < 4; ++t) *(LAS f32x4*)(red + (((sg * 8 + wave) * 64 + 16 * t + c16) * 16 + 4 * kq)) = acc[sg][t];
        __syncthreads();
        if (tid < 256) {
            const int r = tid >> 2, c4 = (tid & 3) * 4;
            float gsum[4] = {0.f, 0.f, 0.f, 0.f};
            u32x2 gw[3];
#pragma unroll
            for (int sg = 0; sg < 3; ++sg) gw[sg] = *(const u32x2*)(PROJ + (size_t)(r0 + r) * PW + P_GATES + sg * D + n0 + c4);
#pragma unroll
            for (int sg = 0; sg < 3; ++sg) {
                f32x4 s = (f32x4){0.f, 0.f, 0.f, 0.f};
#pragma unroll
                for (int wv = 0; wv < 8; ++wv) s = s + *(const LAS f32x4*)(red + (((sg * 8 + wv) * 64 + r) * 16 + c4));
                gsum[0] += sigmoidf_(bflo(gw[sg].x)) * s.x; gsum[1] += sigmoidf_(bfhi(gw[sg].x)) * s.y; gsum[2] += sigmoidf_(bflo(gw[sg].y)) * s.z; gsum[3] += sigmoidf_(bfhi(gw[sg].y)) * s.w;
            }
            u32x2 o; o.x = pk2(gsum[0], gsum[1]); o.y = pk2(gsum[2], gsum[3]); *(u32x2*)(MRGB + (size_t)(r0 + r) * D + n0 + c4) = o;
        }
        __syncthreads();
    }
}

constexpr size_t WS_GQKV = WS_MIX;
constexpr size_t WS_GB = WS_GQKV + al((size_t)MP * 3072 * 2);
constexpr size_t WS_LA = WS_GB + al((size_t)MP * 16 * 4);
constexpr size_t WS_XBC = WS_LA + al((size_t)MP * 512 * 4);
constexpr size_t WS_DT = WS_XBC + al((size_t)MP * 3072 * 2);
constexpr int NGU = NB * NCHUNK * 8, NLU = NB * NCHUNK * 4, NSU = NB * NCHUNK * 32, NSG = NB * NCHUNK * 4;
constexpr size_t WS_G_WK = WS_DT + al((size_t)MP * 32 * 4);
constexpr size_t WS_G_QD = WS_G_WK + al((size_t)NGU * 8192 * 2);
constexpr size_t WS_G_KDT = WS_G_QD + al((size_t)NGU * 8192 * 2);
constexpr size_t WS_G_QKD = WS_G_KDT + al((size_t)NGU * 8192 * 2);
constexpr size_t WS_G_UT = WS_G_QKD + al((size_t)NGU * 4096 * 2);
constexpr size_t WS_G_EGL = WS_G_UT + al((size_t)NGU * 8192 * 4);
constexpr size_t WS_L_QB = WS_G_EGL + al((size_t)NGU * 4);
constexpr size_t WS_L_ATT = WS_L_QB + al((size_t)NLU * 8192 * 2);
constexpr size_t WS_L_KDT = WS_L_ATT + al((size_t)NLU * 4096 * 2);
constexpr size_t WS_L_VT = WS_L_KDT + al((size_t)NLU * 8192 * 2);
constexpr size_t WS_L_EBL = WS_L_VT + al((size_t)NLU * 16384 * 2);
constexpr size_t WS_S_MH = WS_L_EBL + al((size_t)NLU * 128 * 4);
constexpr size_t WS_S_XDTT = WS_S_MH + al((size_t)NSU * 4096 * 2);
constexpr size_t WS_S_XDT2T = WS_S_XDTT + al((size_t)NSU * 4096 * 2);
constexpr size_t WS_S_EA = WS_S_XDT2T + al((size_t)NSU * 4096 * 2);
constexpr size_t WS_S_EAL = WS_S_EA + al((size_t)NSU * 64 * 4);
constexpr size_t WS_S_BT = WS_S_EAL + al((size_t)NSU * 64 * 4);
constexpr size_t WS_OA = WS_S_BT + al((size_t)NSG * 8192 * 2);
constexpr size_t WS_OB = WS_OA + al((size_t)MP * 1024 * 2);
constexpr size_t WS_YC = WS_OB + al((size_t)MP * 1024 * 2);
constexpr size_t WS_END = WS_YC + al((size_t)MP * 2048 * 2);

constexpr size_t O_YP = 0, O_YS = O_YP + (size_t)NPT * D, O_PGC = O_YS + (size_t)NS * D, O_PG = O_PGC + (size_t)2 * NB * 3 * 3072, O_PL = O_PG + (size_t)2 * NB * 8 * 16384,
                 O_PSC = O_PL + (size_t)2 * NB * 4 * 32768, O_PS = O_PSC + (size_t)2 * NB * 3 * 3072, O_SGC = O_PS + (size_t)2 * NB * 32 * 8192, O_SG = O_SGC + (size_t)2 * NS * 3 * 3072,
                 O_SL = O_SG + (size_t)2 * NS * 8 * 16384, O_SSC = O_SL + (size_t)2 * NS * 4 * 32768, O_SS = O_SSC + (size_t)2 * NS * 3 * 3072, O_END = O_SS + (size_t)2 * NS * 32 * 8192;

__device__ __forceinline__ u32x4 pack8(const float (&f)[8]) { u32x4 w; w.x = pk2(f[0], f[1]); w.y = pk2(f[2], f[3]); w.z = pk2(f[4], f[5]); w.w = pk2(f[6], f[7]); return w; }

__device__ __forceinline__ void store8f(float* p, const float (&f)[8]) { *(f32x4*)p = (f32x4){f[0], f[1], f[2], f[3]}; *(f32x4*)(p + 4) = (f32x4){f[4], f[5], f[6], f[7]}; }
__device__ __forceinline__ void load8f(const float* p, float (&f)[8]) { const f32x4 a = *(const f32x4*)p, b = *(const f32x4*)(p + 4); f[0] = a.x; f[1] = a.y; f[2] = a.z; f[3] = a.w; f[4] = b.x; f[5] = b.y; f[6] = b.z; f[7] = b.w; }
template <int KIND  >
__device__ __forceinline__ u32x4 conv_out(const float (&w)[4][8], const float (&bias)[8], const float (&p3)[8], const float (&p2)[8], const float (&p1)[8], const float (&raw)[8]) {
    f32x2 y[4]; f32x2 ssv = {0.f, 0.f};
#pragma unroll
    for (int i = 0; i < 4; ++i) {
        const f32x2 a3 = {p3[2 * i], p3[2 * i + 1]}, a2 = {p2[2 * i], p2[2 * i + 1]}, a1 = {p1[2 * i], p1[2 * i + 1]}, a0 = {raw[2 * i], raw[2 * i + 1]};
        const f32x2 w0 = {w[0][2 * i], w[0][2 * i + 1]}, w1 = {w[1][2 * i], w[1][2 * i + 1]}, w2 = {w[2][2 * i], w[2][2 * i + 1]}, w3 = {w[3][2 * i], w[3][2 * i + 1]};
        f32x2 v = a3 * w0; v = a2 * w1 + v; v = a1 * w2 + v; v = a0 * w3 + v;
        if (KIND == 3) { const f32x2 bb = {bias[2 * i], bias[2 * i + 1]}; v = v + bb; }
        const f32x2 t = v * (-1.4426950408889634f);
        f32x2 d; d.x = __builtin_amdgcn_exp2f(t.x); d.y = __builtin_amdgcn_exp2f(t.y); d = d + 1.0f;
        f32x2 r; r.x = __builtin_amdgcn_rcpf(d.x); r.y = __builtin_amdgcn_rcpf(d.y);
        v = v * r; y[i] = v; ssv = v * v + ssv;
    }
    if (KIND < 2) {
        float ss = ssv.x + ssv.y;
        ss += __shfl_xor(ss, 1); ss += __shfl_xor(ss, 2); ss += __shfl_xor(ss, 4); ss += __shfl_xor(ss, 8);
        const float rn = __builtin_amdgcn_rsqf(ss + EPS) * (KIND == 0 ? 0.08838834764831845f : 1.0f);
#pragma unroll
        for (int i = 0; i < 4; ++i) y[i] = y[i] * rn;
    }
    u32x4 o; o.x = pk2(y[0].x, y[0].y); o.y = pk2(y[1].x, y[1].y); o.z = pk2(y[2].x, y[2].y); o.w = pk2(y[3].x, y[3].y);
    return o;
}
constexpr int M1_T = 32;
template <int KIND, int T>
__device__ __forceinline__ void m1_strip(const Args& a, int layer, int slab  , int m0  , int lane) {
    constexpr bool SSD = (KIND == 3);
    const bf16_t* PROJ = (const bf16_t*)(a.ws + WS_PROJ) + (SSD ? P_XBC : P_QKVA);
    bf16_t* OUT = (bf16_t*)(a.ws + (SSD ? WS_XBC : WS_GQKV));
    const float* cw = (SSD ? a.in[28] : a.in[21]) + (size_t)layer * 4 * 3072;
    const int ch = slab * 512 + lane * 8;
    float w[4][8], bias[8];
#pragma unroll
    for (int j = 0; j < 4; ++j) load8f(cw + j * 3072 + ch, w[j]);
    if (SSD) load8f(a.in[29] + (size_t)layer * 3072 + ch, bias); else { for (int i = 0; i < 8; ++i) bias[i] = 0.f; }
    const int t0 = m0 & (SEQ - 1), b = m0 >> 11;
    float p1[8], p2[8], p3[8], raw[8];
    if (t0 == 0) { for (int i = 0; i < 8; ++i) { p1[i] = 0.f; p2[i] = 0.f; p3[i] = 0.f; } }
    else { unpack8(*(const u32x4*)(PROJ + (size_t)(m0 - 1) * PW + ch), p1); unpack8(*(const u32x4*)(PROJ + (size_t)(m0 - 2) * PW + ch), p2); unpack8(*(const u32x4*)(PROJ + (size_t)(m0 - 3) * PW + ch), p3); }
    float* cso = a.out + (SSD ? O_PSC : O_PGC) + ((size_t)layer * NB + b) * 3 * 3072 + ch;
    u32x4 rw[8], rn[8];
#pragma unroll
    for (int j = 0; j < 8; ++j) rw[j] = *(const u32x4*)(PROJ + (size_t)(m0 + j) * PW + ch);
#pragma unroll
    for (int tg = 0; tg < T; tg += 8) {
        if (tg + 8 < T) {
#pragma unroll
            for (int j = 0; j < 8; ++j) rn[j] = *(const u32x4*)(PROJ + (size_t)(m0 + tg + 8 + j) * PW + ch);
        }
#pragma unroll
        for (int j = 0; j < 8; ++j) {
            const int t = tg + j, m = m0 + t;
            unpack8(rw[j], raw);
            *(u32x4*)(OUT + (size_t)m * 3072 + ch) = conv_out<KIND>(w, bias, p3, p2, p1, raw);
            if (t0 + t >= SEQ - 3) store8f(cso + (size_t)(t0 + t - (SEQ - 3)) * 3072, raw);
#pragma unroll
            for (int i = 0; i < 8; ++i) { p3[i] = p2[i]; p2[i] = p1[i]; p1[i] = raw[i]; }
        }
#pragma unroll
        for (int j = 0; j < 8; ++j) rw[j] = rn[j];
    }
}
template <int KIND>
__device__ __forceinline__ void m1_samp(const Args& a, int layer, int slab, int s0, int lane) {
    constexpr bool SSD = (KIND == 3);
    const bf16_t* PROJ = (const bf16_t*)(a.ws + WS_PROJ) + (SSD ? P_XBC : P_QKVA);
    bf16_t* OUT = (bf16_t*)(a.ws + (SSD ? WS_XBC : WS_GQKV));
    const float* cw = (SSD ? a.in[28] : a.in[21]) + (size_t)layer * 4 * 3072;
    const int ch = slab * 512 + lane * 8;
    float w[4][8], bias[8];
#pragma unroll
    for (int j = 0; j < 4; ++j) load8f(cw + j * 3072 + ch, w[j]);
    if (SSD) load8f(a.in[29] + (size_t)layer * 3072 + ch, bias); else { for (int i = 0; i < 8; ++i) bias[i] = 0.f; }
    {
        float p1[2][8], p2[2][8], p3[2][8]; u32x4 rw[2];
#pragma unroll
        for (int q = 0; q < 2; ++q) {
            const int s = s0 + q;
            const float* st = (SSD ? a.in[5] : a.in[2]) + ((size_t)layer * NS + s) * 3 * 3072 + ch;
            load8f(st, p3[q]); load8f(st + 3072, p2[q]); load8f(st + 6144, p1[q]);
            rw[q] = *(const u32x4*)(PROJ + (size_t)(NPT + s) * PW + ch);
        }
#pragma unroll
        for (int q = 0; q < 2; ++q) {
            const int s = s0 + q, m = NPT + s;
            float* so = a.out + (SSD ? O_SSC : O_SGC) + ((size_t)layer * NS + s) * 3 * 3072 + ch;
            float raw[8]; unpack8(rw[q], raw);
            *(u32x4*)(OUT + (size_t)m * 3072 + ch) = conv_out<KIND>(w, bias, p3[q], p2[q], p1[q], raw);
            store8f(so, p2[q]); store8f(so + 3072, p1[q]); store8f(so + 6144, raw);
        }
    }
}
template <int NQ>
__device__ __forceinline__ void m1_scalar(const Args& a, int layer, int m0, int lane) {
    const float* SMALL = (const float*)(a.ws + WS_SMALL); float* GB = (float*)(a.ws + WS_GB); float* LA = (float*)(a.ws + WS_LA); float* DT = (float*)(a.ws + WS_DT);
    const float* Wg = a.in[25] + (size_t)layer * 16 * 512; const float* bg = a.in[26] + (size_t)layer * 512;
    {
        float bgv[8];
        load8f(bg + lane * 8, bgv);
        const float alog = lane < 8 ? -__expf(a.in[22][layer * 8 + lane]) : 0.f, dtb = lane < 8 ? a.in[23][layer * 8 + lane] : 0.f, sdb = lane < 32 ? a.in[31][layer * 32 + lane] : 0.f;
        f32x4 lrv[NQ][4]; float sb[NQ], sd[NQ], sdt[NQ];
#pragma unroll
        for (int q = 0; q < NQ; ++q) {
            const float* sm = SMALL + (size_t)(m0 + q) * SW;
#pragma unroll
            for (int i = 0; i < 4; ++i) lrv[q][i] = *(const f32x4*)(sm + S_LR + 4 * i);
            sb[q] = sm[S_BETA + (lane & 7)]; sd[q] = sm[S_DEC + (lane & 7)]; sdt[q] = sm[S_DT + (lane & 31)];
        }
        float acc[NQ][8];
#pragma unroll
        for (int q = 0; q < NQ; ++q)
#pragma unroll
            for (int i = 0; i < 8; ++i) acc[q][i] = bgv[i];
        float wg[2][4][8];
#pragma unroll
        for (int rr = 0; rr < 4; ++rr) load8f(Wg + rr * 512 + lane * 8, wg[0][rr]);
#pragma unroll
        for (int r4 = 0; r4 < 4; ++r4) {
            if (r4 < 3) {
#pragma unroll
                for (int rr = 0; rr < 4; ++rr) load8f(Wg + (4 * (r4 + 1) + rr) * 512 + lane * 8, wg[(r4 + 1) & 1][rr]);
            }
#pragma unroll
            for (int rr = 0; rr < 4; ++rr)
#pragma unroll
                for (int q = 0; q < NQ; ++q) { const float lr = lrv[q][r4][rr];
#pragma unroll
                    for (int i = 0; i < 8; ++i) acc[q][i] += lr * wg[r4 & 1][rr][i]; }
            asm volatile("" ::: "memory");
        }
#pragma unroll
        for (int q = 0; q < NQ; ++q) {
            const int m = m0 + q;
            if (lane < 8) { GB[(size_t)m * 16 + lane] = sigmoidf_(sb[q]); GB[(size_t)m * 16 + 8 + lane] = alog * softplusf_(sd[q] + dtb); }
            if (lane < 32) DT[(size_t)m * 32 + lane] = softplusf_(sdt[q] + sdb);
#pragma unroll
            for (int i = 0; i < 8; ++i) acc[q][i] = logsigmoidf_(acc[q][i]) * (1.0f / 16.0f);
            store8f(LA + (size_t)m * 512 + lane * 8, acc[q]);
            asm volatile("" ::: "memory");
        }
    }
}
__device__ __forceinline__ void m1_phase(const Args& a, int vcu, int G, int layer) {
    const int tid = ltid(), lane = tid & 63, wave = __builtin_amdgcn_readfirstlane(tid >> 6);
    const int gw = vcu * NWAVES + wave, NGW = G * NWAVES;
    constexpr int NSTRIP = NPT / M1_T, NPAIR = 12 * NSTRIP, NT_W = 2048, NT_H = 2 * (NPAIR - NT_W), NT_S = 12 * (NS / 2);
    static_assert(NPAIR >= NT_W, "task map");
#ifndef REPMASK
#define REPMASK 0
#endif
    for (int rep_ = 0; rep_ < 1 + ((REPMASK >> 26) & 1); ++rep_)
#pragma unroll 1
    for (int task = gw; task < NT_W + NT_H + NT_S; task += NGW) {
        if (task < NT_W) {
            const int slab12 = task % 12, idx = task / 12, slab = slab12 % 6, m0 = idx * M1_T;
            if (slab12 >= 6) m1_strip<3, 32>(a, layer, slab, m0, lane);
            else if (slab < 2) m1_strip<0, 32>(a, layer, slab, m0, lane);
            else if (slab < 4) m1_strip<1, 32>(a, layer, slab, m0, lane);
            else m1_strip<2, 32>(a, layer, slab, m0, lane);
        } else if (task < NT_W + NT_H) {
            const int hh = task - NT_W, u = NT_W + (hh >> 1), slab12 = u % 12, idx = u / 12, slab = slab12 % 6, m0 = idx * M1_T + 16 * (hh & 1);
            if (slab12 >= 6) m1_strip<3, 16>(a, layer, slab, m0, lane);
            else if (slab < 2) m1_strip<0, 16>(a, layer, slab, m0, lane);
            else if (slab < 4) m1_strip<1, 16>(a, layer, slab, m0, lane);
            else m1_strip<2, 16>(a, layer, slab, m0, lane);
        } else {
            const int tk = task - NT_W - NT_H, slab12 = tk % 12, s0 = 2 * (tk / 12), slab = slab12 % 6;
            if (slab12 >= 6) m1_samp<3>(a, layer, slab, s0, lane);
            else if (slab < 2) m1_samp<0>(a, layer, slab, s0, lane);
            else if (slab < 4) m1_samp<1>(a, layer, slab, s0, lane);
            else m1_samp<2>(a, layer, slab, s0, lane);
        }
    }
#ifndef M1_NO_SCALAR
    for (int rep_ = 0; rep_ < 1 + ((REPMASK >> 27) & 1); ++rep_) {
#pragma unroll 1
        for (int task = gw; task < NPT / 2; task += NGW) m1_scalar<2>(a, layer, 2 * task, lane);
#pragma unroll 1
        for (int k = NGW - 1 - gw; k < NS; k += NGW) m1_scalar<1>(a, layer, NPT + k, lane);
    }
#endif
}

__device__ __forceinline__ void tile_g2l(const bf16_t* g, size_t gp, LAS bf16_t* l, int lp, int R, int C, int tid) {
    const int cpr = C / 8, n = R * cpr;
    for (int i = tid; i < n; i += NTHR) { const int r = i / cpr, c = (i % cpr) * 8; *(LAS u32x4*)(l + r * lp + c) = *(const u32x4*)(g + (size_t)r * gp + c); }
}
template <int R, int C>
__device__ __forceinline__ void tile_issue(const bf16_t* g, size_t gp, u32x4 (&v)[R * (C / 8) / NTHR], int tid) {
    constexpr int cpr = C / 8, NI = R * cpr / NTHR;
#pragma unroll
    for (int k = 0; k < NI; ++k) { const int i = tid + k * NTHR, r = i / cpr, c = (i % cpr) * 8; v[k] = *(const u32x4*)(g + (size_t)r * gp + c); }
}
template <int R, int C>
__device__ __forceinline__ void tile_commit(const u32x4 (&v)[R * (C / 8) / NTHR], LAS bf16_t* l, int lp, int tid) {
    constexpr int cpr = C / 8, NI = R * cpr / NTHR;
#pragma unroll
    for (int k = 0; k < NI; ++k) { const int i = tid + k * NTHR, r = i / cpr, c = (i % cpr) * 8; *(LAS u32x4*)(l + r * lp + c) = v[k]; }
}
__device__ __forceinline__ bf16x8 frag(const LAS bf16_t* l, int lp, int r0, int k0, int lane) { return *(const LAS bf16x8*)(l + (r0 + (lane & 15)) * lp + k0 + 8 * (lane >> 4)); }
#define MFMA16(a, b, c) __builtin_amdgcn_mfma_f32_16x16x32_bf16((a), (b), (c), 0, 0, 0)
template <bool TO_LDS, bool TO_GLB>
__device__ __forceinline__ void transpose_scale(const LAS bf16_t* src, int sp, int C, const LAS float* sc, LAS bf16_t* dl, int dp, bf16_t* dg, int tid) {
    const int npass = C / 128;
    const int spair = tid & 31, cg = tid >> 5;
    const float s0 = sc ? sc[2 * spair] : 1.f, s1 = sc ? sc[2 * spair + 1] : 1.f;
    for (int p = 0; p < npass; ++p) {
        const int c0 = p * 128 + cg * 8;
        float a[8], b[8];
        unpack8(*(const LAS u32x4*)(src + (2 * spair) * sp + c0), a); unpack8(*(const LAS u32x4*)(src + (2 * spair + 1) * sp + c0), b);
#pragma unroll
        for (int i = 0; i < 8; ++i) {
            const unsigned w = pk2(a[i] * s0, b[i] * s1);
            if (TO_LDS) *(LAS unsigned*)(dl + (c0 + i) * dp + 2 * spair) = w;
            if (TO_GLB) *(unsigned*)(dg + (size_t)(c0 + i) * 64 + 2 * spair) = w;
        }
    }
}

struct GdnPre { u32x4 t[6]; float beta, g; };
__device__ __forceinline__ void m2_gdn_prefetch(const Args& a, int uid, GdnPre& P) {
    const int tid = ltid(), lane = tid & 63;
    const int h = uid & 7, m0 = (uid >> 3) * 64;
    const bf16_t* GQKV = (const bf16_t*)(a.ws + WS_GQKV) + (size_t)m0 * 3072 + h * 128; const float* GB = (const float*)(a.ws + WS_GB);
#pragma unroll
    for (int q = 0; q < 3; ++q)
#pragma unroll
        for (int j = 0; j < 2; ++j) { const int i = tid + 512 * j; P.t[2 * q + j] = *(const u32x4*)(GQKV + q * 1024 + (size_t)(i >> 4) * 3072 + (i & 15) * 8); }
    P.beta = GB[(size_t)(m0 + lane) * 16 + h]; P.g = GB[(size_t)(m0 + lane) * 16 + 8 + h];
}
__device__ __forceinline__ void m2_gdn_unit(const Args& a, LAS unsigned char* lds, int uid, GdnPre& P, int next_uid) {
    const int tid = ltid(), lane = tid & 63, wave = __builtin_amdgcn_readfirstlane(tid >> 6), c16 = lane & 15, kq = lane >> 4;
    const int h = uid & 7, bc = uid >> 3, m0 = bc * 64;
    LAS bf16_t* Kt = (LAS bf16_t*)(lds);
    LAS bf16_t* Qt = (LAS bf16_t*)(lds + 18432);
    LAS bf16_t* Vt = (LAS bf16_t*)(lds + 36864);
    LAS float* Lm = (LAS float*)(lds + 55296);
    LAS float* Tm = (LAS float*)(lds + 72704);
    LAS bf16_t* VBT = (LAS bf16_t*)(lds + 90112);
    LAS bf16_t* KBT = (LAS bf16_t*)(lds + 110592);
    LAS float* sm = (LAS float*)(lds + 131072);
    LAS float* s_gc = sm, *s_beta = sm + 64, *s_eg = sm + 128, *s_egl = sm + 192, *s_bk = sm + 256;
    LAS bf16_t* Tb = Qt; LAS float* Ys = (LAS float*)Vt;
    const bf16_t* GQKV = (const bf16_t*)(a.ws + WS_GQKV); const float* GB = (const float*)(a.ws + WS_GB);
    bf16_t* G_WK = (bf16_t*)(a.ws + WS_G_WK) + (size_t)uid * 8192; bf16_t* G_QD = (bf16_t*)(a.ws + WS_G_QD) + (size_t)uid * 8192; bf16_t* G_KDT = (bf16_t*)(a.ws + WS_G_KDT) + (size_t)uid * 8192;
    bf16_t* G_QKD = (bf16_t*)(a.ws + WS_G_QKD) + (size_t)uid * 4096; float* G_UT = (float*)(a.ws + WS_G_UT) + (size_t)uid * 8192; float* G_EGL = (float*)(a.ws + WS_G_EGL);
#pragma unroll
    for (int j = 0; j < 2; ++j) { const int i = tid + 512 * j, o = (i >> 4) * 144 + (i & 15) * 8;
        *(LAS u32x4*)(Qt + o) = P.t[j]; *(LAS u32x4*)(Kt + o) = P.t[2 + j]; *(LAS u32x4*)(Vt + o) = P.t[4 + j]; }
    if (wave == 0) {
        const float beta = P.beta, g = P.g;
        float gc = g;
#pragma unroll
        for (int o = 1; o < 64; o <<= 1) { const float v = __shfl_up(gc, o); if (lane >= o) gc += v; }
        const float gl = __shfl(gc, 63);
        s_gc[lane] = gc; s_beta[lane] = beta; s_eg[lane] = __expf(gc); s_egl[lane] = __expf(gl - gc); s_bk[lane] = beta * __expf(gc);
        G_EGL[(size_t)uid * 64 + lane] = __expf(gl);
    }
    LBAR();
    if (next_uid >= 0) m2_gdn_prefetch(a, next_uid, P);
    for (int i = tid; i < 1024; i += NTHR) { const int r = i >> 4, c = (i & 15) * 8; float f[8]; unpack8(*(const LAS u32x4*)(Qt + r * 144 + c), f); const float e = s_eg[r];
#pragma unroll
        for (int j = 0; j < 8; ++j) f[j] *= e;
        *(u32x4*)(G_QD + r * 128 + c) = pack8(f); }
    transpose_scale<true, false>(Vt, 144, 128, s_beta, VBT, 80, nullptr, tid);
    transpose_scale<true, false>(Kt, 144, 128, s_bk, KBT, 80, nullptr, tid);
    transpose_scale<false, true>(Kt, 144, 128, s_egl, nullptr, 0, G_KDT, tid);
    {
        const int ti = wave >> 1;
#pragma unroll
        for (int jj = 0; jj < 2; ++jj) {
            const int tj = (wave & 1) * 2 + jj;
            f32x4 akk = (f32x4){0.f, 0.f, 0.f, 0.f}, aqk = (f32x4){0.f, 0.f, 0.f, 0.f};
            if (tj <= ti) {
#pragma unroll
                for (int ks = 0; ks < 4; ++ks) {
                    const bf16x8 bk = frag(Kt, 144, 16 * tj, 32 * ks, lane);
                    akk = MFMA16(frag(Kt, 144, 16 * ti, 32 * ks, lane), bk, akk);
                    aqk = MFMA16(frag(Qt, 144, 16 * ti, 32 * ks, lane), bk, aqk);
                }
            }
            const int s = 16 * tj + c16; const float gcs = s_gc[s];
#pragma unroll
            for (int j = 0; j < 4; ++j) {
                const int t = 16 * ti + 4 * kq + j; const float dec = __expf(fminf(s_gc[t] - gcs, 0.f));
                Lm[t * 68 + s] = (s < t) ? s_beta[t] * dec * akk[j] : 0.f;
                G_QKD[t * 64 + s] = (bf16_t)f2bf((s <= t) ? aqk[j] * dec : 0.f);
            }
        }
    }
    LBAR();
    if (wave < 4 && lane < 16) {
        float Tc[16]; const int o = 16 * wave;
#pragma unroll
        for (int t = 0; t < 16; ++t) {
            float acc = (t == lane) ? 1.f : 0.f;
#pragma unroll
            for (int s = 0; s < t; ++s) acc -= Lm[(o + t) * 68 + o + s] * Tc[s];
            Tc[t] = acc; Tm[(o + t) * 68 + o + lane] = acc;
        }
    }
    LBAR();
    for (int d = 1; d < 4; ++d) {
        const int np = 4 - d;
        for (int o = tid; o < np * 256; o += NTHR) {
            const int p = o >> 8, r = (o >> 4) & 15, c = o & 15, i = d + p, j = p;
            float acc = 0.f;
            for (int mm = 16 * j; mm < 16 * i; ++mm) acc += Lm[(16 * i + r) * 68 + mm] * Tm[mm * 68 + 16 * j + c];
            Ys[p * 272 + r * 17 + c] = acc;
        }
        LBAR();
        for (int o = tid; o < np * 256; o += NTHR) {
            const int p = o >> 8, r = (o >> 4) & 15, c = o & 15, i = d + p, j = p;
            float acc = 0.f;
#pragma unroll
            for (int mm = 0; mm < 16; ++mm) acc += Tm[(16 * i + r) * 68 + 16 * i + mm] * Ys[p * 272 + mm * 17 + c];
            Tm[(16 * i + r) * 68 + 16 * j + c] = -acc;
        }
        LBAR();
    }
    for (int i = tid; i < 2048; i += NTHR) { const int r = i >> 5, c = (i & 31) * 2;
        const float v0 = (c <= r) ? Tm[r * 68 + c] : 0.f, v1 = (c + 1 <= r) ? Tm[r * 68 + c + 1] : 0.f;
        *(LAS unsigned*)(Tb + r * 80 + c) = pk2(v0, v1); }
    LBAR();
    {
#pragma unroll
        for (int ti = 0; ti < 4; ++ti) {
            f32x4 acc = (f32x4){0.f, 0.f, 0.f, 0.f};
#pragma unroll
            for (int ks = 0; ks < 2; ++ks) acc = MFMA16(frag(Tb, 80, 16 * ti, 32 * ks, lane), frag(VBT, 80, 16 * wave, 32 * ks, lane), acc);
            *(f32x4*)(G_UT + (size_t)(16 * wave + c16) * 64 + 16 * ti + 4 * kq) = acc;
        }
#pragma unroll
        for (int tt = 0; tt < 4; ++tt) {
            f32x4 acc = (f32x4){0.f, 0.f, 0.f, 0.f};
#pragma unroll
            for (int ks = 0; ks < 2; ++ks) acc = MFMA16(frag(KBT, 80, 16 * wave, 32 * ks, lane), frag(Tb, 80, 16 * tt, 32 * ks, lane), acc);
            u32x2 w; w.x = pk2(acc[0], acc[1]); w.y = pk2(acc[2], acc[3]);
            *(u32x2*)(G_WK + (size_t)(16 * tt + c16) * 128 + 16 * wave + 4 * kq) = w;
        }
    }
    LBAR();
}

__device__ __forceinline__ void m2_gla_unit(const Args& a, LAS unsigned char* lds, int uid) {
    const int tid = ltid(), lane = tid & 63, wave = __builtin_amdgcn_readfirstlane(tid >> 6), c16 = lane & 15, kq = lane >> 4;
    const int h = uid & 3, bc = uid >> 2, m0 = bc * 64;
    LAS bf16_t* Qt = (LAS bf16_t*)(lds);
    LAS bf16_t* Kt = (LAS bf16_t*)(lds + 18432);
    LAS bf16_t* Vt = (LAS bf16_t*)(lds + 36864);
    LAS float* Bm = (LAS float*)(lds + 70656);
    LAS float* tot = (LAS float*)(lds + 104448);
    const bf16_t* PROJ = (const bf16_t*)(a.ws + WS_PROJ); const float* LA = (const float*)(a.ws + WS_LA);
    bf16_t* L_QB = (bf16_t*)(a.ws + WS_L_QB) + (size_t)uid * 8192; bf16_t* L_ATT = (bf16_t*)(a.ws + WS_L_ATT) + (size_t)uid * 4096; bf16_t* L_KDT = (bf16_t*)(a.ws + WS_L_KDT) + (size_t)uid * 8192;
    bf16_t* L_VT = (bf16_t*)(a.ws + WS_L_VT) + (size_t)uid * 16384; float* L_EBL = (float*)(a.ws + WS_L_EBL) + (size_t)uid * 128;
    const int d = tid & 127, seg = tid >> 7;
    float bl[16];
    {
        u32x4 tq[2], tk[2], tv[4];
        tile_issue<64, 128>(PROJ + (size_t)m0 * PW + P_QB + h * 128, PW, tq, tid);
        tile_issue<64, 128>(PROJ + (size_t)m0 * PW + P_KB + h * 128, PW, tk, tid);
        tile_issue<64, 256>(PROJ + (size_t)m0 * PW + P_VB + h * 256, PW, tv, tid);
#pragma unroll
        for (int i = 0; i < 16; ++i) bl[i] = LA[(size_t)(m0 + 16 * seg + i) * 512 + h * 128 + d];
        tile_commit<64, 128>(tq, Qt, 144, tid); tile_commit<64, 128>(tk, Kt, 144, tid); tile_commit<64, 256>(tv, Vt, 264, tid);
        float run = 0.f;
#pragma unroll
        for (int i = 0; i < 16; ++i) { run += bl[i]; bl[i] = run; }
        tot[seg * 128 + d] = run;
    }
    LBAR();
    {
        float off = 0.f;
        for (int s2 = 0; s2 < seg; ++s2) off += tot[s2 * 128 + d];
#pragma unroll
        for (int i = 0; i < 16; ++i) Bm[(16 * seg + i) * 132 + d] = bl[i] + off;
    }
    LBAR();
    transpose_scale<false, true>(Vt, 264, 256, nullptr, nullptr, 0, L_VT, tid);
    {
        const int spair = tid & 31, cg = tid >> 5, c0 = cg * 8;
        float k0[8], k1[8];
        unpack8(*(const LAS u32x4*)(Kt + (2 * spair) * 144 + c0), k0); unpack8(*(const LAS u32x4*)(Kt + (2 * spair + 1) * 144 + c0), k1);
#pragma unroll
        for (int i = 0; i < 8; ++i) {
            const float bL = Bm[63 * 132 + c0 + i];
            const unsigned w = pk2(k0[i] * __expf(bL - Bm[(2 * spair) * 132 + c0 + i]), k1[i] * __expf(bL - Bm[(2 * spair + 1) * 132 + c0 + i]));
            *(unsigned*)(L_KDT + (size_t)(c0 + i) * 64 + 2 * spair) = w;
        }
        if (tid < 128) L_EBL[tid] = __expf(Bm[63 * 132 + tid]);
    }
    LBAR();
    for (int i = tid; i < 1024; i += NTHR) { const int r = i >> 4, c = (i & 15) * 8; float q[8], k[8];
        unpack8(*(const LAS u32x4*)(Qt + r * 144 + c), q); unpack8(*(const LAS u32x4*)(Kt + r * 144 + c), k);
#pragma unroll
        for (int j = 0; j < 8; ++j) { const float bb = Bm[r * 132 + c + j]; q[j] *= 0.08838834764831845f * __expf(bb); k[j] *= __expf(-bb); }
        const u32x4 qw = pack8(q); *(LAS u32x4*)(Qt + r * 144 + c) = qw; *(u32x4*)(L_QB + r * 128 + c) = qw; *(LAS u32x4*)(Kt + r * 144 + c) = pack8(k); }
    LBAR();
    {
        const int ti = wave >> 1;
#pragma unroll
        for (int jj = 0; jj < 2; ++jj) {
            const int tj = (wave & 1) * 2 + jj;
            f32x4 acc = (f32x4){0.f, 0.f, 0.f, 0.f};
            if (tj <= ti) {
#pragma unroll
                for (int ks = 0; ks < 4; ++ks) acc = MFMA16(frag(Qt, 144, 16 * ti, 32 * ks, lane), frag(Kt, 144, 16 * tj, 32 * ks, lane), acc);
            }
            const int s = 16 * tj + c16;
#pragma unroll
            for (int j = 0; j < 4; ++j) { const int t = 16 * ti + 4 * kq + j; L_ATT[t * 64 + s] = (bf16_t)f2bf((s <= t) ? acc[j] : 0.f); }
        }
    }
    LBAR();
}

__device__ __forceinline__ void m2_ssd_unit(const Args& a, LAS unsigned char* lds, int uid, int layer) {
    const int tid = ltid(), lane = tid & 63, wave = __builtin_amdgcn_readfirstlane(tid >> 6), c16 = lane & 15, kq = lane >> 4;
    const int g = uid & 3, bc = uid >> 2, m0 = bc * 64;
    LAS bf16_t* Bt_ = (LAS bf16_t*)(lds);
    LAS bf16_t* Ct_ = (LAS bf16_t*)(lds + 18432);
    LAS bf16_t* Xt = (LAS bf16_t*)(lds + 36864);
    LAS float* CB = (LAS float*)(lds + 103424);
    LAS float* s_dt = (LAS float*)(lds + 120832);
    LAS float* s_ac = s_dt + 512;
    LAS float* s_e2 = s_ac + 512;
    const bf16_t* XBC = (const bf16_t*)(a.ws + WS_XBC); const float* DT = (const float*)(a.ws + WS_DT);
    float dt_pre;
    {
        u32x4 tb[2], tc[2], tx[8];
        tile_issue<64, 128>(XBC + (size_t)m0 * 3072 + 2048 + g * 128, 3072, tb, tid);
        tile_issue<64, 128>(XBC + (size_t)m0 * 3072 + 2560 + g * 128, 3072, tc, tid);
        tile_issue<64, 512>(XBC + (size_t)m0 * 3072 + g * 512, 3072, tx, tid);
        dt_pre = DT[(size_t)(m0 + lane) * 32 + g * 8 + wave];
        tile_commit<64, 128>(tb, Bt_, 144, tid); tile_commit<64, 128>(tc, Ct_, 144, tid); tile_commit<64, 512>(tx, Xt, 520, tid);
    }
    {
        const int hh = wave, hd = g * 8 + hh, su = (bc * 32 + hd);
        const float dt = dt_pre, A = -__expf(a.in[30][layer * 32 + hd]);
        float ac = dt * A;
#pragma unroll
        for (int o = 1; o < 64; o <<= 1) { const float v = __shfl_up(ac, o); if (lane >= o) ac += v; }
        const float al_ = __shfl(ac, 63);
        s_dt[hh * 64 + lane] = dt; s_ac[hh * 64 + lane] = ac; s_e2[hh * 64 + lane] = __expf(al_ - ac);
        ((float*)(a.ws + WS_S_EA))[(size_t)su * 64 + lane] = __expf(ac);
        ((float*)(a.ws + WS_S_EAL))[(size_t)su * 64 + lane] = __expf(al_);
    }
    LBAR();
    {
        const int ti = wave >> 1;
#pragma unroll
        for (int jj = 0; jj < 2; ++jj) {
            const int tj = (wave & 1) * 2 + jj;
            f32x4 acc = (f32x4){0.f, 0.f, 0.f, 0.f};
            if (tj <= ti) {
#pragma unroll
                for (int ks = 0; ks < 4; ++ks) acc = MFMA16(frag(Ct_, 144, 16 * ti, 32 * ks, lane), frag(Bt_, 144, 16 * tj, 32 * ks, lane), acc);
            }
#pragma unroll
            for (int j = 0; j < 4; ++j) CB[(16 * ti + 4 * kq + j) * 68 + 16 * tj + c16] = acc[j];
        }
    }
    transpose_scale<false, true>(Bt_, 144, 128, nullptr, nullptr, 0, (bf16_t*)(a.ws + WS_S_BT) + (size_t)uid * 8192, tid);
    {
        const int spair = tid & 31, cg = tid >> 5;
        for (int p = 0; p < 4; ++p) {
            const int c0 = p * 128 + cg * 8, hh = c0 >> 6, pp = c0 & 63; const size_t su = (size_t)(bc * 32 + g * 8 + hh);
            float x0[8], x1[8];
            unpack8(*(const LAS u32x4*)(Xt + (2 * spair) * 520 + c0), x0); unpack8(*(const LAS u32x4*)(Xt + (2 * spair + 1) * 520 + c0), x1);
            const float d0 = s_dt[hh * 64 + 2 * spair], d1 = s_dt[hh * 64 + 2 * spair + 1], e0 = s_e2[hh * 64 + 2 * spair], e1 = s_e2[hh * 64 + 2 * spair + 1];
            bf16_t* o1 = (bf16_t*)(a.ws + WS_S_XDTT) + su * 4096; bf16_t* o2 = (bf16_t*)(a.ws + WS_S_XDT2T) + su * 4096;
#pragma unroll
            for (int i = 0; i < 8; ++i) {
                const float v0 = x0[i] * d0, v1 = x1[i] * d1;
                *(unsigned*)(o1 + (pp + i) * 64 + 2 * spair) = pk2(v0, v1);
                *(unsigned*)(o2 + (pp + i) * 64 + 2 * spair) = pk2(v0 * e0, v1 * e1);
            }
        }
    }
    LBAR();
    for (int i = tid; i < 8 * 2048; i += NTHR) {
        const int hh = i >> 11, r = (i >> 5) & 63, c = (i & 31) * 2; const size_t su = (size_t)(bc * 32 + g * 8 + hh);
        const float at = s_ac[hh * 64 + r];
        const float v0 = (c <= r) ? CB[r * 68 + c] * __expf(fminf(at - s_ac[hh * 64 + c], 0.f)) : 0.f;
        const float v1 = (c + 1 <= r) ? CB[r * 68 + c + 1] * __expf(fminf(at - s_ac[hh * 64 + c + 1], 0.f)) : 0.f;
        *(unsigned*)((bf16_t*)(a.ws + WS_S_MH) + su * 4096 + r * 64 + c) = pk2(v0, v1);
    }
    LBAR();
}
__device__ __forceinline__ void m2_phase(const Args& a, LAS unsigned char* lds, int vcu, int G, int layer) {
    if (vcu < NGU) {
        GdnPre P; m2_gdn_prefetch(a, vcu, P);
        for (int u = vcu; u < NGU; u += G) m2_gdn_unit(a, lds, u, P, u + G < NGU ? u + G : -1);
    }
    for (int u = vcu + ((NGU - vcu + G - 1) / G) * G; u < NGU + NLU + NSG; u += G) {
        if (u < NGU) { }
        else if (u < NGU + NLU) m2_gla_unit(a, lds, u - NGU);
        else m2_ssd_unit(a, lds, u - NGU - NLU, layer);
    }
}

#define LD16(p) (*(const u32x4*)(p))

__device__ __forceinline__ void scan_gdn_unit(const Args& a, LAS unsigned char* lds, int unit, int layer) {
    const int tid = ltid(), lane = tid & 63, wave = __builtin_amdgcn_readfirstlane(tid >> 6), c16 = lane & 15, kq = lane >> 4;
    const int j = unit & 3, h = (unit >> 2) & 7, b = unit >> 5;
    constexpr int OFF_P = 0, OFF_KDT = 36864, BUFSZ = 57344;
    LAS bf16_t* St = (LAS bf16_t*)(lds + 2 * BUFSZ);
    LAS bf16_t* wT = (LAS bf16_t*)(lds + 2 * BUFSZ + 9216);
    const bf16_t* G_WK = (const bf16_t*)(a.ws + WS_G_WK); const bf16_t* G_QD = (const bf16_t*)(a.ws + WS_G_QD); const bf16_t* G_KDT = (const bf16_t*)(a.ws + WS_G_KDT);
    const bf16_t* G_QKD = (const bf16_t*)(a.ws + WS_G_QKD); const float* G_UT = (const float*)(a.ws + WS_G_UT); const float* G_EGL = (const float*)(a.ws + WS_G_EGL);
    bf16_t* OA = (bf16_t*)(a.ws + WS_OA);
    struct Regs { u32x4 r[6]; u32x4 rx[2]; float egl; };
    auto issue = [&](Regs& R, int c) {
        const size_t uid = (size_t)((b * 32 + c) * 8 + h);
        const bf16_t* wk = G_WK + uid * 8192; const bf16_t* qd = G_QD + uid * 8192; const bf16_t* kdt = G_KDT + uid * 8192; const bf16_t* qkd = G_QKD + uid * 4096;
        R.r[0] = LD16(wk + (size_t)tid * 8); R.r[1] = LD16(wk + (size_t)(tid + 512) * 8);
        R.r[2] = LD16(qd + (size_t)tid * 8); R.r[3] = LD16(qd + (size_t)(tid + 512) * 8);
        R.r[4] = LD16(kdt + (size_t)tid * 8); R.r[5] = LD16(kdt + (size_t)(tid + 512) * 8);
        {
            const char* p0 = wave < 4 ? (const char*)(G_UT + uid * 8192 + (size_t)(32 * j + c16) * 64 + 16 * wave + 4 * kq) : (const char*)(qkd + (size_t)(16 * (wave - 4) + c16) * 64 + 8 * kq);
            const size_t st = wave < 4 ? (size_t)16 * 64 * 4 : (size_t)32 * 2;
            R.rx[0] = LD16(p0); R.rx[1] = LD16(p0 + st);
        }
        R.egl = G_EGL[uid * 64 + lane];
    };
    auto commit = [&](const Regs& R, int buf) {
        LAS unsigned char* B = lds + buf * BUFSZ;
        *(LAS u32x4*)(B + OFF_P + ((tid >> 4) * 144 + (tid & 15) * 8) * 2) = R.r[0]; *(LAS u32x4*)(B + OFF_P + (((tid + 512) >> 4) * 144 + (tid & 15) * 8) * 2) = R.r[1];
        *(LAS u32x4*)(B + OFF_P + ((64 + (tid >> 4)) * 144 + (tid & 15) * 8) * 2) = R.r[2]; *(LAS u32x4*)(B + OFF_P + ((64 + ((tid + 512) >> 4)) * 144 + (tid & 15) * 8) * 2) = R.r[3];
        *(LAS u32x4*)(B + OFF_KDT + ((tid >> 3) * 80 + (tid & 7) * 8) * 2) = R.r[4]; *(LAS u32x4*)(B + OFF_KDT + (((tid + 512) >> 3) * 80 + (tid & 7) * 8) * 2) = R.r[5];
    };
    f32x4 Sreg[2] = {(f32x4){0.f, 0.f, 0.f, 0.f}, (f32x4){0.f, 0.f, 0.f, 0.f}};
#pragma unroll
    for (int tj = 0; tj < 2; ++tj) *(LAS u32x2*)(St + (16 * tj + c16) * 144 + 16 * wave + 4 * kq) = (u32x2){0u, 0u};
    Regs RA, RB, RC;
    issue(RA, 0); commit(RA, 0);
    u32x4 cx[2] = {RA.rx[0], RA.rx[1]}; float cegl = RA.egl;
    issue(RB, 1); issue(RC, 2); issue(RA, 3);
    auto step = [&](int c, Regs& Rn) {
        LBAR();
        const LAS unsigned char* B = lds + (c & 1) * BUFSZ;
        const LAS bf16_t* P = (const LAS bf16_t*)(B + OFF_P); const LAS bf16_t* KDT = (const LAS bf16_t*)(B + OFF_KDT);
        f32x4 p[2] = {(f32x4){0.f, 0.f, 0.f, 0.f}, (f32x4){0.f, 0.f, 0.f, 0.f}};
#pragma unroll
        for (int ks = 0; ks < 4; ++ks) {
            const bf16x8 af = frag(P, 144, 16 * wave, 32 * ks, lane);
#pragma unroll
            for (int tj = 0; tj < 2; ++tj) p[tj] = MFMA16(af, frag(St, 144, 16 * tj, 32 * ks, lane), p[tj]);
        }
        if (wave < 4) {
#pragma unroll
            for (int tj = 0; tj < 2; ++tj) { const f32x4 w = __builtin_bit_cast(f32x4, cx[tj]) - p[tj]; u32x2 o; o.x = pk2(w[0], w[1]); o.y = pk2(w[2], w[3]); *(LAS u32x2*)(wT + (16 * tj + c16) * 80 + 16 * wave + 4 * kq) = o; }
        }
        LBAR();
        if (wave >= 4) {
            const int ti = wave - 4;
#pragma unroll
            for (int ks = 0; ks < 2; ++ks) {
                const bf16x8 af = __builtin_bit_cast(bf16x8, cx[ks]);
#pragma unroll
                for (int tj = 0; tj < 2; ++tj) p[tj] = MFMA16(af, frag(wT, 80, 16 * tj, 32 * ks, lane), p[tj]);
            }
        }
#pragma unroll
        for (int tj = 0; tj < 2; ++tj) Sreg[tj] = Sreg[tj] * cegl;
#pragma unroll
        for (int ks = 0; ks < 2; ++ks) {
            const bf16x8 af = frag(KDT, 80, 16 * wave, 32 * ks, lane);
#pragma unroll
            for (int tj = 0; tj < 2; ++tj) Sreg[tj] = MFMA16(af, frag(wT, 80, 16 * tj, 32 * ks, lane), Sreg[tj]);
        }
#pragma unroll
        for (int tj = 0; tj < 2; ++tj) { u32x2 o; o.x = pk2(Sreg[tj][0], Sreg[tj][1]); o.y = pk2(Sreg[tj][2], Sreg[tj][3]); *(LAS u32x2*)(St + (16 * tj + c16) * 144 + 16 * wave + 4 * kq) = o; }
        if (c + 1 < NCHUNK) { commit(Rn, (c + 1) & 1); cx[0] = Rn.rx[0]; cx[1] = Rn.rx[1]; cegl = Rn.egl; if (c + 4 < NCHUNK) issue(Rn, c + 4); }
        if (wave >= 4) {
            bf16_t* op = OA + ((size_t)b * SEQ + c * 64 + 16 * (wave - 4) + 4 * kq) * 1024 + h * 128 + 32 * j + c16;
#pragma unroll
            for (int tj = 0; tj < 2; ++tj)
#pragma unroll
                for (int i = 0; i < 4; ++i) st16_asm(op + (size_t)i * 1024 + 16 * tj, f2bf(p[tj][i]));
        }
    };
#pragma unroll
    for (int c = 0; c < NCHUNK - 2; c += 3) { step(c, RB); step(c + 1, RC); step(c + 2, RA); }
    step(NCHUNK - 2, RB); step(NCHUNK - 1, RC);
    float* so = a.out + O_PG + (((size_t)layer * NB + b) * 8 + h) * 16384;
#pragma unroll
    for (int tj = 0; tj < 2; ++tj)
#pragma unroll
        for (int i = 0; i < 4; ++i) so[(size_t)(16 * wave + 4 * kq + i) * 128 + 32 * j + 16 * tj + c16] = Sreg[tj][i];
    LBAR();
}

__device__ __forceinline__ void scan_gla_unit(const Args& a, LAS unsigned char* lds, int unit, int layer) {
    const int tid = ltid(), lane = tid & 63, wave = __builtin_amdgcn_readfirstlane(tid >> 6), c16 = lane & 15, kq = lane >> 4;
    const int j = unit & 7, h = (unit >> 3) & 3, b = unit >> 5;
    constexpr int OFF_ATT = 0, OFF_QB = 10240, OFF_KDT = 28672, OFF_VT = 49152, OFF_EBL = 54272, BUFSZ = 54784;
    LAS bf16_t* St0 = (LAS bf16_t*)(lds + 2 * BUFSZ);
    const bf16_t* L_QB = (const bf16_t*)(a.ws + WS_L_QB); const bf16_t* L_ATT = (const bf16_t*)(a.ws + WS_L_ATT); const bf16_t* L_KDT = (const bf16_t*)(a.ws + WS_L_KDT);
    const bf16_t* L_VT = (const bf16_t*)(a.ws + WS_L_VT); const float* L_EBL = (const float*)(a.ws + WS_L_EBL);
    bf16_t* OB = (bf16_t*)(a.ws + WS_OB);
    struct Regs { u32x4 r[7]; };
    auto issue = [&](Regs& R, int c) {
        const size_t uid = (size_t)((b * 32 + c) * 4 + h);
        const bf16_t* att = L_ATT + uid * 4096; const bf16_t* qb = L_QB + uid * 8192; const bf16_t* kdt = L_KDT + uid * 8192; const bf16_t* vt = L_VT + uid * 16384 + (size_t)(32 * j) * 64;
        R.r[0] = LD16(att + (size_t)tid * 8);
        R.r[1] = LD16(qb + (size_t)tid * 8); R.r[2] = LD16(qb + (size_t)(tid + 512) * 8);
        R.r[3] = LD16(kdt + (size_t)tid * 8); R.r[4] = LD16(kdt + (size_t)(tid + 512) * 8);
        R.r[5] = LD16(vt + (size_t)(tid & 255) * 8);
        R.r[6] = LD16((const bf16_t*)(L_EBL + uid * 128) + (size_t)(tid & 31) * 8);
    };
    auto commit = [&](const Regs& R, int buf) {
        LAS unsigned char* B = lds + buf * BUFSZ;
        *(LAS u32x4*)(B + OFF_ATT + ((tid >> 3) * 80 + (tid & 7) * 8) * 2) = R.r[0];
        *(LAS u32x4*)(B + OFF_QB + ((tid >> 4) * 144 + (tid & 15) * 8) * 2) = R.r[1]; *(LAS u32x4*)(B + OFF_QB + (((tid + 512) >> 4) * 144 + (tid & 15) * 8) * 2) = R.r[2];
        *(LAS u32x4*)(B + OFF_KDT + ((tid >> 3) * 80 + (tid & 7) * 8) * 2) = R.r[3]; *(LAS u32x4*)(B + OFF_KDT + (((tid + 512) >> 3) * 80 + (tid & 7) * 8) * 2) = R.r[4];
        if (tid < 256) *(LAS u32x4*)(B + OFF_VT + ((tid >> 3) * 80 + (tid & 7) * 8) * 2) = R.r[5];
        if (tid < 32) *(LAS u32x4*)(B + OFF_EBL + tid * 16) = R.r[6];
    };
    f32x4 Sreg[2] = {(f32x4){0.f, 0.f, 0.f, 0.f}, (f32x4){0.f, 0.f, 0.f, 0.f}};
#pragma unroll
    for (int tj = 0; tj < 2; ++tj) *(LAS u32x2*)(St0 + (16 * tj + c16) * 144 + 16 * wave + 4 * kq) = (u32x2){0u, 0u};
    Regs RA, RB, RC;
    issue(RA, 0); commit(RA, 0); issue(RB, 1); issue(RC, 2); issue(RA, 3);
    auto step = [&](int c, Regs& Rn) {
        LBAR();
        const LAS unsigned char* B = lds + (c & 1) * BUFSZ;
        const LAS bf16_t* ATT = (const LAS bf16_t*)(B + OFF_ATT); const LAS bf16_t* QB = (const LAS bf16_t*)(B + OFF_QB); const LAS bf16_t* KDT = (const LAS bf16_t*)(B + OFF_KDT);
        const LAS bf16_t* VT = (const LAS bf16_t*)(B + OFF_VT); const LAS float* EBL = (const LAS float*)(B + OFF_EBL);
        const LAS bf16_t* Sc = St0 + (c & 1) * (32 * 144); LAS bf16_t* Sn = St0 + ((c + 1) & 1) * (32 * 144);
        f32x4 oo;
        {
            const int ti = wave >> 1, tj = wave & 1;
            f32x4 o = (f32x4){0.f, 0.f, 0.f, 0.f};
#pragma unroll
            for (int ks = 0; ks < 2; ++ks) o = MFMA16(frag(ATT, 80, 16 * ti, 32 * ks, lane), frag(VT, 80, 16 * tj, 32 * ks, lane), o);
#pragma unroll
            for (int ks = 0; ks < 4; ++ks) o = MFMA16(frag(QB, 144, 16 * ti, 32 * ks, lane), frag(Sc, 144, 16 * tj, 32 * ks, lane), o);
            oo = o;
        }
        {
            const f32x4 e = *(const LAS f32x4*)(EBL + 16 * wave + 4 * kq);
#pragma unroll
            for (int tj = 0; tj < 2; ++tj) Sreg[tj] = Sreg[tj] * e;
#pragma unroll
            for (int ks = 0; ks < 2; ++ks) {
                const bf16x8 af = frag(KDT, 80, 16 * wave, 32 * ks, lane);
#pragma unroll
                for (int tj = 0; tj < 2; ++tj) Sreg[tj] = MFMA16(af, frag(VT, 80, 16 * tj, 32 * ks, lane), Sreg[tj]);
            }
#pragma unroll
            for (int tj = 0; tj < 2; ++tj) { u32x2 o; o.x = pk2(Sreg[tj][0], Sreg[tj][1]); o.y = pk2(Sreg[tj][2], Sreg[tj][3]); *(LAS u32x2*)(Sn + (16 * tj + c16) * 144 + 16 * wave + 4 * kq) = o; }
        }
        if (c + 1 < NCHUNK) { commit(Rn, (c + 1) & 1); if (c + 4 < NCHUNK) issue(Rn, c + 4); }
        {
            bf16_t* op = OB + ((size_t)b * SEQ + c * 64 + 16 * (wave >> 1) + 4 * kq) * 1024 + h * 256 + 32 * j + 16 * (wave & 1) + c16;
#pragma unroll
            for (int i = 0; i < 4; ++i) st16_asm(op + (size_t)i * 1024, f2bf(oo[i]));
        }
    };
#pragma unroll
    for (int c = 0; c < NCHUNK - 2; c += 3) { step(c, RB); step(c + 1, RC); step(c + 2, RA); }
    step(NCHUNK - 2, RB); step(NCHUNK - 1, RC);
    float* so = a.out + O_PL + (((size_t)layer * NB + b) * 4 + h) * 32768;
#pragma unroll
    for (int tj = 0; tj < 2; ++tj)
#pragma unroll
        for (int i = 0; i < 4; ++i) so[(size_t)(16 * wave + 4 * kq + i) * 256 + 32 * j + 16 * tj + c16] = Sreg[tj][i];
    LBAR();
}

template <int DUMMY>
__device__ __forceinline__ void scan_ssd_unit(const Args& a, LAS unsigned char* lds, int unit, int layer) {
    const int tid = ltid(), lane = tid & 63, wave = __builtin_amdgcn_readfirstlane(tid >> 6), c16 = lane & 15, kq = lane >> 4;
    const int h = unit & 31, b = unit >> 5, g = h >> 3;
    constexpr int OFF_MH = 0, OFF_X1 = 10240, OFF_X2 = 20480, OFF_BT = 30720, OFF_EA = 51200, BUFSZ = 51456;
    LAS bf16_t* Hs0 = (LAS bf16_t*)(lds + 2 * BUFSZ);
    const bf16_t* S_MH = (const bf16_t*)(a.ws + WS_S_MH); const bf16_t* S_X1 = (const bf16_t*)(a.ws + WS_S_XDTT); const bf16_t* S_X2 = (const bf16_t*)(a.ws + WS_S_XDT2T);
    const bf16_t* S_BT = (const bf16_t*)(a.ws + WS_S_BT); const float* S_EA = (const float*)(a.ws + WS_S_EA); const float* S_EAL = (const float*)(a.ws + WS_S_EAL);
    const bf16_t* XBC = (const bf16_t*)(a.ws + WS_XBC); bf16_t* YC = (bf16_t*)(a.ws + WS_YC);
    struct Regs { u32x4 r[6]; bf16x8 rc[4]; };
    const int ti = wave >> 1;
    auto issue = [&](Regs& R, int c) {
        const size_t su = (size_t)((b * 32 + c) * 32 + h), sg = (size_t)((b * 32 + c) * 4 + g);
        R.r[0] = LD16(S_MH + su * 4096 + (size_t)tid * 8); R.r[1] = LD16(S_X1 + su * 4096 + (size_t)tid * 8); R.r[2] = LD16(S_X2 + su * 4096 + (size_t)tid * 8);
        R.r[3] = LD16(S_BT + sg * 8192 + (size_t)tid * 8); R.r[4] = LD16(S_BT + sg * 8192 + (size_t)(tid + 512) * 8);
        R.r[5] = LD16((const bf16_t*)(S_EA + su * 64) + (size_t)(tid & 15) * 8);
        const bf16_t* cr = XBC + ((size_t)b * SEQ + c * 64 + 16 * ti + c16) * 3072 + 2560 + g * 128 + 8 * kq;
#pragma unroll
        for (int ks = 0; ks < 4; ++ks) { if (DUMMY != 2) R.rc[ks] = *(const bf16x8*)(cr + 32 * ks); else R.rc[ks] = __builtin_bit_cast(bf16x8, R.r[ks]); }
    };
    auto commit = [&](const Regs& R, int buf) {
        LAS unsigned char* B = lds + buf * BUFSZ;
        const int o = ((tid >> 3) * 80 + (tid & 7) * 8) * 2;
        *(LAS u32x4*)(B + OFF_MH + o) = R.r[0]; *(LAS u32x4*)(B + OFF_X1 + o) = R.r[1]; *(LAS u32x4*)(B + OFF_X2 + o) = R.r[2];
        *(LAS u32x4*)(B + OFF_BT + o) = R.r[3]; *(LAS u32x4*)(B + OFF_BT + (((tid + 512) >> 3) * 80 + (tid & 7) * 8) * 2) = R.r[4];
        if (tid < 16) *(LAS u32x4*)(B + OFF_EA + tid * 16) = R.r[5];
    };
    f32x4 Hreg[4];
#pragma unroll
    for (int tp = 0; tp < 4; ++tp) { Hreg[tp] = (f32x4){0.f, 0.f, 0.f, 0.f}; *(LAS u32x2*)(Hs0 + (16 * tp + c16) * 144 + 16 * wave + 4 * kq) = (u32x2){0u, 0u}; }
    Regs RA, RB;
    issue(RA, 0); commit(RA, 0);
    bf16x8 cc[4] = {RA.rc[0], RA.rc[1], RA.rc[2], RA.rc[3]};
    issue(RB, 1); issue(RA, 2);
    auto step = [&](int c, Regs& Rn) {
        LBAR();
        const LAS unsigned char* B = lds + (c & 1) * BUFSZ;
        const LAS bf16_t* MH = (const LAS bf16_t*)(B + OFF_MH); const LAS bf16_t* X1 = (const LAS bf16_t*)(B + OFF_X1); const LAS bf16_t* X2 = (const LAS bf16_t*)(B + OFF_X2);
        const LAS bf16_t* BT = (const LAS bf16_t*)(B + OFF_BT); const LAS float* EA = (const LAS float*)(B + OFF_EA);
        const LAS bf16_t* Hc = Hs0 + (c & 1) * (64 * 144); LAS bf16_t* Hn = Hs0 + ((c + 1) & 1) * (64 * 144);
        f32x4 yy[2];
        {
            const f32x4 ea = *(const LAS f32x4*)(EA + 16 * ti + 4 * kq);
#pragma unroll
            for (int q = 0; q < 2; ++q) {
                const int tp = 2 * (wave & 1) + q;
                f32x4 y1 = (f32x4){0.f, 0.f, 0.f, 0.f}, y2 = (f32x4){0.f, 0.f, 0.f, 0.f};
#pragma unroll
                for (int ks = 0; ks < 2; ++ks) y1 = MFMA16(frag(MH, 80, 16 * ti, 32 * ks, lane), frag(X1, 80, 16 * tp, 32 * ks, lane), y1);
#pragma unroll
                for (int ks = 0; ks < 4; ++ks) y2 = MFMA16(cc[ks], frag(Hc, 144, 16 * tp, 32 * ks, lane), y2);
                yy[q] = y1 + ea * y2;
            }
        }
        const float ceal = EA[63];
#pragma unroll
        for (int tp = 0; tp < 4; ++tp) Hreg[tp] = Hreg[tp] * ceal;
#pragma unroll
        for (int ks = 0; ks < 2; ++ks) {
            const bf16x8 af = frag(BT, 80, 16 * wave, 32 * ks, lane);
#pragma unroll
            for (int tp = 0; tp < 4; ++tp) Hreg[tp] = MFMA16(af, frag(X2, 80, 16 * tp, 32 * ks, lane), Hreg[tp]);
        }
#pragma unroll
        for (int tp = 0; tp < 4; ++tp) { u32x2 o; o.x = pk2(Hreg[tp][0], Hreg[tp][1]); o.y = pk2(Hreg[tp][2], Hreg[tp][3]); *(LAS u32x2*)(Hn + (16 * tp + c16) * 144 + 16 * wave + 4 * kq) = o; }
        if (c + 1 < NCHUNK) { commit(Rn, (c + 1) & 1); cc[0] = Rn.rc[0]; cc[1] = Rn.rc[1]; cc[2] = Rn.rc[2]; cc[3] = Rn.rc[3]; if (c + 3 < NCHUNK) issue(Rn, c + 3); }
        {
            bf16_t* yp = YC + ((size_t)b * SEQ + c * 64 + 16 * ti + 4 * kq) * 2048 + h * 64 + 32 * (wave & 1) + c16;
#pragma unroll
            for (int q = 0; q < 2; ++q)
#pragma unroll
                for (int i = 0; i < 4; ++i) { if (DUMMY != 1) st16_asm(yp + (size_t)i * 2048 + 16 * q, f2bf(yy[q][i])); else asm volatile("" :: "v"(yy[q][i])); }
        }
    };
#pragma unroll
    for (int c = 0; c < NCHUNK; c += 2) { step(c, RB); step(c + 1, RA); }
    float* so = a.out + O_PS + (((size_t)layer * NB + b) * 32 + h) * 8192;
#pragma unroll
    for (int tp = 0; tp < 4; ++tp) { if (DUMMY == 0) *(f32x4*)(so + (size_t)(16 * tp + c16) * 128 + 16 * wave + 4 * kq) = Hreg[tp]; else asm volatile("" :: "v"(Hreg[tp])); }
    LBAR();
}

__device__ __forceinline__ void samp_gdn_loop(const Args& a, LAS unsigned char* lds, int u0, int ustride, int uend, int layer) {
    const int tid = ltid();
    LAS float* sk = (LAS float*)lds, *sq = sk + 128, *sv = sk + 256, *sw = sk + 384, *red = sk + 512;
    const int dv = 4 * (tid & 31), dkb = tid >> 5;
    if (u0 >= uend) return;
    f32x4 S[8], Sn[8];
    { const int h = u0 & 7, s = u0 >> 3; const float* Sin = a.in[3] + (((size_t)layer * NS + s) * 8 + h) * 16384;
#pragma unroll
      for (int i = 0; i < 8; ++i) S[i] = __builtin_nontemporal_load((const f32x4*)(Sin + (size_t)(8 * dkb + i) * 128 + dv)); }
#pragma unroll 1
    for (int unit = u0; unit < uend; unit += ustride) {
        const int h = unit & 7, s = unit >> 3, m = NPT + s, un = unit + ustride;
        if (un < uend) { const int hn = un & 7, sn = un >> 3; const float* Sin = a.in[3] + (((size_t)layer * NS + sn) * 8 + hn) * 16384;
#pragma unroll
            for (int i = 0; i < 8; ++i) Sn[i] = __builtin_nontemporal_load((const f32x4*)(Sin + (size_t)(8 * dkb + i) * 128 + dv)); }
        const bf16_t* GQKV = (const bf16_t*)(a.ws + WS_GQKV) + (size_t)m * 3072; const float* GB = (const float*)(a.ws + WS_GB) + (size_t)m * 16;
        float* Sout = a.out + O_SG + (((size_t)layer * NS + s) * 8 + h) * 16384;
        if (tid < 128) { sq[tid] = bf2f(GQKV[h * 128 + tid]); sk[tid] = bf2f(GQKV[1024 + h * 128 + tid]); sv[tid] = bf2f(GQKV[2048 + h * 128 + tid]); }
        const float beta = GB[h], eg = __expf(GB[8 + h]);
        LBAR();
        f32x4 part = (f32x4){0.f, 0.f, 0.f, 0.f};
#pragma unroll
        for (int i = 0; i < 8; ++i) part = part + S[i] * sk[8 * dkb + i];
        *(LAS f32x4*)(red + dkb * 128 + dv) = part;
        LBAR();
        if (tid < 128) { float ks = 0.f;
#pragma unroll
            for (int i = 0; i < 16; ++i) ks += red[i * 128 + tid];
            sw[tid] = beta * (sv[tid] - eg * ks); }
        LBAR();
        const f32x4 w = *(const LAS f32x4*)(sw + dv);
        part = (f32x4){0.f, 0.f, 0.f, 0.f};
#pragma unroll
        for (int i = 0; i < 8; ++i) { S[i] = S[i] * eg + w * sk[8 * dkb + i]; __builtin_nontemporal_store(S[i], (f32x4*)(Sout + (size_t)(8 * dkb + i) * 128 + dv)); part = part + S[i] * sq[8 * dkb + i]; }
        *(LAS f32x4*)(red + dkb * 128 + dv) = part;
        LBAR();
        if (tid < 128) { float o = 0.f;
#pragma unroll
            for (int i = 0; i < 16; ++i) o += red[i * 128 + tid];
            ((bf16_t*)(a.ws + WS_OA))[(size_t)m * 1024 + h * 128 + tid] = (bf16_t)f2bf(o); }
        LBAR();
#pragma unroll
        for (int i = 0; i < 8; ++i) S[i] = Sn[i];
    }
}
__device__ __forceinline__ void samp_gla_loop(const Args& a, LAS unsigned char* lds, int u0, int ustride, int uend, int layer) {
    const int tid = ltid();
    LAS float* sk = (LAS float*)lds, *sq = sk + 128, *se = sk + 256, *sv = sk + 384, *red = sk + 640;
    const int dv = 4 * (tid & 63), dkb = tid >> 6;
    if (u0 >= uend) return;
    f32x4 S[16], Sn[16];
    { const int h = u0 & 3, s = u0 >> 2; const float* Sin = a.in[4] + (((size_t)layer * NS + s) * 4 + h) * 32768;
#pragma unroll
      for (int i = 0; i < 16; ++i) S[i] = __builtin_nontemporal_load((const f32x4*)(Sin + (size_t)(16 * dkb + i) * 256 + dv)); }
#pragma unroll 1
    for (int unit = u0; unit < uend; unit += ustride) {
        const int h = unit & 3, s = unit >> 2, m = NPT + s, un = unit + ustride;
        if (un < uend) { const int hn = un & 3, sn = un >> 2; const float* Sin = a.in[4] + (((size_t)layer * NS + sn) * 4 + hn) * 32768;
#pragma unroll
            for (int i = 0; i < 16; ++i) Sn[i] = __builtin_nontemporal_load((const f32x4*)(Sin + (size_t)(16 * dkb + i) * 256 + dv)); }
        const bf16_t* PR = (const bf16_t*)(a.ws + WS_PROJ) + (size_t)m * PW; const float* LA = (const float*)(a.ws + WS_LA) + (size_t)m * 512;
        float* Sout = a.out + O_SL + (((size_t)layer * NS + s) * 4 + h) * 32768;
        if (tid < 128) { sq[tid] = bf2f(PR[P_QB + h * 128 + tid]) * 0.08838834764831845f; sk[tid] = bf2f(PR[P_KB + h * 128 + tid]); se[tid] = __expf(LA[h * 128 + tid]); }
        if (tid < 256) sv[tid] = bf2f(PR[P_VB + h * 256 + tid]);
        LBAR();
        const f32x4 v = *(const LAS f32x4*)(sv + dv);
        f32x4 part = (f32x4){0.f, 0.f, 0.f, 0.f};
#pragma unroll
        for (int i = 0; i < 16; ++i) { const int dk = 16 * dkb + i; S[i] = S[i] * se[dk] + v * sk[dk]; __builtin_nontemporal_store(S[i], (f32x4*)(Sout + (size_t)dk * 256 + dv)); part = part + S[i] * sq[dk]; }
        *(LAS f32x4*)(red + dkb * 256 + dv) = part;
        LBAR();
        if (tid < 256) { float o = 0.f;
#pragma unroll
            for (int i = 0; i < 8; ++i) o += red[i * 256 + tid];
            ((bf16_t*)(a.ws + WS_OB))[(size_t)m * 1024 + h * 256 + tid] = (bf16_t)f2bf(o); }
        LBAR();
#pragma unroll
        for (int i = 0; i < 16; ++i) S[i] = Sn[i];
    }
}
__device__ __forceinline__ void samp_ssd_loop(const Args& a, int u0, int ustride, int uend, int layer) {
    const int tid = ltid(), lane = tid & 63, wave = __builtin_amdgcn_readfirstlane(tid >> 6);
    const int n = 4 * (lane & 31), pb = 32 * (lane >> 5);
#pragma unroll 1
    for (int unit = u0; unit < uend; unit += ustride) {
        const int g = unit & 3, s = unit >> 2, m = NPT + s, h = g * 8 + wave;
        const bf16_t* XB = (const bf16_t*)(a.ws + WS_XBC) + (size_t)m * 3072; const float dt = ((const float*)(a.ws + WS_DT))[(size_t)m * 32 + h];
        const float dA = __expf(dt * -__expf(a.in[30][layer * 32 + h]));
        const float* Hin = a.in[6] + (((size_t)layer * NS + s) * 32 + h) * 8192 + (size_t)pb * 128 + n; float* Hout = a.out + O_SS + (((size_t)layer * NS + s) * 32 + h) * 8192 + (size_t)pb * 128 + n;
        const u32x2 bw = *(const u32x2*)(XB + 2048 + g * 128 + n), cw = *(const u32x2*)(XB + 2560 + g * 128 + n);
        const f32x4 Bv = (f32x4){bflo(bw.x), bfhi(bw.x), bflo(bw.y), bfhi(bw.y)} * dt, Cv = (f32x4){bflo(cw.x), bfhi(cw.x), bflo(cw.y), bfhi(cw.y)};
        bf16_t* YC = (bf16_t*)(a.ws + WS_YC) + (size_t)m * 2048 + h * 64 + pb;
        f32x4 hv[8], hn8[8];
#pragma unroll
        for (int i = 0; i < 8; ++i) hv[i] = __builtin_nontemporal_load((const f32x4*)(Hin + (size_t)i * 128));
#pragma unroll
        for (int i0 = 0; i0 < 32; i0 += 8) {
            if (i0 + 8 < 32) {
#pragma unroll
                for (int i = 0; i < 8; ++i) hn8[i] = __builtin_nontemporal_load((const f32x4*)(Hin + (size_t)(i0 + 8 + i) * 128));
            }
            const u32x4 xw = *(const u32x4*)(XB + h * 64 + pb + i0);
            float xs[8]; unpack8(xw, xs);
#pragma unroll
            for (int i = 0; i < 8; ++i) {
                const f32x4 hnew = hv[i] * dA + Bv * xs[i]; __builtin_nontemporal_store(hnew, (f32x4*)(Hout + (size_t)(i0 + i) * 128));
                float y = (hnew.x * Cv.x + hnew.y * Cv.y) + (hnew.z * Cv.z + hnew.w * Cv.w);
                y += __shfl_xor(y, 1); y += __shfl_xor(y, 2); y += __shfl_xor(y, 4); y += __shfl_xor(y, 8); y += __shfl_xor(y, 16);
                if ((lane & 31) == 0) YC[i0 + i] = (bf16_t)f2bf(y);
            }
#pragma unroll
            for (int i = 0; i < 8; ++i) hv[i] = hn8[i];
        }
    }
}
#ifndef REPMASK
#define REPMASK 0
#endif
__device__ __forceinline__ void m3_phase(const Args& a, LAS unsigned char* lds, int vcu, int G, int layer) {
#pragma unroll 1
    for (int u = vcu; u < 256; u += G) { if (u < 128) { scan_gdn_unit(a, lds, u, layer); scan_gla_unit(a, lds, u, layer); } else scan_ssd_unit<0>(a, lds, u - 128, layer); }
    int g0 = vcu, gs = G, ge = 1024, l0 = vcu, ls = G, le = 512;
    if (G == 256) { const int r = vcu & 127; gs = 128; ls = 128;
        if (vcu < 128) { g0 = r; ge = 256; l0 = r; le = 128; } else { g0 = 256 + r; ge = 1024; l0 = 128 + r; le = 512; } }
    samp_gdn_loop(a, lds, g0, gs, ge, layer);
    samp_gla_loop(a, lds, l0, ls, le, layer);
    samp_ssd_loop(a, vcu, G, 512, layer);
}

__device__ __forceinline__ void m4_phase(const Args& a, int vcu, int G, int layer) {
    const int tid = ltid(), lane = tid & 63, wave = __builtin_amdgcn_readfirstlane(tid >> 6);
    const int gw = vcu * NWAVES + wave, NGW = G * NWAVES;
    const bf16_t* PROJ = (const bf16_t*)(a.ws + WS_PROJ); const bf16_t* OA = (const bf16_t*)(a.ws + WS_OA); const bf16_t* OB = (const bf16_t*)(a.ws + WS_OB); const bf16_t* YC = (const bf16_t*)(a.ws + WS_YC);
    const bf16_t* XBC = (const bf16_t*)(a.ws + WS_XBC); bf16_t* BR = (bf16_t*)(a.ws + WS_BR);
    const float* gnw = a.in[24] + (size_t)layer * 128; const float* lnw = a.in[27] + (size_t)layer * 256; const float* snw = a.in[33] + (size_t)layer * 2048; const float* sd = a.in[32] + (size_t)layer * 32;
    auto gdn_piece = [&](int m, int it, const u32x4 loa, const u32x4 lza) __attribute__((always_inline)) {
        const int ch = it * 512 + lane * 8; float o[8], z[8];
        unpack8(loa, o); unpack8(lza, z);
        float ss = 0.f;
#pragma unroll
        for (int i = 0; i < 8; ++i) ss += o[i] * o[i];
        ss += __shfl_xor(ss, 1); ss += __shfl_xor(ss, 2); ss += __shfl_xor(ss, 4); ss += __shfl_xor(ss, 8);
        const float r = 1.0f / sqrtf(ss * (1.f / 128.f) + EPS);
        const f32x4 w0 = *(const f32x4*)(gnw + (ch & 127)), w1 = *(const f32x4*)(gnw + (ch & 127) + 4);
#pragma unroll
        for (int i = 0; i < 4; ++i) { o[i] = o[i] * r * w0[i] * siluf_(z[i]); o[4 + i] = o[4 + i] * r * w1[i] * siluf_(z[4 + i]); }
        *(u32x4*)(BR + (size_t)m * 4096 + ch) = pack8(o);
    };
    auto gla_piece = [&](int m, int it, const u32x4 lob, const u32x4 lrb) __attribute__((always_inline)) {
        const int ch = it * 512 + lane * 8; float o[8], z[8];
        unpack8(lob, o); unpack8(lrb, z);
        float ss = 0.f;
#pragma unroll
        for (int i = 0; i < 8; ++i) ss += o[i] * o[i];
        ss += __shfl_xor(ss, 1); ss += __shfl_xor(ss, 2); ss += __shfl_xor(ss, 4); ss += __shfl_xor(ss, 8); ss += __shfl_xor(ss, 16);
        const float r = 1.0f / sqrtf(ss * (1.f / 256.f) + EPS);
        const f32x4 w0 = *(const f32x4*)(lnw + (ch & 255)), w1 = *(const f32x4*)(lnw + (ch & 255) + 4);
#pragma unroll
        for (int i = 0; i < 4; ++i) { o[i] = o[i] * r * w0[i] * siluf_(z[i]); o[4 + i] = o[4 + i] * r * w1[i] * siluf_(z[4 + i]); }
        *(u32x4*)(BR + (size_t)m * 4096 + 1024 + ch) = pack8(o);
    };
    auto ssd_piece = [&](int m, int it, const u32x4 lyc, const u32x4 lxc, const u32x4 lzc) __attribute__((always_inline)) {
        const int ch = it * 512 + lane * 8; float y[8], x[8], z[8];
        unpack8(lyc, y); unpack8(lxc, x); unpack8(lzc, z);
        const float dd = sd[ch >> 6]; float ss = 0.f;
#pragma unroll
        for (int i = 0; i < 8; ++i) { y[i] = (y[i] + dd * x[i]) * siluf_(z[i]); ss += y[i] * y[i]; }
        ss = wave_sum(ss);
        const float r = 1.0f / sqrtf(ss * (1.f / 512.f) + EPS);
        const f32x4 w0 = *(const f32x4*)(snw + ch), w1 = *(const f32x4*)(snw + ch + 4);
#pragma unroll
        for (int i = 0; i < 4; ++i) { y[i] = y[i] * r * w0[i]; y[4 + i] = y[4 + i] * r * w1[i]; }
        *(u32x4*)(BR + (size_t)m * 4096 + 2048 + ch) = pack8(y);
    };
#pragma unroll 1
    for (int m = gw; m < NPT; m += NGW) {
        const bf16_t* pr = PROJ + (size_t)m * PW;
        u32x4 l_oa[2], l_za[2], l_ob[2], l_rb[2], l_yc[4], l_xc[4], l_zc[4];
#pragma unroll
        for (int it = 0; it < 2; ++it) { const int ch = it * 512 + lane * 8;
            l_oa[it] = *(const u32x4*)(OA + (size_t)m * 1024 + ch); l_za[it] = *(const u32x4*)(pr + P_ZA + ch);
            l_ob[it] = *(const u32x4*)(OB + (size_t)m * 1024 + ch); l_rb[it] = *(const u32x4*)(pr + P_RB + ch); }
#pragma unroll
        for (int it = 0; it < 4; ++it) { const int ch = it * 512 + lane * 8;
            l_yc[it] = *(const u32x4*)(YC + (size_t)m * 2048 + ch); l_xc[it] = *(const u32x4*)(XBC + (size_t)m * 3072 + ch); l_zc[it] = *(const u32x4*)(pr + P_ZC + ch); }
#pragma unroll
        for (int it = 0; it < 2; ++it) gdn_piece(m, it, l_oa[it], l_za[it]);
#pragma unroll
        for (int it = 0; it < 2; ++it) gla_piece(m, it, l_ob[it], l_rb[it]);
#pragma unroll
        for (int it = 0; it < 4; ++it) ssd_piece(m, it, l_yc[it], l_xc[it], l_zc[it]);
    }
#pragma unroll 1
    for (int p = gw; p < 8 * NS; p += NGW) {
        const int m = NPT + (p >> 3), pc = p & 7; const bf16_t* pr = PROJ + (size_t)m * PW;
        if (pc < 2) { const int ch = pc * 512 + lane * 8; gdn_piece(m, pc, *(const u32x4*)(OA + (size_t)m * 1024 + ch), *(const u32x4*)(pr + P_ZA + ch)); }
        else if (pc < 4) { const int it = pc - 2, ch = it * 512 + lane * 8; gla_piece(m, it, *(const u32x4*)(OB + (size_t)m * 1024 + ch), *(const u32x4*)(pr + P_RB + ch)); }
        else { const int it = pc - 4, ch = it * 512 + lane * 8; ssd_piece(m, it, *(const u32x4*)(YC + (size_t)m * 2048 + ch), *(const u32x4*)(XBC + (size_t)m * 3072 + ch), *(const u32x4*)(pr + P_ZC + ch)); }
    }
}

#ifndef MK_N_LAUNCHES
#define MK_N_LAUNCHES 1
#endif
constexpr int PH_PER_LAYER = 14, N_PHASES = 2 + 2 * PH_PER_LAYER + 1;
constexpr int CW_BAR = 4096;

#define AS4 __attribute__((address_space(4)))
__device__ __forceinline__ Args load_args() {
    Args r;
#if defined(__HIP_DEVICE_COMPILE__)
    const AS4 Args* ap = (const AS4 Args*)__builtin_amdgcn_kernarg_segment_ptr(); asm volatile("" : "+s"(ap));
    for (int i = 0; i < 39; ++i) r.in[i] = ap->in[i]; r.out = ap->out; r.ws = ap->ws; r.ph_lo = ap->ph_lo; r.ph_hi = ap->ph_hi;
#else
    r = Args{};
#endif
    return r;
}
#define LAYER_PTRS unsigned char* lw = a.ws + WS_W + (size_t)layer * LW_SIZE; const float* modl = (const float*)(a.ws + WS_MOD) + (size_t)layer * NCR * NMOD; \
    float* X = (float*)(a.ws + WS_X); const bf16_t* H = (const bf16_t*)(a.ws + WS_H); bf16_t* ACT = (bf16_t*)(a.ws + WS_ACT); bf16_t* PROJ = (bf16_t*)(a.ws + WS_PROJ); float* SMALL = (float*)(a.ws + WS_SMALL); \
    bf16_t* BR = (bf16_t*)(a.ws + WS_BR); float* MRG = (float*)(a.ws + WS_MRG); bf16_t* MRGB = (bf16_t*)(a.ws + WS_MRGB); (void)lw; (void)modl; (void)X; (void)H; (void)ACT; (void)PROJ; (void)SMALL; (void)BR; (void)MRG; (void)MRGB;
#define PHASE_FN __device__ __forceinline__ void
PHASE_FN ph_gateup(LAS unsigned char* lds, int G, int bx, int layer, int which) {
    const Args a = load_args(); LAYER_PTRS
    pg8::Gemm g{H, (const bf16_t*)(lw + (which ? LW_GU2 : LW_GU1)), D}; pg8::Sched S; S.init(MP / 256, 2 * FF / 256, G, bx, D);
    EpiSwiglu E{ACT}; pg8::gemm_phase<EpiSwiglu>(lds, g, S, E);
#ifndef CVT_ALL_IN_P0
    {
        constexpr int NWG = (MP / 256) * (2 * FF / 256); const int rem = NWG % G, set = layer == 0 ? (which ? 3 : 1) : (which ? -1 : 4);
        if (rem != 0 && bx >= rem && set > 0) convert_set(a, lds, bx - rem, G - rem, set);
    }
#endif
}
PHASE_FN ph_down(LAS unsigned char* lds, int vcu, int G, int bx, int layer, int which) {
    const Args a = load_args(); LAYER_PTRS
    const bf16_t* W = (const bf16_t*)(lw + (which ? LW_D2 : LW_D1)); const float* gate = modl + (which ? 8 : 2) * D;
    pg8::Gemm g{ACT, W, FF}; pg8::Sched S; S.init(NPT / 256, D / 256, G, bx, FF); S.nmini = 8 * 21; S.mini_last_nt = 6;
    EpiResid E{X, gate, 0.5f, (float*)(a.ws + WS_PART)}; pg8::gemm_phase<EpiResid>(lds, g, S, E);
}
PHASE_FN ph_win(LAS unsigned char* lds, int G, int bx, int layer) {
    const Args a = load_args(); LAYER_PTRS
    pg8::Gemm g{H, (const bf16_t*)(lw + LW_IN), D}; pg8::Sched S; S.init(MP / 256, NINP / 256, G, bx, D);
    EpiWin E{PROJ, SMALL}; pg8::gemm_phase<EpiWin>(lds, g, S, E);
#ifndef CVT_ALL_IN_P0
    {
        constexpr int NWG = (MP / 256) * (NINP / 256); const int rem = NWG % G;
        if (rem != 0 && bx >= rem) convert_set(a, lds, bx - rem, G - rem, layer == 0 ? 2 : 5);
    }
#endif
}
PHASE_FN ph_branch(LAS unsigned char* lds, int vcu, int G, int bx, int layer) {
    const Args a = load_args(); LAYER_PTRS
    pg8::Gemm g{BR, (const bf16_t*)(lw + LW_BR), 4096}; pg8::Sched S; S.init(NPT / 256, D / 256, G, bx, 4096);
    S.nseg = 3;
    EpiBranch E{MRG, MRGB, PROJ}; pg8::gemm_phase<EpiBranch>(lds, g, S, E);
    skinny_branch(lds, vcu, G, BR, (const bf16_t*)(lw + LW_BR), MRGB, PROJ);
    if ((REPMASK >> 23) & 1) { skinny_gemm(a, lds, vcu, G, BR, 4096, (const bf16_t*)(lw + LW_BR), 4096, 3, 1024, 1024, 2048, 1, nullptr, nullptr, 0.f, MRGB, PROJ); skinny_gemm(a, lds, vcu, G, BR, 4096, (const bf16_t*)(lw + LW_BR), 4096, 3, 1024, 1024, 2048, 1, nullptr, nullptr, 0.f, MRGB, PROJ); skinny_gemm(a, lds, vcu, G, BR, 4096, (const bf16_t*)(lw + LW_BR), 4096, 3, 1024, 1024, 2048, 1, nullptr, nullptr, 0.f, MRGB, PROJ); }
}
PHASE_FN ph_out(LAS unsigned char* lds, int vcu, int G, int bx, int layer) {
    const Args a = load_args(); LAYER_PTRS
    pg8::Gemm g{MRGB, (const bf16_t*)(lw + LW_OUT), D}; pg8::Sched S; S.init(NPT / 256, D / 256, G, bx, D); S.nmini = 8 * 8; S.mini_last_nt = 4;
    EpiResid E{X, modl + 5 * D, 1.0f, (float*)(a.ws + WS_PART)}; pg8::gemm_phase<EpiResid>(lds, g, S, E);
}

__global__ void __launch_bounds__(NTHR, 2) mk_fwd(Args a0) {
    extern __shared__ __attribute__((aligned(16))) unsigned char lds_raw[];
    LAS unsigned char* lds = (LAS unsigned char*)lds_raw;
    const int G = gridDim.x, bx = blockIdx.x, vcu = (G % 8 == 0) ? (bx % 8) * (G / 8) + bx / 8 : bx;
    const int lo = a0.ph_lo, hi = a0.ph_hi;
    if (threadIdx.x < 16) ((LAS unsigned*)(lds + LDSCTL_OFF))[threadIdx.x] = 0u;
    __syncthreads();
    XcdBarrier bar; bar.bar = (unsigned*)(a0.ws + WS_CTL) + CW_BAR; bar.x = 0; bar.st = (volatile LAS unsigned*)(lds + LDSCTL_OFF);
    if (hi - lo > 1) bar = xcd_barrier_post((unsigned*)(a0.ws + WS_CTL) + CW_BAR, (volatile LAS unsigned*)(lds + LDSCTL_OFF));
#ifndef ONLY_PH
#define ONLY_PH -1
#endif
#define IN(k) ((ONLY_PH < 0 || ONLY_PH == (((k) < 2 || (k) == N_PHASES - 1) ? (k) : 2 + ((k) - 2) % PH_PER_LAYER)) && lo <= (k) && (k) < hi)
#ifndef REPMASK
#define REPMASK 0
#endif
#define REP(j) if ((REPMASK >> (j)) & 1)
#define SEAM(k) do { if (IN(k) && IN((k) + 1)) { xcd_barrier(bar); if ((REPMASK >> 24) & 1) { xcd_barrier(bar); xcd_barrier(bar); } } } while (0)
    if (IN(0)) { const Args a = load_args(); p0_convert(a, lds, vcu, G); REP(14) p0_convert(a, lds, vcu, G); } SEAM(0);
    if (IN(1)) { const Args a = load_args(); p1_mod(a, lds, vcu, G); REP(15) p1_mod(a, lds, vcu, G); } SEAM(1);
    for (int layer = 0; layer < 2; ++layer) {
        const int pb = 2 + layer * PH_PER_LAYER;
        if ((REPMASK >> 25) & 1) { const unsigned long long t0 = __builtin_amdgcn_s_memrealtime(); while (__builtin_amdgcn_s_memrealtime() - t0 < 20000ull) __builtin_amdgcn_s_sleep(32); }
        if (IN(pb + 0)) { const Args a = load_args(); const float* mod0 = (const float*)(a.ws + WS_MOD); norm_mod_phase(a, lds, vcu, G, layer, 0, layer == 0, layer == 0 ? 0 : 21, mod0 + 8 * D, 0.5f); } SEAM(pb + 0);
        if (IN(pb + 1)) { ph_gateup(lds, G, bx, layer, 0); REP(1) ph_gateup(lds, G, bx, layer, 0); } SEAM(pb + 1);
        if (IN(pb + 2)) ph_down(lds, vcu, G, bx, layer, 0); SEAM(pb + 2);
        if (IN(pb + 3)) { const Args a = load_args(); const float* modl = (const float*)(a.ws + WS_MOD) + (size_t)layer * NCR * NMOD; norm_mod_phase(a, lds, vcu, G, layer, 1, false, 21, modl + 2 * D, 0.5f); } SEAM(pb + 3);
        if (IN(pb + 4)) { ph_win(lds, G, bx, layer); REP(4) ph_win(lds, G, bx, layer); } SEAM(pb + 4);
        if (IN(pb + 5)) { const Args a = load_args(); m1_phase(a, vcu, G, layer); REP(5) m1_phase(a, vcu, G, layer); } SEAM(pb + 5);
        if (IN(pb + 6)) { const Args a = load_args(); m2_phase(a, lds, vcu, G, layer); REP(6) m2_phase(a, lds, vcu, G, layer); } SEAM(pb + 6);
        if (IN(pb + 7)) { const Args a = load_args(); m3_phase(a, lds, vcu, G, layer); REP(7) m3_phase(a, lds, vcu, G, layer); } SEAM(pb + 7);
        if (IN(pb + 8)) { const Args a = load_args(); m4_phase(a, vcu, G, layer); REP(8) m4_phase(a, vcu, G, layer); } SEAM(pb + 8);
        if (IN(pb + 9)) { ph_branch(lds, vcu, G, bx, layer); REP(9) ph_branch(lds, vcu, G, bx, layer); } SEAM(pb + 9);
        if (IN(pb + 10)) ph_out(lds, vcu, G, bx, layer); SEAM(pb + 10);
        if (IN(pb + 11)) { const Args a = load_args(); const float* modl = (const float*)(a.ws + WS_MOD) + (size_t)layer * NCR * NMOD; norm_mod_phase(a, lds, vcu, G, layer, 2, false, 8, modl + 5 * D, 1.0f); } SEAM(pb + 11);
        if (IN(pb + 12)) ph_gateup(lds, G, bx, layer, 1); SEAM(pb + 12);
        if (IN(pb + 13)) ph_down(lds, vcu, G, bx, layer, 1); SEAM(pb + 13);
    }
    { const Args af = load_args(); if (af.ph_lo <= N_PHASES - 1 && N_PHASES - 1 < af.ph_hi) {
    const Args a = af; const float* mod1 = (const float*)(a.ws + WS_MOD) + (size_t)NCR * NMOD; final_norm_phase(a, lds, vcu, G, 21, mod1 + 8 * D, 0.5f); } }
#undef IN
#undef SEAM
}

extern "C" void kernel_launch(void* const* d_in, const int* in_sizes, int n_in, void* d_out, int out_size, void* d_ws, size_t ws_size, hipStream_t stream) {
    static int grid = 0;
    if (grid == 0) {
        if (n_in != 39 || (size_t)out_size != O_END || ws_size < WS_END) {
            fprintf(stderr, "kernel_launch: built for 39 inputs, %zu outputs, >= %zu bytes of workspace; got n_in %d, out %d, ws %zu; nothing launched\n", (size_t)O_END, (size_t)WS_END, n_in, out_size, ws_size);
            grid = -1; return; }
        int dev = 0, cus = 0, per_cu = 0;
        if (hipGetDevice(&dev) != hipSuccess || hipDeviceGetAttribute(&cus, hipDeviceAttributeMultiprocessorCount, dev) != hipSuccess) { grid = -1; return; }
        if (hipFuncSetAttribute((const void*)mk_fwd, hipFuncAttributeMaxDynamicSharedMemorySize, LDS_BYTES) != hipSuccess) { fprintf(stderr, "kernel_launch: hipFuncSetAttribute failed\n"); grid = -1; return; }
        if (hipOccupancyMaxActiveBlocksPerMultiprocessor(&per_cu, (const void*)mk_fwd, NTHR, LDS_BYTES) != hipSuccess || per_cu < 1)
            fprintf(stderr, "kernel_launch: note: occupancy query reports %d workgroups per CU\n", per_cu);
        (void)hipGetLastError();
        grid = cus;
    }
    if (grid < 0) return;
    if (hipMemsetAsync((char*)d_ws + WS_CTL, 0, CTL_BYTES, stream) != hipSuccess) { fprintf(stderr, "kernel_launch: memset failed\n"); return; }
    Args a{};
    for (int i = 0; i < 39; ++i) a.in[i] = (const float*)d_in[i];
    a.out = (float*)d_out; a.ws = (unsigned char*)d_ws;
#if MK_N_LAUNCHES == 1
    a.ph_lo = 0; a.ph_hi = N_PHASES;
    hipLaunchKernelGGL(mk_fwd, dim3(grid), dim3(NTHR), LDS_BYTES, stream, a);
#else
    for (int p = 0; p < N_PHASES; ++p) { a.ph_lo = p; a.ph_hi = p + 1; hipLaunchKernelGGL(mk_fwd, dim3(grid), dim3(NTHR), LDS_BYTES, stream, a); }
#endif
    const hipError_t le = hipPeekAtLastError();
    if (le != hipSuccess) fprintf(stderr, "kernel_launch: launch failed: %s\n", hipGetErrorName(le));
}
```

```cpp
#define MK_N_LAUNCHES 1
#include <hip/hip_runtime.h>
#include <cstdio>
#include <cstdint>

#define LAS __attribute__((address_space(3)))
typedef unsigned short bf16_t;
typedef short bf16x8 __attribute__((ext_vector_type(8)));
typedef float f32x4 __attribute__((ext_vector_type(4)));
typedef float f32x2 __attribute__((ext_vector_type(2)));
typedef unsigned u32x4 __attribute__((ext_vector_type(4)));
typedef unsigned u32x2 __attribute__((ext_vector_type(2)));

constexpr int D = 2048, NB = 4, SEQ = 2048, NPT = NB * SEQ  , NS = 128  , MT = NPT + NS  , MP = 8448  ;
constexpr int NCR = NB + NS;
constexpr int FF = 5504, NMOD = 9 * D;
constexpr int NIN = 18496, PW = 18432  , NINP = 18688  , SW = 64  ;
constexpr int P_QKVA = 0, P_ZA = 3072, P_QB = 4096, P_KB = 4608, P_VB = 5120, P_RB = 6144, P_ZC = 7168, P_XBC = 9216, P_GATES = 12288;
constexpr int S_BETA = 0, S_DEC = 8, S_LR = 16, S_DT = 32;
constexpr int NCHUNK = 32, CH = 64;
constexpr float EPS = 1e-6f;

typedef __bf16 hwbf16x2 __attribute__((ext_vector_type(2)));
__device__ __forceinline__ unsigned pk2(float lo, float hi) { const f32x2 v = {lo, hi}; return __builtin_bit_cast(unsigned, __builtin_convertvector(v, hwbf16x2)); }
__device__ __forceinline__ unsigned f2bf(float f) { return pk2(f, f) & 0xffffu; }
__device__ __forceinline__ float bf2f(unsigned short b) { return __builtin_bit_cast(float, ((unsigned)b) << 16); }
__device__ __forceinline__ float bflo(unsigned w) { return __builtin_bit_cast(float, w << 16); }
__device__ __forceinline__ float bfhi(unsigned w) { return __builtin_bit_cast(float, w & 0xffff0000u); }
__device__ __forceinline__ float fast_rcp(float x) { return __builtin_amdgcn_rcpf(x); }
__device__ __forceinline__ float sigmoidf_(float x) { return fast_rcp(1.f + __expf(-x)); }
__device__ __forceinline__ float siluf_(float x) { return x * sigmoidf_(x); }
__device__ __forceinline__ float softplusf_(float x) { return fmaxf(x, 0.f) + __logf(1.f + __expf(-fabsf(x))); }
__device__ __forceinline__ float logsigmoidf_(float x) { return fminf(x, 0.f) - __logf(1.f + __expf(-fabsf(x))); }
__device__ __forceinline__ float wave_sum(float v) {
#pragma unroll
    for (int o = 1; o < 64; o <<= 1) v += __shfl_xor(v, o);
    return v;
}
__device__ __forceinline__ int ltid() { int t = threadIdx.x; asm volatile("" : "+v"(t)); return t; }
#define LBAR() do { asm volatile("s_waitcnt lgkmcnt(0)" ::: "memory"); __builtin_amdgcn_s_barrier(); asm volatile("" ::: "memory"); } while (0)
__device__ __forceinline__ float vload_f32(const float* p) { asm volatile("" : "+v"(p)); return *p; }
__device__ __forceinline__ void st16_asm(bf16_t* p, unsigned v) { asm volatile("global_store_short %0, %1, off" :: "v"(p), "v"(v) : "memory"); }
__device__ __forceinline__ u32x4 ld16_asm(const void* p) { u32x4 r; asm volatile("global_load_dwordx4 %0, %1, off" : "=v"(r) : "v"(p) : "memory"); return r; }
__device__ __forceinline__ float ld4_asm(const void* p) { float r; asm volatile("global_load_dword %0, %1, off" : "=v"(r) : "v"(p) : "memory"); return r; }
#define VMW_CASE(n) case n: asm volatile("s_waitcnt vmcnt(" #n ")" ::: "memory"); break;
__device__ __forceinline__ void wait_vm(int n) {
    switch (n) { VMW_CASE(0) VMW_CASE(4) VMW_CASE(7) VMW_CASE(8) VMW_CASE(9) VMW_CASE(11) VMW_CASE(12) VMW_CASE(14) VMW_CASE(15) VMW_CASE(16) VMW_CASE(17) VMW_CASE(18) VMW_CASE(19) VMW_CASE(20) VMW_CASE(22) VMW_CASE(23) VMW_CASE(24) VMW_CASE(25) VMW_CASE(26) VMW_CASE(27) VMW_CASE(28) VMW_CASE(30) VMW_CASE(33) VMW_CASE(34) VMW_CASE(36) VMW_CASE(42)
      default: asm volatile("s_waitcnt vmcnt(0)" ::: "memory"); break; }
}
#define LDS_WAIT() asm volatile("s_waitcnt lgkmcnt(0)" ::: "memory")
#define VM_WAIT() asm volatile("s_waitcnt vmcnt(0)" ::: "memory")

namespace pg8 {
constexpr int BM = 256, BK = 64, HALF = 128, HTB = HALF * BK * 2, STAGE_BYTES = 8 * HTB, NXCD = 8, WGM = 8;
__host__ __device__ __forceinline__ int lds_byte(int r, int c) { const int st = (r >> 4) * 2 + (c >> 5), rr = r & 15, cc = c & 31, ob = rr * 64 + cc * 2; return st * 1024 + (ob ^ (((ob >> 9) & 1) << 5)); }
__host__ __device__ __forceinline__ void stage_rc(int b, int& R, int& C) { const int st = b / 1024, sb = b % 1024, swz = sb ^ (((sb >> 9) & 1) << 5); R = (st >> 1) * 16 + swz / 64; C = (st & 1) * 32 + (swz % 64) / 2; }
__host__ __device__ __forceinline__ int perm32(int rho) { const int n = rho >> 4, i = rho & 15; return 8 * (i >> 2) + 4 * n + (i & 3); }

struct Unit { int pm, pn, k0, nt, seg; };
struct Gemm { const bf16_t* A; const bf16_t* Bt; int K; };

struct Sched {
    int nM, nN, nwg, G, c, nseg, nt;
    int nmini, mini_last_nt;
    __device__ __forceinline__ void init(int nM_, int nN_, int G_, int c_, int K) { nM = nM_; nN = nN_; nwg = nM * nN; G = G_; c = c_; nseg = 1; nt = K / BK; nmini = 0; mini_last_nt = 4; }
    __device__ __forceinline__ bool next(int i, Unit& u) const {
        const int ui = (nseg == 1) ? i : i / 3, sg = (nseg == 1) ? 0 : i - 3 * ui;
        const long L = (long)ui * G + c;
        if (L >= nwg) {
            const int mi = (int)(L - nwg); if (mi >= nmini) return false;
            const int chunk = mi / nN; u.pm = nM; u.pn = mi - chunk * nN; u.k0 = chunk * 4 * BK; u.nt = (mi + nN >= nmini) ? mini_last_nt : 4; u.seg = 1; return true;
        }
        int wgid = (int)L; { const int q = nwg / NXCD, r = nwg % NXCD, xcd = wgid % NXCD, off = wgid / NXCD; wgid = (xcd < r ? xcd * (q + 1) : r * (q + 1) + (xcd - r) * q) + off; }
        const int nig = WGM * nN, gid = wgid / nig, fm = gid * WGM, gsz = (nM - fm) < WGM ? (nM - fm) : WGM;
        u.pm = fm + ((wgid % nig) % gsz); u.pn = (wgid % nig) / gsz;
        u.k0 = sg * 1024; u.nt = (nseg == 1) ? nt : (sg == 2 ? 32 : 16); u.seg = sg; return true;
    }
};
__device__ __forceinline__ unsigned cvt_pk_bf16(float lo, float hi) { unsigned r; asm volatile("v_cvt_pk_bf16_f32 %0, %1, %2" : "=v"(r) : "v"(lo), "v"(hi)); return r; }

template <class Epi>
__device__ __forceinline__ void gemm_phase(LAS unsigned char* lds, const Gemm g, const Sched& S, const Epi& E) {
    const int tid = ltid(), wid = __builtin_amdgcn_readfirstlane(tid >> 6), lane = tid & 63, wr = wid >> 2, wc = wid & 3, fr = lane & 15, fq = lane >> 4;
    const int K = g.K;
    unsigned voffA[2], voffB[2];
#pragma unroll
    for (int i = 0; i < 2; ++i) { int R, C; stage_rc(tid * 16 + i * 8192, R, C); const int Rb = Epi::PERM ? ((R & ~31) + perm32(R & 31)) : R;
        voffA[i] = (unsigned)(R * K + C) * 2u; voffB[i] = (unsigned)(Rb * K + C) * 2u; }
    const size_t kstep = (size_t)(BK * 2);
    const size_t hstep = (size_t)HALF * K * 2;
    const size_t tstep = 2 * hstep;
    const unsigned ldsw = (unsigned)wid * 1024u;
    const int aoff = lds_byte(wr * 64 + fr, fq * 8), boff = lds_byte(wc * 32 + fr, fq * 8);
#define PG8_SA(b, h) (((b) * 2 + (h)) * HTB)
#define PG8_SB(b, h) ((4 + (b) * 2 + (h)) * HTB)
#define PG8_STAGE(bufoff, gbase, voff) do { _Pragma("unroll") for (int _i = 0; _i < 2; ++_i) \
        __builtin_amdgcn_global_load_lds((const unsigned*)((const char*)(gbase) + (voff)[_i]), (LAS unsigned*)(lds + (bufoff) + ldsw + _i * 8192), 16, 0, 0); } while (0)
#define PG8_LDA(dst, b, h) do { _Pragma("unroll") for (int m = 0; m < 4; ++m) _Pragma("unroll") for (int k = 0; k < 2; ++k) dst[m][k] = *(const LAS bf16x8*)(lds + PG8_SA(b, h) + aoff + m * 2048 + k * 1024); } while (0)
#define PG8_LDB(dst, b, h) do { _Pragma("unroll") for (int n = 0; n < 2; ++n) _Pragma("unroll") for (int k = 0; k < 2; ++k) dst[n][k] = *(const LAS bf16x8*)(lds + PG8_SB(b, h) + boff + n * 2048 + k * 1024); } while (0)
#define PG8_MMA(ai, bj, At, Bt) do { __builtin_amdgcn_s_setprio(1); _Pragma("unroll") for (int m = 0; m < 4; ++m) _Pragma("unroll") for (int n = 0; n < 2; ++n) _Pragma("unroll") for (int k = 0; k < 2; ++k) \
        acc[ai][bj][m][n] = __builtin_amdgcn_mfma_f32_16x16x32_bf16(Bt[n][k], At[m][k], acc[ai][bj][m][n], 0, 0, 0); __builtin_amdgcn_s_setprio(0); } while (0)
#define PG8_WAIT_V(n) asm volatile("s_waitcnt vmcnt(" #n ")" ::: "memory")
#define PG8_WAIT_L(n) asm volatile("s_waitcnt lgkmcnt(" #n ")" ::: "memory")
#define PG8_BAR __builtin_amdgcn_s_barrier()
#define PG8_SCHED __builtin_amdgcn_sched_barrier(0)
    Unit cur, nxt; int ui = 0;
    if (!S.next(0, cur)) return;
    f32x4 acc[2][2][4][2];
#pragma unroll
    for (int a = 0; a < 2; ++a)
#pragma unroll
        for (int b = 0; b < 2; ++b)
#pragma unroll
            for (int m = 0; m < 4; ++m)
#pragma unroll
                for (int n = 0; n < 2; ++n) acc[a][b][m][n] = (f32x4){0.f, 0.f, 0.f, 0.f};
    bf16x8 At[4][2], B0[2][2], B1[2][2];
    const char* cA = (const char*)g.A + (size_t)cur.pm * tstep + (size_t)cur.k0 * 2; const char* cB = (const char*)g.Bt + (size_t)cur.pn * tstep + (size_t)cur.k0 * 2;
    PG8_STAGE(PG8_SB(0, 0), cB, voffB); PG8_STAGE(PG8_SB(0, 1), cB + hstep, voffB); PG8_STAGE(PG8_SA(0, 0), cA, voffA); PG8_STAGE(PG8_SA(0, 1), cA + hstep, voffA);
    if (wr == 1) PG8_BAR;
    PG8_WAIT_V(2); PG8_BAR;
    PG8_STAGE(PG8_SB(1, 0), cB + kstep, voffB); PG8_STAGE(PG8_SA(1, 0), cA + kstep, voffA); PG8_STAGE(PG8_SB(1, 1), cB + hstep + kstep, voffB);
    PG8_WAIT_V(6); PG8_BAR;
    for (;;) {
        const bool has_next = S.next(ui + 1, nxt);
        const char* nA = has_next ? (const char*)g.A + (size_t)nxt.pm * tstep + (size_t)nxt.k0 * 2 : cA; const char* nB = has_next ? (const char*)g.Bt + (size_t)nxt.pn * tstep + (size_t)nxt.k0 * 2 : cB;
        const int nt = cur.nt;
        for (int t = 0; t < nt; t += 2) {
            const bool last = (t == nt - 2);
            const char* a1 = cA + (size_t)(t + 1) * kstep;
            const char* a2 = last ? nA : cA + (size_t)(t + 2) * kstep; const char* b2 = last ? nB : cB + (size_t)(t + 2) * kstep;
            const char* a3 = a2 + kstep; const char* b3 = b2 + kstep;
            PG8_LDB(B0, 0, 0); PG8_LDB(B1, 0, 1); PG8_SCHED; PG8_LDA(At, 0, 0); PG8_STAGE(PG8_SA(1, 1), a1 + hstep, voffA);
            PG8_WAIT_V(8); PG8_WAIT_L(0); PG8_BAR; PG8_MMA(0, 0, At, B0); PG8_MMA(0, 1, At, B1); PG8_BAR; PG8_SCHED;
            PG8_LDA(At, 0, 1); PG8_STAGE(PG8_SB(0, 0), b2, voffB); PG8_STAGE(PG8_SB(0, 1), b2 + hstep, voffB); PG8_STAGE(PG8_SA(0, 0), a2, voffA);
            PG8_WAIT_V(8); PG8_WAIT_L(0); PG8_BAR; PG8_MMA(1, 0, At, B0); PG8_MMA(1, 1, At, B1); PG8_BAR; PG8_SCHED;
            PG8_LDB(B0, 1, 0); PG8_LDB(B1, 1, 1); PG8_SCHED; PG8_LDA(At, 1, 0); PG8_STAGE(PG8_SA(0, 1), a2 + hstep, voffA);
            PG8_WAIT_V(8); PG8_WAIT_L(0); PG8_BAR; PG8_MMA(0, 0, At, B0); PG8_MMA(0, 1, At, B1); PG8_BAR; PG8_SCHED;
            PG8_LDA(At, 1, 1); PG8_STAGE(PG8_SB(1, 0), b3, voffB); PG8_STAGE(PG8_SB(1, 1), b3 + hstep, voffB); PG8_STAGE(PG8_SA(1, 0), a3, voffA);
            PG8_WAIT_V(8); PG8_WAIT_L(0); PG8_BAR; PG8_MMA(1, 0, At, B0); PG8_MMA(1, 1, At, B1); PG8_BAR; PG8_SCHED;
        }
        if (wr == 0) PG8_BAR;
        E(acc, cur, wr, wc, fr, fq);
        if (!has_next) break;
#pragma unroll
        for (int a = 0; a < 2; ++a)
#pragma unroll
            for (int b = 0; b < 2; ++b)
#pragma unroll
                for (int m = 0; m < 4; ++m)
#pragma unroll
                    for (int n = 0; n < 2; ++n) acc[a][b][m][n] = (f32x4){0.f, 0.f, 0.f, 0.f};
        cur = nxt; cA = nA; cB = nB; ++ui;
        if (wr == 1) PG8_BAR;
    }
    PG8_WAIT_V(0);
    PG8_BAR;
#undef PG8_SA
#undef PG8_SB
#undef PG8_STAGE
#undef PG8_LDA
#undef PG8_LDB
#undef PG8_MMA
#undef PG8_WAIT_V
#undef PG8_WAIT_L
#undef PG8_BAR
#undef PG8_SCHED
}
}
#define CVT_ALL_IN_P0 1

#define XB_TMO      128
#define XB_XCNT(j)  (256  + 64 * (j))
#define XB_XSUB(j)  (1280 + 64 * (j))
#define XB_XGEN(j)  (2304 + 64 * (j))
#define XB_TOP      3328
#define XB_TOPGEN   3392
#define XCD_BAR_WORDS 3456
#define XB_SPIN_CAP (1u << 18)
__device__ __forceinline__ unsigned xb_ld(unsigned* p)              { return __hip_atomic_load(p, __ATOMIC_RELAXED, __HIP_MEMORY_SCOPE_AGENT); }
__device__ __forceinline__ unsigned xb_add(unsigned* p, unsigned v) { return __hip_atomic_fetch_add(p, v, __ATOMIC_RELAXED, __HIP_MEMORY_SCOPE_AGENT); }
__device__ __forceinline__ unsigned xb_xcc_id() { return (unsigned)__builtin_amdgcn_s_getreg((3 << 11) | 20) & 0xFu; }
#define XB_SPIN(cond, bar) do { unsigned _sp = 0; while (cond) { __builtin_amdgcn_s_sleep(1); \
    if ((++_sp & 255u) == 0u) { if (xb_ld(&(bar)[XB_TMO])) break; if (_sp > XB_SPIN_CAP) { atomicAdd(&(bar)[XB_TMO], 1u); break; } } } } while (0)
struct XcdBarrier { unsigned* bar; unsigned x; volatile LAS unsigned* st; };
__device__ __forceinline__ XcdBarrier xcd_barrier_post(unsigned* bar, volatile LAS unsigned* st) {
    XcdBarrier b; b.bar = bar; b.x = xb_xcc_id(); b.st = st;
    if (threadIdx.x == 0) (void)xb_add(&bar[XB_XCNT(b.x)], 1u);
    return b;
}
__device__ __forceinline__ void xcd_barrier_complete(unsigned* bar, unsigned x, unsigned& nloc, unsigned& nx) {
    const unsigned G = gridDim.x * gridDim.y * gridDim.z;
    unsigned sum, cnt, mine, sp = 0u;
    for (;;) {
        sum = 0u; cnt = 0u; mine = 0u;
#pragma unroll
        for (unsigned j = 0; j < 16; ++j) { const unsigned c = xb_ld(&bar[XB_XCNT(j)]); sum += c; cnt += (c > 0u) ? 1u : 0u; mine = (j == x) ? c : mine; }
        if (sum == G) break;
        __builtin_amdgcn_s_sleep(1);
        if ((++sp & 255u) == 0u) { if (xb_ld(&bar[XB_TMO])) break; if (sp > XB_SPIN_CAP) { atomicAdd(&bar[XB_TMO], 1u); break; } }
    }
    nloc = mine > 0u ? mine : 1u; nx = cnt > 0u ? cnt : 1u;
}
__device__ __forceinline__ void xcd_barrier(const XcdBarrier& b) {
    asm volatile("s_waitcnt vmcnt(0)" ::: "memory");
    __syncthreads();
    if (threadIdx.x == 0) {
        unsigned* bar = b.bar;
        __builtin_amdgcn_s_waitcnt(0);
        unsigned nloc = b.st[0], nx = b.st[1];
        if (nloc == 0u) { xcd_barrier_complete(bar, b.x, nloc, nx); b.st[0] = nloc; b.st[1] = nx; }
        const unsigned old = xb_add(&bar[XB_XSUB(b.x)], 1u);
        const unsigned gen = old / nloc;
        if (old + 1u == (gen + 1u) * nloc) {
            __builtin_amdgcn_fence(__ATOMIC_RELEASE, "agent");
            asm volatile("s_waitcnt vmcnt(0)" ::: "memory");
            const unsigned og = xb_add(&bar[XB_TOP], 1u);
            const unsigned tg = og / nx;
            if (og + 1u == (tg + 1u) * nx) xb_add(&bar[XB_TOPGEN], 1u);
            else XB_SPIN(xb_ld(&bar[XB_TOPGEN]) == tg, bar);
            __builtin_amdgcn_fence(__ATOMIC_ACQUIRE, "agent");
            xb_add(&bar[XB_XGEN(b.x)], 1u);
            asm volatile("s_waitcnt vmcnt(0)" ::: "memory");
        } else {
            XB_SPIN(xb_ld(&bar[XB_XGEN(b.x)]) == gen, bar);
            __builtin_amdgcn_fence(__ATOMIC_ACQUIRE, "agent");
            asm volatile("s_waitcnt vmcnt(0)" ::: "memory");
        }
    }
    __syncthreads();
}

constexpr size_t al(size_t x) { return (x + 0xFFFFFull) & ~(size_t)0xFFFFFull; }
constexpr size_t WS_CTL = 0, CTL_BYTES = 1u << 20;
constexpr size_t SZ_WGU = (size_t)2 * FF * D * 2, SZ_WD = (size_t)D * FF * 2, SZ_WIN = (size_t)NINP * D * 2, SZ_WBR = (size_t)D * 4096 * 2, SZ_WOUT = (size_t)D * D * 2;
constexpr size_t LW_GU1 = 0, LW_D1 = LW_GU1 + al(SZ_WGU), LW_GU2 = LW_D1 + al(SZ_WD), LW_D2 = LW_GU2 + al(SZ_WGU), LW_IN = LW_D2 + al(SZ_WD), LW_BR = LW_IN + al(SZ_WIN), LW_OUT = LW_BR + al(SZ_WBR), LW_SIZE = LW_OUT + al(SZ_WOUT);
constexpr size_t WS_W = WS_CTL + CTL_BYTES;
constexpr size_t WS_MOD = WS_W + 2 * LW_SIZE;
constexpr size_t WS_SC = WS_MOD + al((size_t)2 * NCR * NMOD * 4);
constexpr size_t WS_X = WS_SC + al((size_t)144 * D * 2);
constexpr size_t WS_H = WS_X + al((size_t)MP * D * 4);
constexpr size_t WS_ACT = WS_H + al((size_t)MP * D * 2);
constexpr size_t WS_PROJ = WS_ACT + al((size_t)MP * FF * 2);
constexpr size_t WS_SMALL = WS_PROJ + al((size_t)MP * PW * 2);
constexpr size_t WS_BR = WS_SMALL + al((size_t)MP * SW * 4);
constexpr size_t WS_MRG = WS_BR + al((size_t)MP * 4096 * 2);
constexpr size_t WS_MRGB = WS_MRG + al((size_t)MP * D * 4);
constexpr size_t WS_PART = WS_MRGB + al((size_t)MP * D * 2);
constexpr size_t WS_MIX = WS_PART + al((size_t)21 * NS * D * 4);

constexpr int RING_BYTES = 131072, LDS_BYTES = 147456, LDSCTL_OFF = LDS_BYTES - 64;
constexpr int NWAVES = 8, NTHR = 512;

struct Args { const float* in[39]; float* out; unsigned char* ws; int ph_lo, ph_hi; };

__device__ __forceinline__ int win_col(int n) {
    if (n < 4096) return n;
    if (n < 4104) return PW + S_BETA + (n - 4096);
    if (n < 4112) return PW + S_DEC + (n - 4104);
    if (n < 4624) return P_QB + (n - 4112);
    if (n < 5136) return P_KB + (n - 4624);
    if (n < 6160) return P_VB + (n - 5136);
    if (n < 6176) return PW + S_LR + (n - 6160);
    if (n < 7200) return P_RB + (n - 6176);
    if (n < 9248) return P_ZC + (n - 7200);
    if (n < 12320) return P_XBC + (n - 9248);
    if (n < 12352) return PW + S_DT + (n - 12320);
    return P_GATES + (n - 12352);
}
__device__ __forceinline__ int map_row(int mode, int n) {
    if (mode == 0) return n;
    if (mode == 1) return ((n >> 7) << 8) + (n & 127);
    if (mode == 2) return ((n >> 7) << 8) + 128 + (n & 127);
    return win_col(n);
}
__device__ __forceinline__ void transpose_item(const float* __restrict__ W, int N, bf16_t* __restrict__ WT, int KP, int koff, int mode, LAS float* scr, int kb, int nb, int lane) {
    const int k0 = 64 * kb, n0 = 32 * nb;
    {
        f32x4 v[8];
#pragma unroll
        for (int i = 0; i < 8; ++i) v[i] = __builtin_nontemporal_load((const f32x4*)(W + (size_t)(k0 + 8 * i + (lane >> 3)) * N + n0 + 4 * (lane & 7)));
#pragma unroll
        for (int i = 0; i < 8; ++i) { LAS float* d = scr + (8 * i + (lane >> 3)) * 33 + 4 * (lane & 7); d[0] = v[i].x; d[1] = v[i].y; d[2] = v[i].z; d[3] = v[i].w; }
    }
    LDS_WAIT(); asm volatile("" ::: "memory");
    const int c = lane & 7;
#pragma unroll
    for (int j = 0; j < 4; ++j) { const int n = (lane >> 3) + 8 * j; const LAS float* s = scr + (8 * c) * 33 + n;
        u32x4 o; o.x = pk2(s[0 * 33], s[1 * 33]); o.y = pk2(s[2 * 33], s[3 * 33]); o.z = pk2(s[4 * 33], s[5 * 33]); o.w = pk2(s[6 * 33], s[7 * 33]);
        *(u32x4*)(WT + (size_t)map_row(mode, n0 + n) * KP + koff + k0 + 8 * c) = o; }
    LDS_WAIT(); asm volatile("" ::: "memory");
}
struct CvtJob { const float* W; bf16_t* WT; int K, N, KP, koff, mode; };
__device__ __forceinline__ CvtJob cvt_job(const Args& a, int l, int j) {
    unsigned char* lw = a.ws + WS_W + (size_t)l * LW_SIZE;
    CvtJob r;
    switch (j) {
    case 0: r = CvtJob{a.in[14] + (size_t)l * D * FF, (bf16_t*)(lw + LW_GU1), D, FF, D, 0, 1}; break;
    case 1: r = CvtJob{a.in[15] + (size_t)l * D * FF, (bf16_t*)(lw + LW_GU1), D, FF, D, 0, 2}; break;
    case 2: r = CvtJob{a.in[16] + (size_t)l * FF * D, (bf16_t*)(lw + LW_D1), FF, D, FF, 0, 0}; break;
    case 3: r = CvtJob{a.in[17] + (size_t)l * D * FF, (bf16_t*)(lw + LW_GU2), D, FF, D, 0, 1}; break;
    case 4: r = CvtJob{a.in[18] + (size_t)l * D * FF, (bf16_t*)(lw + LW_GU2), D, FF, D, 0, 2}; break;
    case 5: r = CvtJob{a.in[19] + (size_t)l * FF * D, (bf16_t*)(lw + LW_D2), FF, D, FF, 0, 0}; break;
    case 6: r = CvtJob{a.in[20] + (size_t)l * D * NIN, (bf16_t*)(lw + LW_IN), D, NIN, D, 0, 3}; break;
    case 7: r = CvtJob{a.in[34] + (size_t)l * 1024 * D, (bf16_t*)(lw + LW_BR), 1024, D, 4096, 0, 0}; break;
    case 8: r = CvtJob{a.in[35] + (size_t)l * 1024 * D, (bf16_t*)(lw + LW_BR), 1024, D, 4096, 1024, 0}; break;
    case 9: r = CvtJob{a.in[36] + (size_t)l * 2048 * D, (bf16_t*)(lw + LW_BR), 2048, D, 4096, 2048, 0}; break;
    default: r = CvtJob{a.in[37] + (size_t)l * D * D, (bf16_t*)(lw + LW_OUT), D, D, D, 0, 0}; break;
    }
    return r;
}
__device__ __forceinline__ bool cvt_set_job(int set, int idx, int& l, int& j) {
    if (set == 0) { if (idx >= 5) return false; l = idx == 4 ? 1 : 0; j = idx == 0 ? 0 : (idx == 1 ? 1 : (idx == 2 ? 2 : 6)); return true; }
    if (set == 1) { if (idx >= 5) return false; l = 0; j = idx == 4 ? 5 : 7 + idx; return true; }
    if (set == 2) { if (idx >= 2) return false; l = 0; j = 3 + idx; return true; }
    if (set == 3) { if (idx >= 2) return false; l = 1; j = idx; return true; }
    if (set == 4) { if (idx >= 5) return false; l = 1; j = idx == 0 ? 2 : 6 + idx; return true; }
    if (idx >= 3) return false; l = 1; j = 3 + idx; return true;
}
__device__ __forceinline__ void convert_set(const Args& a, LAS unsigned char* lds, int rank, int nrank, int set) {
    const int tid = ltid(), lane = tid & 63, wave = __builtin_amdgcn_readfirstlane(tid >> 6);
    LAS float* scr = (LAS float*)(lds + wave * 16384);
    const int gw = rank * NWAVES + wave, NGW = nrank * NWAVES;
    for (int idx = 0; idx < 5; ++idx) {
        int l, j; if (!cvt_set_job(set, idx, l, j)) break;
        const CvtJob jb = cvt_job(a, l, j);
        const int nblk = jb.N / 32, nit = (jb.K / 64) * nblk;
        for (int it = gw; it < nit; it += NGW) transpose_item(jb.W, jb.N, jb.WT, jb.KP, jb.koff, jb.mode, scr, it / nblk, it % nblk, lane);
    }
}
__device__ __forceinline__ void transpose_item64(const float* __restrict__ W, int N, bf16_t* __restrict__ WT, int KP, int koff, int mode, LAS float* scr, int kb, int nb, int lane) {
    const int k0 = 64 * kb, n0 = 64 * nb;
    {
        f32x4 v[16];
#pragma unroll
        for (int i = 0; i < 16; ++i) v[i] = __builtin_nontemporal_load((const f32x4*)(W + (size_t)(k0 + 4 * i + (lane >> 4)) * N + n0 + 4 * (lane & 15)));
#pragma unroll
        for (int i = 0; i < 16; ++i) { LAS float* d = scr + (4 * i + (lane >> 4)) * 65 + 4 * (lane & 15); d[0] = v[i].x; d[1] = v[i].y; d[2] = v[i].z; d[3] = v[i].w; }
    }
    LDS_WAIT(); asm volatile("" ::: "memory");
    const int c = lane & 7;
#pragma unroll
    for (int j = 0; j < 8; ++j) { const int n = (lane >> 3) + 8 * j; const LAS float* sp = scr + (8 * c) * 65 + n;
        u32x4 o; o.x = pk2(sp[0 * 65], sp[1 * 65]); o.y = pk2(sp[2 * 65], sp[3 * 65]); o.z = pk2(sp[4 * 65], sp[5 * 65]); o.w = pk2(sp[6 * 65], sp[7 * 65]);
        *(u32x4*)(WT + (size_t)map_row(mode, n0 + n) * KP + koff + k0 + 8 * c) = o; }
    LDS_WAIT(); asm volatile("" ::: "memory");
}
__device__ __forceinline__ void p0_convert(const Args& a, LAS unsigned char* lds, int vcu, int G) {
    const int tid = ltid(), lane = tid & 63, wave = __builtin_amdgcn_readfirstlane(tid >> 6);
    LAS float* scr = (LAS float*)(lds + wave * 16896);
    const int gw = vcu * NWAVES + wave, NGW = G * NWAVES;
    {
        constexpr int PER_LAYER = 28832;
#pragma unroll 1
        for (int g = gw; g < 2 * PER_LAYER; g += NGW) {
            const int l = g >= PER_LAYER ? 1 : 0, r = g - l * PER_LAYER;
            int base, inidx, K, N, KP, koff, mode; size_t lwo;
#define QJ(B, I, K_, N_, KP_, KO, MD, LW) { base = B; inidx = I; K = K_; N = N_; KP = KP_; koff = KO; mode = MD; lwo = LW; }
            if (r < 2752) QJ(0, 14, D, FF, D, 0, 1, LW_GU1) else if (r < 5504) QJ(2752, 15, D, FF, D, 0, 2, LW_GU1) else if (r < 8256) QJ(5504, 16, FF, D, FF, 0, 0, LW_D1)
            else if (r < 11008) QJ(8256, 17, D, FF, D, 0, 1, LW_GU2) else if (r < 13760) QJ(11008, 18, D, FF, D, 0, 2, LW_GU2) else if (r < 16512) QJ(13760, 19, FF, D, FF, 0, 0, LW_D2)
            else if (r < 25760) QJ(16512, 20, D, NIN, D, 0, 3, LW_IN)
            else if (r < 26272) QJ(25760, 34, 1024, D, 4096, 0, 0, LW_BR) else if (r < 26784) QJ(26272, 35, 1024, D, 4096, 1024, 0, LW_BR) else if (r < 27808) QJ(26784, 36, 2048, D, 4096, 2048, 0, LW_BR)
            else QJ(27808, 37, D, D, D, 0, 0, LW_OUT)
#undef QJ
            const float* W = nullptr;
#if defined(__HIP_DEVICE_COMPILE__)
            { const __attribute__((address_space(4))) Args* ap = (const __attribute__((address_space(4))) Args*)__builtin_amdgcn_kernarg_segment_ptr(); W = ap->in[inidx] + (size_t)l * K * N; }
#endif
            bf16_t* WT = (bf16_t*)(a.ws + WS_W + (size_t)l * LW_SIZE + lwo);
            const int nblk = N / 64, it = r - base;
            transpose_item64(W, N, WT, KP, koff, mode, scr, it / nblk, it % nblk, lane);
        }
    }
    for (int l = 0; l < 2; ++l) {
        u32x4* p = (u32x4*)(a.ws + WS_W + (size_t)l * LW_SIZE + LW_IN + (size_t)NIN * D * 2);
        const int n16 = (NINP - NIN) * D * 2 / 16;
        for (int i = (vcu * NTHR + tid); i < n16; i += G * NTHR) p[i] = (u32x4){0u, 0u, 0u, 0u};
    }
    {
        const float* cp = a.in[7]; const float* cs = a.in[8]; unsigned* sc = (unsigned*)(a.ws + WS_SC);
        for (int i = vcu * NTHR + tid; i < 144 * D / 2; i += G * NTHR) {
            const int r = i / (D / 2), c2 = (i % (D / 2)) * 2; float v0 = 0.f, v1 = 0.f;
            if (r < NCR) { const float* src = r < NB ? cp + (size_t)r * D : cs + (size_t)(r - NB) * D; v0 = siluf_(src[c2]); v1 = siluf_(src[c2 + 1]); }
            sc[i] = pk2(v0, v1);
        }
    }
}

__device__ __forceinline__ void p1_mod(const Args& a, LAS unsigned char* lds, int vcu, int G) {
    const int tid = ltid(), lane = tid & 63, wave = __builtin_amdgcn_readfirstlane(tid >> 6), c16 = lane & 15, kq = lane >> 4;
    constexpr int NC = 144, BP = NC * 4, BSZ = 32 * BP, ASZ = 144 * 64, SLOT = BSZ + ASZ;
    const bf16_t* SC = (const bf16_t*)(a.ws + WS_SC);
    const int nunits = 2 * (NMOD / NC);
    for (int u = vcu; u < nunits; u += G) {
        const int l = u / (NMOD / NC), n0 = (u % (NMOD / NC)) * NC;
        const float* W = a.in[9] + (size_t)l * D * NMOD + n0;
        auto issue = [&](int ks) {
            LAS unsigned char* S = lds + (ks % 5) * SLOT;
#pragma unroll
            for (int i = 0; i < 4; ++i) {
                const int p = wave + 8 * i;
                if (p < 18) {
                    const int o = p * 1024 + 16 * lane, row = o / BP, cb = o - row * BP;
                    __builtin_amdgcn_global_load_lds((const unsigned*)((const char*)(W + (size_t)(ks * 32 + row) * NMOD) + cb), (LAS unsigned*)(S + p * 1024), 16, 0, 2);
                } else if (p < 27) {
                    const int q = p - 18;
                    __builtin_amdgcn_global_load_lds((const unsigned*)(SC + (size_t)(16 * q + (lane >> 2)) * D + ks * 32 + 8 * (lane & 3)), (LAS unsigned*)(S + BSZ + q * 1024), 16, 0, 0);
                }
            }
        };
        f32x4 acc[9][2];
#pragma unroll
        for (int t = 0; t < 9; ++t) { acc[t][0] = (f32x4){0.f, 0.f, 0.f, 0.f}; acc[t][1] = (f32x4){0.f, 0.f, 0.f, 0.f}; }
        __syncthreads();
        issue(0); issue(1); issue(2); issue(3);
#pragma unroll 1
        for (int ks = 0; ks < 64; ++ks) {
            if (ks + 3 < 64) { if (wave < 3) asm volatile("s_waitcnt vmcnt(12)" ::: "memory"); else asm volatile("s_waitcnt vmcnt(9)" ::: "memory"); }
            else if (ks + 2 < 64) { if (wave < 3) asm volatile("s_waitcnt vmcnt(8)" ::: "memory"); else asm volatile("s_waitcnt vmcnt(6)" ::: "memory"); }
            else if (ks + 1 < 64) { if (wave < 3) asm volatile("s_waitcnt vmcnt(4)" ::: "memory"); else asm volatile("s_waitcnt vmcnt(3)" ::: "memory"); }
            else asm volatile("s_waitcnt vmcnt(0)" ::: "memory");
            __builtin_amdgcn_s_barrier(); asm volatile("" ::: "memory");
            if (ks + 4 < 64) issue(ks + 4);
            const LAS unsigned char* S = lds + (ks % 5) * SLOT;
            bf16x8 bfr[2];
#pragma unroll
            for (int g = 0; g < 2; ++g) {
                const int ct = g == 0 ? wave : 8;
                const LAS float* bp = (const LAS float*)(S + (8 * kq) * BP) + 16 * ct + c16;
                float w[8];
#pragma unroll
                for (int j = 0; j < 8; ++j) w[j] = bp[j * (BP / 4)];
                u32x4 p; p.x = pk2(w[0], w[1]); p.y = pk2(w[2], w[3]); p.z = pk2(w[4], w[5]); p.w = pk2(w[6], w[7]);
                bfr[g] = __builtin_bit_cast(bf16x8, p);
            }
#pragma unroll
            for (int t = 0; t < 9; ++t) {
                const bf16x8 af = *(const LAS bf16x8*)(S + BSZ + (16 * t + c16) * 64 + kq * 16);
                acc[t][0] = __builtin_amdgcn_mfma_f32_16x16x32_bf16(af, bfr[0], acc[t][0], 0, 0, 0);
                if (wave == 0) acc[t][1] = __builtin_amdgcn_mfma_f32_16x16x32_bf16(af, bfr[1], acc[t][1], 0, 0, 0);
            }
        }
        const float* bias = a.in[10] + (size_t)l * NMOD + n0;
        float* mod = (float*)(a.ws + WS_MOD) + (size_t)l * NCR * NMOD + n0;
        const float b0 = bias[16 * wave + c16], b1 = bias[128 + c16];
#pragma unroll
        for (int t = 0; t < 9; ++t)
#pragma unroll
            for (int j = 0; j < 4; ++j) { const int r = 16 * t + 4 * kq + j;
                if (r < NCR) { mod[(size_t)r * NMOD + 16 * wave + c16] = acc[t][0][j] + b0; if (wave == 0) mod[(size_t)r * NMOD + 128 + c16] = acc[t][1][j] + b1; } }
    }
    __syncthreads();
}

__device__ __forceinline__ void xb_load8(const bf16_t* p, f32x4& lo, f32x4& hi) { const u32x4 w = *(const u32x4*)p; lo = (f32x4){bflo(w.x), bfhi(w.x), bflo(w.y), bfhi(w.y)}; hi = (f32x4){bflo(w.z), bfhi(w.z), bflo(w.w), bfhi(w.w)}; }
__device__ __forceinline__ void xb_store8(bf16_t* p, const f32x4 lo, const f32x4 hi) { u32x4 w; w.x = pk2(lo.x, lo.y); w.y = pk2(lo.z, lo.w); w.z = pk2(hi.x, hi.y); w.w = pk2(hi.z, hi.w); *(u32x4*)p = w; }
__device__ __forceinline__ int cond_row(int m) { return m < NPT ? (m >> 11) : NB + (m - NPT); }
template <bool FINAL>
__device__ __forceinline__ void sample_rows_norm(const Args& a, LAS unsigned char* lds, int vcu, int G, const float* nw, const float* mr0  , bool first,
                                                 int nch, const float* gate  , float scale) {
    const int tid = ltid(), lane = tid & 63, wave = __builtin_amdgcn_readfirstlane(tid >> 6);
    float* X = (float*)(a.ws + WS_X); bf16_t* H = (bf16_t*)(a.ws + WS_H); const float* PART = (const float*)(a.ws + WS_PART);
    LAS float* red = (LAS float*)lds;
    int v0 = vcu; asm volatile("" : "+s"(v0));
#pragma unroll 1
    for (int s = v0; s < NS; s += G) {
        const int m = NPT + s, c = 4 * tid;
        f32x4 x = first ? *(const f32x4*)(a.in[1] + (size_t)s * D + c) : *(const f32x4*)(X + (size_t)m * D + c);
        if (nch > 0) {
            f32x4 acc = (f32x4){0.f, 0.f, 0.f, 0.f};
#pragma unroll 7
            for (int ch = 0; ch < nch; ++ch) acc = acc + *(const f32x4*)(PART + ((size_t)ch * NS + s) * D + c);
            x = x + *(const f32x4*)(gate + (size_t)(NB + s) * NMOD + c) * scale * acc;
        }
        if (!FINAL) *(f32x4*)(X + (size_t)m * D + c) = x;
        float ss = (x.x * x.x + x.y * x.y) + (x.z * x.z + x.w * x.w);
        ss = wave_sum(ss);
        if (lane == 0) red[wave] = ss;
        __syncthreads();
        float tot = 0.f;
#pragma unroll
        for (int w = 0; w < NWAVES; ++w) tot += red[w];
        __syncthreads();
        const float rstd = 1.0f / sqrtf(tot * (1.f / D) + EPS);
        const f32x4 w4 = *(const f32x4*)(nw + c);
        if (FINAL) *(f32x4*)(a.out + (size_t)m * D + c) = x * rstd * w4;
        else {
            const float* mr = mr0 + (size_t)(NB + s) * NMOD;
            const f32x4 sh = *(const f32x4*)(mr + c), sc = *(const f32x4*)(mr + D + c);
            const f32x4 y = x * rstd * w4 * (sc + 1.0f) + sh;
            u32x2 o; o.x = pk2(y.x, y.y); o.y = pk2(y.z, y.w); *(u32x2*)(H + (size_t)m * D + c) = o;
        }
    }
}
__device__ __forceinline__ void norm_mod_phase(const Args& a, LAS unsigned char* lds, int vcu, int G, int layer, int which  , bool first, int nch, const float* gate, float scale) {
    const int tid = ltid(), lane = tid & 63, wave = __builtin_amdgcn_readfirstlane(tid >> 6);
    const int gw = vcu * NWAVES + wave, NGW = G * NWAVES;
    float* X = (float*)(a.ws + WS_X); bf16_t* H = (bf16_t*)(a.ws + WS_H);
    const float* nw = a.in[11 + which] + (size_t)layer * D;
    const float* modl = (const float*)(a.ws + WS_MOD) + (size_t)layer * NCR * NMOD;
    sample_rows_norm<false>(a, lds, vcu, G, nw, modl + (size_t)(3 * which) * D, first, nch, gate, scale);
    if (!first) {
        for (int m = MT + gw; m < MP; m += NGW) { u32x4* hrow = (u32x4*)(H + (size_t)m * D);
#pragma unroll
            for (int j = 0; j < 4; ++j) hrow[64 * j + lane] = (u32x4){0u, 0u, 0u, 0u}; }
        const bf16_t* XB = (const bf16_t*)X;
        u32x4 cur[4], nxt[4];
        int m = gw;
        if (m < NPT) {
#pragma unroll
            for (int j = 0; j < 4; ++j) cur[j] = *(const u32x4*)(XB + (size_t)m * D + 512 * j + 8 * lane); }
#pragma unroll 1
        while (m < NPT) {
            const int mn = m + NGW;
#pragma unroll
            for (int j = 0; j < 4; ++j) nxt[j] = cur[j];
            if (mn < NPT) {
#pragma unroll
                for (int j = 0; j < 4; ++j) nxt[j] = *(const u32x4*)(XB + (size_t)mn * D + 512 * j + 8 * lane); }
            f32x4 v[8]; float s = 0.f;
#pragma unroll
            for (int j = 0; j < 4; ++j) { const u32x4 w = cur[j];
                v[2 * j] = (f32x4){bflo(w.x), bfhi(w.x), bflo(w.y), bfhi(w.y)}; v[2 * j + 1] = (f32x4){bflo(w.z), bfhi(w.z), bflo(w.w), bfhi(w.w)};
                s += (v[2 * j].x * v[2 * j].x + v[2 * j].y * v[2 * j].y) + (v[2 * j].z * v[2 * j].z + v[2 * j].w * v[2 * j].w);
                s += (v[2 * j + 1].x * v[2 * j + 1].x + v[2 * j + 1].y * v[2 * j + 1].y) + (v[2 * j + 1].z * v[2 * j + 1].z + v[2 * j + 1].w * v[2 * j + 1].w); }
            const float rstd = 1.0f / sqrtf(wave_sum(s) * (1.f / D) + EPS);
            const float* mr = modl + (size_t)cond_row(m) * NMOD + (size_t)(3 * which) * D;
            u32x4* hrow = (u32x4*)(H + (size_t)m * D);
#pragma unroll
            for (int j = 0; j < 4; ++j) {
                const int c = 512 * j + 8 * lane;
                const f32x4 w0 = *(const f32x4*)(nw + c), w1 = *(const f32x4*)(nw + c + 4);
                const f32x4 sh0 = *(const f32x4*)(mr + c), sh1 = *(const f32x4*)(mr + c + 4);
                const f32x4 sc0 = *(const f32x4*)(mr + D + c), sc1 = *(const f32x4*)(mr + D + c + 4);
                const f32x4 y0 = v[2 * j] * rstd * w0 * (sc0 + 1.0f) + sh0, y1 = v[2 * j + 1] * rstd * w1 * (sc1 + 1.0f) + sh1;
                u32x4 o; o.x = pk2(y0.x, y0.y); o.y = pk2(y0.z, y0.w); o.z = pk2(y1.x, y1.y); o.w = pk2(y1.z, y1.w);
                hrow[64 * j + lane] = o;
            }
#pragma unroll
            for (int j = 0; j < 4; ++j) cur[j] = nxt[j];
            m = mn;
        }
        return;
    }
    for (int m = gw; m < MP; m += NGW) {
        u32x4* hrow = (u32x4*)(H + (size_t)m * D);
        if (m >= NPT) {
            if (m >= MT) {
#pragma unroll
                for (int j = 0; j < 4; ++j) hrow[64 * j + lane] = (u32x4){0u, 0u, 0u, 0u};
            }
            continue;
        }
        const float* xr = a.in[0] + (size_t)m * D; bf16_t* xb = (bf16_t*)X + (size_t)m * D;
        f32x4 v[8]; float s = 0.f;
#pragma unroll
        for (int j = 0; j < 4; ++j) {
            if (first) { v[2 * j] = *(const f32x4*)(xr + 512 * j + 8 * lane); v[2 * j + 1] = *(const f32x4*)(xr + 512 * j + 8 * lane + 4); }
            else xb_load8(xb + 512 * j + 8 * lane, v[2 * j], v[2 * j + 1]);
            s += (v[2 * j].x * v[2 * j].x + v[2 * j].y * v[2 * j].y) + (v[2 * j].z * v[2 * j].z + v[2 * j].w * v[2 * j].w);
            s += (v[2 * j + 1].x * v[2 * j + 1].x + v[2 * j + 1].y * v[2 * j + 1].y) + (v[2 * j + 1].z * v[2 * j + 1].z + v[2 * j + 1].w * v[2 * j + 1].w);
        }
        if (first) {
#pragma unroll
            for (int j = 0; j < 4; ++j) xb_store8(xb + 512 * j + 8 * lane, v[2 * j], v[2 * j + 1]);
        }
        const float rstd = 1.0f / sqrtf(wave_sum(s) * (1.f / D) + EPS);
        const float* mr = modl + (size_t)cond_row(m) * NMOD + (size_t)(3 * which) * D;
#pragma unroll
        for (int j = 0; j < 4; ++j) {
            const int c = 512 * j + 8 * lane;
            const f32x4 w0 = *(const f32x4*)(nw + c), w1 = *(const f32x4*)(nw + c + 4);
            const f32x4 sh0 = *(const f32x4*)(mr + c), sh1 = *(const f32x4*)(mr + c + 4);
            const f32x4 sc0 = *(const f32x4*)(mr + D + c), sc1 = *(const f32x4*)(mr + D + c + 4);
            const f32x4 y0 = v[2 * j] * rstd * w0 * (sc0 + 1.0f) + sh0, y1 = v[2 * j + 1] * rstd * w1 * (sc1 + 1.0f) + sh1;
            u32x4 o; o.x = pk2(y0.x, y0.y); o.y = pk2(y0.z, y0.w); o.z = pk2(y1.x, y1.y); o.w = pk2(y1.z, y1.w);
            hrow[64 * j + lane] = o;
        }
    }
}
__device__ __forceinline__ void final_norm_phase(const Args& a, LAS unsigned char* lds, int vcu, int G, int nch, const float* gate, float scale) {
    const int tid = ltid(), lane = tid & 63, wave = __builtin_amdgcn_readfirstlane(tid >> 6);
    const int gw = vcu * NWAVES + wave, NGW = G * NWAVES;
    const float* X = (const float*)(a.ws + WS_X); const float* nw = a.in[38];
    sample_rows_norm<true>(a, lds, vcu, G, nw, nullptr, false, nch, gate, scale);
    for (int m = gw; m < NPT; m += NGW) {
        const bf16_t* xb = (const bf16_t*)X + (size_t)m * D; float* yo = a.out + (size_t)m * D;
        f32x4 v[8]; float s = 0.f;
#pragma unroll
        for (int j = 0; j < 4; ++j) { xb_load8(xb + 512 * j + 8 * lane, v[2 * j], v[2 * j + 1]);
            s += (v[2 * j].x * v[2 * j].x + v[2 * j].y * v[2 * j].y) + (v[2 * j].z * v[2 * j].z + v[2 * j].w * v[2 * j].w);
            s += (v[2 * j + 1].x * v[2 * j + 1].x + v[2 * j + 1].y * v[2 * j + 1].y) + (v[2 * j + 1].z * v[2 * j + 1].z + v[2 * j + 1].w * v[2 * j + 1].w); }
        const float rstd = 1.0f / sqrtf(wave_sum(s) * (1.f / D) + EPS);
#pragma unroll
        for (int j = 0; j < 4; ++j) { const int c = 512 * j + 8 * lane; const f32x4 w0 = *(const f32x4*)(nw + c), w1 = *(const f32x4*)(nw + c + 4);
            *(f32x4*)(yo + c) = v[2 * j] * rstd * w0; *(f32x4*)(yo + c + 4) = v[2 * j + 1] * rstd * w1; }
    }
}

using pg8::Unit;
__device__ __forceinline__ void unpack8(const u32x4 w, float (&f)[8]) { f[0] = bflo(w.x); f[1] = bfhi(w.x); f[2] = bflo(w.y); f[3] = bfhi(w.y); f[4] = bflo(w.z); f[5] = bfhi(w.z); f[6] = bflo(w.w); f[7] = bfhi(w.w); }
struct EpiSwiglu {
    static constexpr bool PERM = true;
    bf16_t* ACT;
    __device__ __forceinline__ void operator()(const f32x4 (&acc)[2][2][4][2], const Unit& u, int wr, int wc, int fr, int fq) const {
        const int row0 = u.pm * 256 + wr * 64 + fr, f0 = u.pn * 128 + wc * 32 + 8 * fq;
#pragma unroll
        for (int ai = 0; ai < 2; ++ai)
#pragma unroll
            for (int m = 0; m < 4; ++m) {
                const f32x4 g0 = acc[ai][0][m][0], g1 = acc[ai][0][m][1], u0 = acc[ai][1][m][0], u1 = acc[ai][1][m][1];
                float o[8];
#pragma unroll
                for (int j = 0; j < 4; ++j) { o[j] = siluf_(g0[j]) * u0[j]; o[4 + j] = siluf_(g1[j]) * u1[j]; }
                u32x4 w; w.x = pg8::cvt_pk_bf16(o[0], o[1]); w.y = pg8::cvt_pk_bf16(o[2], o[3]); w.z = pg8::cvt_pk_bf16(o[4], o[5]); w.w = pg8::cvt_pk_bf16(o[6], o[7]);
                *(u32x4*)(ACT + (size_t)(row0 + ai * 128 + m * 16) * FF + f0) = w;
            }
    }
};
struct EpiResid {
    static constexpr bool PERM = true;
    float* X; const float* gate; float scale; float* PART;
    __device__ __forceinline__ void operator()(const f32x4 (&acc)[2][2][4][2], const Unit& u, int wr, int wc, int fr, int fq) const {
        const int col0 = u.pn * 256 + wc * 32 + 8 * fq;
        if (u.seg == 0) {
            const int row0 = u.pm * 256 + wr * 64 + fr;
            const float* gr = gate + (size_t)(u.pm >> 3) * NMOD + col0;
            f32x4 gv[2][2];
#pragma unroll
            for (int bj = 0; bj < 2; ++bj)
#pragma unroll
                for (int n = 0; n < 2; ++n) gv[bj][n] = *(const f32x4*)(gr + bj * 128 + n * 4) * scale;
#pragma unroll
            for (int ai = 0; ai < 2; ++ai) {
                bf16_t* rowp = (bf16_t*)X + (size_t)(row0 + ai * 128) * D + col0;
                u32x4 xv[4][2];
#pragma unroll
                for (int m = 0; m < 4; ++m)
#pragma unroll
                    for (int bj = 0; bj < 2; ++bj) xv[m][bj] = *(const u32x4*)(rowp + (size_t)(m * 16) * D + bj * 128);
#pragma unroll
                for (int m = 0; m < 4; ++m)
#pragma unroll
                    for (int bj = 0; bj < 2; ++bj) { const u32x4 w = xv[m][bj];
                        const f32x4 lo = (f32x4){bflo(w.x), bfhi(w.x), bflo(w.y), bfhi(w.y)}, hi = (f32x4){bflo(w.z), bfhi(w.z), bflo(w.w), bfhi(w.w)};
                        xb_store8(rowp + (size_t)(m * 16) * D + bj * 128, lo + gv[bj][0] * acc[ai][bj][m][0], hi + gv[bj][1] * acc[ai][bj][m][1]); }
                asm volatile("" ::: "memory");
            }
        } else {
            float* pp = PART + ((size_t)(u.k0 >> 8) * NS + wr * 64 + fr) * D + col0;
#pragma unroll
            for (int m = 0; m < 4; ++m)
#pragma unroll
                for (int bj = 0; bj < 2; ++bj)
#pragma unroll
                    for (int n = 0; n < 2; ++n) *(f32x4*)(pp + (size_t)(m * 16) * D + bj * 128 + n * 4) = acc[0][bj][m][n];
        }
    }
};
struct EpiWin {
    static constexpr bool PERM = true;
    bf16_t* PROJ; float* SMALL;
    __device__ __forceinline__ void operator()(const f32x4 (&acc)[2][2][4][2], const Unit& u, int wr, int wc, int fr, int fq) const {
        const int row0 = u.pm * 256 + wr * 64 + fr;
        if (u.pn < PW / 256) {
            const int col0 = u.pn * 256 + wc * 32 + 8 * fq;
#pragma unroll
            for (int ai = 0; ai < 2; ++ai)
#pragma unroll
                for (int m = 0; m < 4; ++m) { bf16_t* rowp = PROJ + (size_t)(row0 + ai * 128 + m * 16) * PW + col0;
#pragma unroll
                    for (int bj = 0; bj < 2; ++bj) { const f32x4 v0 = acc[ai][bj][m][0], v1 = acc[ai][bj][m][1];
                        u32x4 w; w.x = pg8::cvt_pk_bf16(v0[0], v0[1]); w.y = pg8::cvt_pk_bf16(v0[2], v0[3]); w.z = pg8::cvt_pk_bf16(v1[0], v1[1]); w.w = pg8::cvt_pk_bf16(v1[2], v1[3]);
                        *(u32x4*)(rowp + bj * 128) = w; } }
        } else if (wc < 2) {
            const int col0 = wc * 32 + 8 * fq;
#pragma unroll
            for (int ai = 0; ai < 2; ++ai)
#pragma unroll
                for (int m = 0; m < 4; ++m) { float* rowp = SMALL + (size_t)(row0 + ai * 128 + m * 16) * SW + col0;
                    *(f32x4*)(rowp) = acc[ai][0][m][0]; *(f32x4*)(rowp + 4) = acc[ai][0][m][1]; }
        }
    }
};
struct EpiBranch {
    static constexpr bool PERM = true;
    float* MRG; bf16_t* MRGB; const bf16_t* PROJ;
    __device__ __forceinline__ void operator()(const f32x4 (&acc)[2][2][4][2], const Unit& u, int wr, int wc, int fr, int fq) const {
        const int row0 = u.pm * 256 + wr * 64 + fr, col0 = u.pn * 256 + wc * 32 + 8 * fq;
#pragma unroll
        for (int ai = 0; ai < 2; ++ai) {
            u32x4 gwv[4][2], pv[4][2];
#pragma unroll
            for (int m = 0; m < 4; ++m) { const size_t r = (size_t)(row0 + ai * 128 + m * 16);
#pragma unroll
                for (int bj = 0; bj < 2; ++bj) { const int c = col0 + bj * 128;
                    gwv[m][bj] = *(const u32x4*)(PROJ + r * PW + P_GATES + u.seg * D + c);
                    pv[m][bj] = (u32x4){0u, 0u, 0u, 0u};
                    if (u.seg > 0) pv[m][bj] = *(const u32x4*)(MRGB + r * D + c); } }
#pragma unroll
            for (int m = 0; m < 4; ++m) { const size_t r = (size_t)(row0 + ai * 128 + m * 16);
#pragma unroll
                for (int bj = 0; bj < 2; ++bj) { const int c = col0 + bj * 128;
                    float g[8], p[8]; unpack8(gwv[m][bj], g); unpack8(pv[m][bj], p);
                    f32x4 v0, v1;
#pragma unroll
                    for (int j = 0; j < 4; ++j) { v0[j] = sigmoidf_(g[j]) * acc[ai][bj][m][0][j] + p[j]; v1[j] = sigmoidf_(g[4 + j]) * acc[ai][bj][m][1][j] + p[4 + j]; }
                    u32x4 w; w.x = pg8::cvt_pk_bf16(v0[0], v0[1]); w.y = pg8::cvt_pk_bf16(v0[2], v0[3]); w.z = pg8::cvt_pk_bf16(v1[0], v1[1]); w.w = pg8::cvt_pk_bf16(v1[2], v1[3]);
                    *(u32x4*)(MRGB + r * D + c) = w; } }
            asm volatile("" ::: "memory"); }
    }
};

__device__ __forceinline__ void skinny_gemm(const Args& a, LAS unsigned char* lds, int vcu, int G, const bf16_t* A, int lda, const bf16_t* Bt, int ldb, int nseg, int klen0, int klen1, int klen2,
                                            int mode, float* X, const float* gate, float scale, bf16_t* MRGB, const bf16_t* PROJ) {
    const int tid = ltid(), lane = tid & 63, wave = __builtin_amdgcn_readfirstlane(tid >> 6), c16 = lane & 15, kq = lane >> 4;
    LAS float* red = (LAS float*)lds;
    for (int w = vcu; w < 256; w += G) {
        const int n0 = 16 * (w >> 1), r0 = NPT + 64 * (w & 1);
        float gsum[4] = {0.f, 0.f, 0.f, 0.f};
        int kbase = 0;
        for (int sg = 0; sg < nseg; ++sg) {
            const int klen = sg == 0 ? klen0 : (sg == 1 ? klen1 : klen2);
            f32x4 acc[4];
#pragma unroll
            for (int t = 0; t < 4; ++t) acc[t] = (f32x4){0.f, 0.f, 0.f, 0.f};
            const int nks = klen / 32;
            const bf16_t* bp = Bt + (size_t)(n0 + c16) * ldb + kbase + 8 * kq;
            const bf16_t* ap = A + (size_t)(r0 + c16) * lda + kbase + 8 * kq;
            const int nblk = (nks + 3) >> 2;
#pragma unroll 1
            for (int blk = wave; blk < nblk; blk += NWAVES) {
                bf16x8 bq[4], aq[4][4];
#pragma unroll
                for (int q = 0; q < 4; ++q) {
                    const int kk = blk * 4 + q, k0 = (kk < nks ? kk : 0) * 32;
                    bq[q] = *(const bf16x8*)(bp + k0);
#pragma unroll
                    for (int t = 0; t < 4; ++t) aq[q][t] = *(const bf16x8*)(ap + (size_t)(16 * t) * lda + k0);
                }
#pragma unroll
                for (int q = 0; q < 4; ++q) {
                    if (blk * 4 + q < nks) {
#pragma unroll
                        for (int t = 0; t < 4; ++t) acc[t] = __builtin_amdgcn_mfma_f32_16x16x32_bf16(bq[q], aq[q][t], acc[t], 0, 0, 0);
                    }
                }
            }
#pragma unroll
            for (int t = 0; t < 4; ++t) *(LAS f32x4*)(red + ((wave * 64 + 16 * t + c16) * 16 + 4 * kq)) = acc[t];
            __syncthreads();
            if (tid < 256) {
                const int r = tid >> 2, c4 = (tid & 3) * 4;
                f32x4 s = (f32x4){0.f, 0.f, 0.f, 0.f};
#pragma unroll
                for (int wv = 0; wv < 8; ++wv) s = s + *(const LAS f32x4*)(red + ((wv * 64 + r) * 16 + c4));
                if (mode == 1) {
                    const u32x2 gw = *(const u32x2*)(PROJ + (size_t)(r0 + r) * PW + P_GATES + sg * D + n0 + c4);
                    gsum[0] += sigmoidf_(bflo(gw.x)) * s.x; gsum[1] += sigmoidf_(bfhi(gw.x)) * s.y; gsum[2] += sigmoidf_(bflo(gw.y)) * s.z; gsum[3] += sigmoidf_(bfhi(gw.y)) * s.w;
                } else { gsum[0] += s.x; gsum[1] += s.y; gsum[2] += s.z; gsum[3] += s.w; }
            }
            __syncthreads();
            kbase += klen;
        }
        if (tid < 256) {
            const int r = r0 + (tid >> 2), c = n0 + (tid & 3) * 4;
            if (mode == 0) {
                const f32x4 gv = *(const f32x4*)(gate + (size_t)cond_row(r) * NMOD + c) * scale;
                f32x4* p = (f32x4*)(X + (size_t)r * D + c);
                *p = *p + gv * (f32x4){gsum[0], gsum[1], gsum[2], gsum[3]};
            } else {
                u32x2 o; o.x = pk2(gsum[0], gsum[1]); o.y = pk2(gsum[2], gsum[3]); *(u32x2*)(MRGB + (size_t)r * D + c) = o;
            }
        }
    }
}

__device__ __forceinline__ void skinny_branch(LAS unsigned char* lds, int vcu, int G, const bf16_t* A, const bf16_t* Bt, bf16_t* MRGB, const bf16_t* PROJ) {
    const int tid = ltid(), lane = tid & 63, wave = __builtin_amdgcn_readfirstlane(tid >> 6), c16 = lane & 15, kq = lane >> 4;
    LAS float* red = (LAS float*)lds;
#pragma unroll 1
    for (int w = vcu; w < 256; w += G) {
        const int n0 = 16 * (w >> 1), r0 = NPT + 64 * (w & 1);
        const bf16_t* bp = Bt + (size_t)(n0 + c16) * 4096 + 8 * kq;
        const bf16_t* ap = A + (size_t)(r0 + c16) * 4096 + 8 * kq;
        f32x4 acc[3][4];
#pragma unroll
        for (int sg = 0; sg < 3; ++sg)
#pragma unroll
            for (int t = 0; t < 4; ++t) acc[sg][t] = (f32x4){0.f, 0.f, 0.f, 0.f};
#pragma unroll
        for (int b = 0; b < 4; ++b) {
            const int sg = b < 2 ? b : 2, kb = (wave + 8 * b) * 128;
            bf16x8 bq[4], aq[4][4];
#pragma unroll
            for (int q = 0; q < 4; ++q) {
                bq[q] = *(const bf16x8*)(bp + kb + 32 * q);
#pragma unroll
                for (int t = 0; t < 4; ++t) aq[q][t] = *(const bf16x8*)(ap + (size_t)(16 * t) * 4096 + kb + 32 * q);
            }
#pragma unroll
            for (int q = 0; q < 4; ++q)
#pragma unroll
                for (int t = 0; t < 4; ++t) acc[sg][t] = __builtin_amdgcn_mfma_f32_16x16x32_bf16(bq[q], aq[q][t], acc[sg][t], 0, 0, 0);
        }
#pragma unroll
        for (int sg = 0; sg < 3; ++sg)
#pragma unroll
            for (int t = 0; t < 4; ++t) *(LAS f32x4*)(red + (((sg * 8 + wave) * 64 + 16 * t + c16) * 16 + 4 * kq)) = acc[sg][t];
        __syncthreads();
        if (tid < 256) {
            const int r = tid >> 2, c4 = (tid & 3) * 4;
            float gsum[4] = {0.f, 0.f, 0.f, 0.f};
            u32x2 gw[3];
#pragma unroll
            for (int sg = 0; sg < 3; ++sg) gw[sg] = *(const u32x2*)(PROJ + (size_t)(r0 + r) * PW + P_GATES + sg * D + n0 + c4);
#pragma unroll
            for (int sg = 0; sg < 3; ++sg) {
                f32x4 s = (f32x4){0.f, 0.f, 0.f, 0.f};
#pragma unroll
                for (int wv = 0; wv < 8; ++wv) s = s + *(const LAS f32x4*)(red + (((sg * 8 + wv) * 64 + r) * 16 + c4));
                gsum[0] += sigmoidf_(bflo(gw[sg].x)) * s.x; gsum[1] += sigmoidf_(bfhi(gw[sg].x)) * s.y; gsum[2] += sigmoidf_(bflo(gw[sg].y)) * s.z; gsum[3] += sigmoidf_(bfhi(gw[sg].y)) * s.w;
            }
            u32x2 o; o.x = pk2(gsum[0], gsum[1]); o.y = pk2(gsum[2], gsum[3]); *(u32x2*)(MRGB + (size_t)(r0 + r) * D + n0 + c4) = o;
        }
        __syncthreads();
    }
}

constexpr size_t WS_GQKV = WS_MIX;
constexpr size_t WS_GB = WS_GQKV + al((size_t)MP * 3072 * 2);
constexpr size_t WS_LA = WS_GB + al((size_t)MP * 16 * 4);
constexpr size_t WS_XBC = WS_LA + al((size_t)MP * 512 * 4);
constexpr size_t WS_DT = WS_XBC + al((size_t)MP * 3072 * 2);
constexpr int NGU = NB * NCHUNK * 8, NLU = NB * NCHUNK * 4, NSU = NB * NCHUNK * 32, NSG = NB * NCHUNK * 4;
constexpr size_t WS_G_WK = WS_DT + al((size_t)MP * 32 * 4);
constexpr size_t WS_G_QD = WS_G_WK + al((size_t)NGU * 8192 * 2);
constexpr size_t WS_G_KDT = WS_G_QD + al((size_t)NGU * 8192 * 2);
constexpr size_t WS_G_QKD = WS_G_KDT + al((size_t)NGU * 8192 * 2);
constexpr size_t WS_G_UT = WS_G_QKD + al((size_t)NGU * 4096 * 2);
constexpr size_t WS_G_EGL = WS_G_UT + al((size_t)NGU * 8192 * 4);
constexpr size_t WS_L_QB = WS_G_EGL + al((size_t)NGU * 4);
constexpr size_t WS_L_ATT = WS_L_QB + al((size_t)NLU * 8192 * 2);
constexpr size_t WS_L_KDT = WS_L_ATT + al((size_t)NLU * 4096 * 2);
constexpr size_t WS_L_VT = WS_L_KDT + al((size_t)NLU * 8192 * 2);
constexpr size_t WS_L_EBL = WS_L_VT + al((size_t)NLU * 16384 * 2);
constexpr size_t WS_S_MH = WS_L_EBL + al((size_t)NLU * 128 * 4);
constexpr size_t WS_S_XDTT = WS_S_MH + al((size_t)NSU * 4096 * 2);
constexpr size_t WS_S_XDT2T = WS_S_XDTT + al((size_t)NSU * 4096 * 2);
constexpr size_t WS_S_EA = WS_S_XDT2T + al((size_t)NSU * 4096 * 2);
constexpr size_t WS_S_EAL = WS_S_EA + al((size_t)NSU * 64 * 4);
constexpr size_t WS_S_BT = WS_S_EAL + al((size_t)NSU * 64 * 4);
constexpr size_t WS_OA = WS_S_BT + al((size_t)NSG * 8192 * 2);
constexpr size_t WS_OB = WS_OA + al((size_t)MP * 1024 * 2);
constexpr size_t WS_YC = WS_OB + al((size_t)MP * 1024 * 2);
constexpr size_t WS_END = WS_YC + al((size_t)MP * 2048 * 2);

constexpr size_t O_YP = 0, O_YS = O_YP + (size_t)NPT * D, O_PGC = O_YS + (size_t)NS * D, O_PG = O_PGC + (size_t)2 * NB * 3 * 3072, O_PL = O_PG + (size_t)2 * NB * 8 * 16384,
                 O_PSC = O_PL + (size_t)2 * NB * 4 * 32768, O_PS = O_PSC + (size_t)2 * NB * 3 * 3072, O_SGC = O_PS + (size_t)2 * NB * 32 * 8192, O_SG = O_SGC + (size_t)2 * NS * 3 * 3072,
                 O_SL = O_SG + (size_t)2 * NS * 8 * 16384, O_SSC = O_SL + (size_t)2 * NS * 4 * 32768, O_SS = O_SSC + (size_t)2 * NS * 3 * 3072, O_END = O_SS + (size_t)2 * NS * 32 * 8192;

__device__ __forceinline__ u32x4 pack8(const float (&f)[8]) { u32x4 w; w.x = pk2(f[0], f[1]); w.y = pk2(f[2], f[3]); w.z = pk2(f[4], f[5]); w.w = pk2(f[6], f[7]); return w; }

__device__ __forceinline__ void store8f(float* p, const float (&f)[8]) { *(f32x4*)p = (f32x4){f[0], f[1], f[2], f[3]}; *(f32x4*)(p + 4) = (f32x4){f[4], f[5], f[6], f[7]}; }
__device__ __forceinline__ void load8f(const float* p, float (&f)[8]) { const f32x4 a = *(const f32x4*)p, b = *(const f32x4*)(p + 4); f[0] = a.x; f[1] = a.y; f[2] = a.z; f[3] = a.w; f[4] = b.x; f[5] = b.y; f[6] = b.z; f[7] = b.w; }
template <int KIND  >
__device__ __forceinline__ u32x4 conv_out(const float (&w)[4][8], const float (&bias)[8], const float (&p3)[8], const float (&p2)[8], const float (&p1)[8], const float (&raw)[8]) {
    f32x2 y[4]; f32x2 ssv = {0.f, 0.f};
#pragma unroll
    for (int i = 0; i < 4; ++i) {
        const f32x2 a3 = {p3[2 * i], p3[2 * i + 1]}, a2 = {p2[2 * i], p2[2 * i + 1]}, a1 = {p1[2 * i], p1[2 * i + 1]}, a0 = {raw[2 * i], raw[2 * i + 1]};
        const f32x2 w0 = {w[0][2 * i], w[0][2 * i + 1]}, w1 = {w[1][2 * i], w[1][2 * i + 1]}, w2 = {w[2][2 * i], w[2][2 * i + 1]}, w3 = {w[3][2 * i], w[3][2 * i + 1]};
        f32x2 v = a3 * w0; v = a2 * w1 + v; v = a1 * w2 + v; v = a0 * w3 + v;
        if (KIND == 3) { const f32x2 bb = {bias[2 * i], bias[2 * i + 1]}; v = v + bb; }
        const f32x2 t = v * (-1.4426950408889634f);
        f32x2 d; d.x = __builtin_amdgcn_exp2f(t.x); d.y = __builtin_amdgcn_exp2f(t.y); d = d + 1.0f;
        f32x2 r; r.x = __builtin_amdgcn_rcpf(d.x); r.y = __builtin_amdgcn_rcpf(d.y);
        v = v * r; y[i] = v; ssv = v * v + ssv;
    }
    if (KIND < 2) {
        float ss = ssv.x + ssv.y;
        ss += __shfl_xor(ss, 1); ss += __shfl_xor(ss, 2); ss += __shfl_xor(ss, 4); ss += __shfl_xor(ss, 8);
        const float rn = __builtin_amdgcn_rsqf(ss + EPS) * (KIND == 0 ? 0.08838834764831845f : 1.0f);
#pragma unroll
        for (int i = 0; i < 4; ++i) y[i] = y[i] * rn;
    }
    u32x4 o; o.x = pk2(y[0].x, y[0].y); o.y = pk2(y[1].x, y[1].y); o.z = pk2(y[2].x, y[2].y); o.w = pk2(y[3].x, y[3].y);
    return o;
}
constexpr int M1_T = 32;
template <int KIND, int T>
__device__ __forceinline__ void m1_strip(const Args& a, int layer, int slab  , int m0  , int lane) {
    constexpr bool SSD = (KIND == 3);
    const bf16_t* PROJ = (const bf16_t*)(a.ws + WS_PROJ) + (SSD ? P_XBC : P_QKVA);
    bf16_t* OUT = (bf16_t*)(a.ws + (SSD ? WS_XBC : WS_GQKV));
    const float* cw = (SSD ? a.in[28] : a.in[21]) + (size_t)layer * 4 * 3072;
    const int ch = slab * 512 + lane * 8;
    float w[4][8], bias[8];
#pragma unroll
    for (int j = 0; j < 4; ++j) load8f(cw + j * 3072 + ch, w[j]);
    if (SSD) load8f(a.in[29] + (size_t)layer * 3072 + ch, bias); else { for (int i = 0; i < 8; ++i) bias[i] = 0.f; }
    const int t0 = m0 & (SEQ - 1), b = m0 >> 11;
    float p1[8], p2[8], p3[8], raw[8];
    if (t0 == 0) { for (int i = 0; i < 8; ++i) { p1[i] = 0.f; p2[i] = 0.f; p3[i] = 0.f; } }
    else { unpack8(*(const u32x4*)(PROJ + (size_t)(m0 - 1) * PW + ch), p1); unpack8(*(const u32x4*)(PROJ + (size_t)(m0 - 2) * PW + ch), p2); unpack8(*(const u32x4*)(PROJ + (size_t)(m0 - 3) * PW + ch), p3); }
    float* cso = a.out + (SSD ? O_PSC : O_PGC) + ((size_t)layer * NB + b) * 3 * 3072 + ch;
    u32x4 rw[8], rn[8];
#pragma unroll
    for (int j = 0; j < 8; ++j) rw[j] = *(const u32x4*)(PROJ + (size_t)(m0 + j) * PW + ch);
#pragma unroll
    for (int tg = 0; tg < T; tg += 8) {
        if (tg + 8 < T) {
#pragma unroll
            for (int j = 0; j < 8; ++j) rn[j] = *(const u32x4*)(PROJ + (size_t)(m0 + tg + 8 + j) * PW + ch);
        }
#pragma unroll
        for (int j = 0; j < 8; ++j) {
            const int t = tg + j, m = m0 + t;
            unpack8(rw[j], raw);
            *(u32x4*)(OUT + (size_t)m * 3072 + ch) = conv_out<KIND>(w, bias, p3, p2, p1, raw);
            if (t0 + t >= SEQ - 3) store8f(cso + (size_t)(t0 + t - (SEQ - 3)) * 3072, raw);
#pragma unroll
            for (int i = 0; i < 8; ++i) { p3[i] = p2[i]; p2[i] = p1[i]; p1[i] = raw[i]; }
        }
#pragma unroll
        for (int j = 0; j < 8; ++j) rw[j] = rn[j];
    }
}
template <int KIND>
__device__ __forceinline__ void m1_samp(const Args& a, int layer, int slab, int s0, int lane) {
    constexpr bool SSD = (KIND == 3);
    const bf16_t* PROJ = (const bf16_t*)(a.ws + WS_PROJ) + (SSD ? P_XBC : P_QKVA);
    bf16_t* OUT = (bf16_t*)(a.ws + (SSD ? WS_XBC : WS_GQKV));
    const float* cw = (SSD ? a.in[28] : a.in[21]) + (size_t)layer * 4 * 3072;
    const int ch = slab * 512 + lane * 8;
    float w[4][8], bias[8];
#pragma unroll
    for (int j = 0; j < 4; ++j) load8f(cw + j * 3072 + ch, w[j]);
    if (SSD) load8f(a.in[29] + (size_t)layer * 3072 + ch, bias); else { for (int i = 0; i < 8; ++i) bias[i] = 0.f; }
    {
        float p1[2][8], p2[2][8], p3[2][8]; u32x4 rw[2];
#pragma unroll
        for (int q = 0; q < 2; ++q) {
            const int s = s0 + q;
            const float* st = (SSD ? a.in[5] : a.in[2]) + ((size_t)layer * NS + s) * 3 * 3072 + ch;
            load8f(st, p3[q]); load8f(st + 3072, p2[q]); load8f(st + 6144, p1[q]);
            rw[q] = *(const u32x4*)(PROJ + (size_t)(NPT + s) * PW + ch);
        }
#pragma unroll
        for (int q = 0; q < 2; ++q) {
            const int s = s0 + q, m = NPT + s;
            float* so = a.out + (SSD ? O_SSC : O_SGC) + ((size_t)layer * NS + s) * 3 * 3072 + ch;
            float raw[8]; unpack8(rw[q], raw);
            *(u32x4*)(OUT + (size_t)m * 3072 + ch) = conv_out<KIND>(w, bias, p3[q], p2[q], p1[q], raw);
            store8f(so, p2[q]); store8f(so + 3072, p1[q]); store8f(so + 6144, raw);
        }
    }
}
template <int NQ>
__device__ __forceinline__ void m1_scalar(const Args& a, int layer, int m0, int lane) {
    const float* SMALL = (const float*)(a.ws + WS_SMALL); float* GB = (float*)(a.ws + WS_GB); float* LA = (float*)(a.ws + WS_LA); float* DT = (float*)(a.ws + WS_DT);
    const float* Wg = a.in[25] + (size_t)layer * 16 * 512; const float* bg = a.in[26] + (size_t)layer * 512;
    {
        float bgv[8];
        load8f(bg + lane * 8, bgv);
        const float alog = lane < 8 ? -__expf(a.in[22][layer * 8 + lane]) : 0.f, dtb = lane < 8 ? a.in[23][layer * 8 + lane] : 0.f, sdb = lane < 32 ? a.in[31][layer * 32 + lane] : 0.f;
        f32x4 lrv[NQ][4]; float sb[NQ], sd[NQ], sdt[NQ];
#pragma unroll
        for (int q = 0; q < NQ; ++q) {
            const float* sm = SMALL + (size_t)(m0 + q) * SW;
#pragma unroll
            for (int i = 0; i < 4; ++i) lrv[q][i] = *(const f32x4*)(sm + S_LR + 4 * i);
            sb[q] = sm[S_BETA + (lane & 7)]; sd[q] = sm[S_DEC + (lane & 7)]; sdt[q] = sm[S_DT + (lane & 31)];
        }
        float acc[NQ][8];
#pragma unroll
        for (int q = 0; q < NQ; ++q)
#pragma unroll
            for (int i = 0; i < 8; ++i) acc[q][i] = bgv[i];
#pragma unroll
        for (int r4 = 0; r4 < 4; ++r4) {
            float wg[4][8];
#pragma unroll
            for (int rr = 0; rr < 4; ++rr) load8f(Wg + (4 * r4 + rr) * 512 + lane * 8, wg[rr]);
#pragma unroll
            for (int rr = 0; rr < 4; ++rr)
#pragma unroll
                for (int q = 0; q < NQ; ++q) { const float lr = lrv[q][r4][rr];
#pragma unroll
                    for (int i = 0; i < 8; ++i) acc[q][i] += lr * wg[rr][i]; }
            asm volatile("" ::: "memory");
        }
#pragma unroll
        for (int q = 0; q < NQ; ++q) {
            const int m = m0 + q;
            if (lane < 8) { GB[(size_t)m * 16 + lane] = sigmoidf_(sb[q]); GB[(size_t)m * 16 + 8 + lane] = alog * softplusf_(sd[q] + dtb); }
            if (lane < 32) DT[(size_t)m * 32 + lane] = softplusf_(sdt[q] + sdb);
#pragma unroll
            for (int i = 0; i < 8; ++i) acc[q][i] = logsigmoidf_(acc[q][i]) * (1.0f / 16.0f);
            store8f(LA + (size_t)m * 512 + lane * 8, acc[q]);
            asm volatile("" ::: "memory");
        }
    }
}
__device__ __forceinline__ void m1_phase(const Args& a, int vcu, int G, int layer) {
    const int tid = ltid(), lane = tid & 63, wave = __builtin_amdgcn_readfirstlane(tid >> 6);
    const int gw = vcu * NWAVES + wave, NGW = G * NWAVES;
    constexpr int NSTRIP = NPT / M1_T, NPAIR = 12 * NSTRIP, NT_W = 2048, NT_H = 2 * (NPAIR - NT_W), NT_S = 12 * (NS / 2);
    static_assert(NPAIR >= NT_W, "task map");
#ifndef REPMASK
#define REPMASK 0
#endif
    for (int rep_ = 0; rep_ < 1 + ((REPMASK >> 26) & 1); ++rep_)
#pragma unroll 1
    for (int task = gw; task < NT_W + NT_H + NT_S; task += NGW) {
        if (task < NT_W) {
            const int slab12 = task % 12, idx = task / 12, slab = slab12 % 6, m0 = idx * M1_T;
            if (slab12 >= 6) m1_strip<3, 32>(a, layer, slab, m0, lane);
            else if (slab < 2) m1_strip<0, 32>(a, layer, slab, m0, lane);
            else if (slab < 4) m1_strip<1, 32>(a, layer, slab, m0, lane);
            else m1_strip<2, 32>(a, layer, slab, m0, lane);
        } else if (task < NT_W + NT_H) {
            const int hh = task - NT_W, u = NT_W + (hh >> 1), slab12 = u % 12, idx = u / 12, slab = slab12 % 6, m0 = idx * M1_T + 16 * (hh & 1);
            if (slab12 >= 6) m1_strip<3, 16>(a, layer, slab, m0, lane);
            else if (slab < 2) m1_strip<0, 16>(a, layer, slab, m0, lane);
            else if (slab < 4) m1_strip<1, 16>(a, layer, slab, m0, lane);
            else m1_strip<2, 16>(a, layer, slab, m0, lane);
        } else {
            const int tk = task - NT_W - NT_H, slab12 = tk % 12, s0 = 2 * (tk / 12), slab = slab12 % 6;
            if (slab12 >= 6) m1_samp<3>(a, layer, slab, s0, lane);
            else if (slab < 2) m1_samp<0>(a, layer, slab, s0, lane);
            else if (slab < 4) m1_samp<1>(a, layer, slab, s0, lane);
            else m1_samp<2>(a, layer, slab, s0, lane);
        }
    }
#ifndef M1_NO_SCALAR
    for (int rep_ = 0; rep_ < 1 + ((REPMASK >> 27) & 1); ++rep_) {
#pragma unroll 1
        for (int task = gw; task < NPT / 2; task += NGW) m1_scalar<2>(a, layer, 2 * task, lane);
#pragma unroll 1
        for (int k = NGW - 1 - gw; k < NS; k += NGW) m1_scalar<1>(a, layer, NPT + k, lane);
    }
#endif
}

__device__ __forceinline__ void tile_g2l(const bf16_t* g, size_t gp, LAS bf16_t* l, int lp, int R, int C, int tid) {
    const int cpr = C / 8, n = R * cpr;
    for (int i = tid; i < n; i += NTHR) { const int r = i / cpr, c = (i % cpr) * 8; *(LAS u32x4*)(l + r * lp + c) = *(const u32x4*)(g + (size_t)r * gp + c); }
}
template <int R, int C>
__device__ __forceinline__ void tile_issue(const bf16_t* g, size_t gp, u32x4 (&v)[R * (C / 8) / NTHR], int tid) {
    constexpr int cpr = C / 8, NI = R * cpr / NTHR;
#pragma unroll
    for (int k = 0; k < NI; ++k) { const int i = tid + k * NTHR, r = i / cpr, c = (i % cpr) * 8; v[k] = *(const u32x4*)(g + (size_t)r * gp + c); }
}
template <int R, int C>
__device__ __forceinline__ void tile_commit(const u32x4 (&v)[R * (C / 8) / NTHR], LAS bf16_t* l, int lp, int tid) {
    constexpr int cpr = C / 8, NI = R * cpr / NTHR;
#pragma unroll
    for (int k = 0; k < NI; ++k) { const int i = tid + k * NTHR, r = i / cpr, c = (i % cpr) * 8; *(LAS u32x4*)(l + r * lp + c) = v[k]; }
}
__device__ __forceinline__ bf16x8 frag(const LAS bf16_t* l, int lp, int r0, int k0, int lane) { return *(const LAS bf16x8*)(l + (r0 + (lane & 15)) * lp + k0 + 8 * (lane >> 4)); }
#define MFMA16(a, b, c) __builtin_amdgcn_mfma_f32_16x16x32_bf16((a), (b), (c), 0, 0, 0)
template <bool TO_LDS, bool TO_GLB>
__device__ __forceinline__ void transpose_scale(const LAS bf16_t* src, int sp, int C, const LAS float* sc, LAS bf16_t* dl, int dp, bf16_t* dg, int tid) {
    const int npass = C / 128;
    const int spair = tid & 31, cg = tid >> 5;
    const float s0 = sc ? sc[2 * spair] : 1.f, s1 = sc ? sc[2 * spair + 1] : 1.f;
    for (int p = 0; p < npass; ++p) {
        const int c0 = p * 128 + cg * 8;
        float a[8], b[8];
        unpack8(*(const LAS u32x4*)(src + (2 * spair) * sp + c0), a); unpack8(*(const LAS u32x4*)(src + (2 * spair + 1) * sp + c0), b);
#pragma unroll
        for (int i = 0; i < 8; ++i) {
            const unsigned w = pk2(a[i] * s0, b[i] * s1);
            if (TO_LDS) *(LAS unsigned*)(dl + (c0 + i) * dp + 2 * spair) = w;
            if (TO_GLB) *(unsigned*)(dg + (size_t)(c0 + i) * 64 + 2 * spair) = w;
        }
    }
}

struct GdnPre { u32x4 t[6]; float beta, g; };
__device__ __forceinline__ void m2_gdn_prefetch(const Args& a, int uid, GdnPre& P) {
    const int tid = ltid(), lane = tid & 63;
    const int h = uid & 7, m0 = (uid >> 3) * 64;
    const bf16_t* GQKV = (const bf16_t*)(a.ws + WS_GQKV) + (size_t)m0 * 3072 + h * 128; const float* GB = (const float*)(a.ws + WS_GB);
#pragma unroll
    for (int q = 0; q < 3; ++q)
#pragma unroll
        for (int j = 0; j < 2; ++j) { const int i = tid + 512 * j; P.t[2 * q + j] = *(const u32x4*)(GQKV + q * 1024 + (size_t)(i >> 4) * 3072 + (i & 15) * 8); }
    P.beta = GB[(size_t)(m0 + lane) * 16 + h]; P.g = GB[(size_t)(m0 + lane) * 16 + 8 + h];
}
__device__ __forceinline__ void m2_gdn_unit(const Args& a, LAS unsigned char* lds, int uid, GdnPre& P, int next_uid) {
    const int tid = ltid(), lane = tid & 63, wave = __builtin_amdgcn_readfirstlane(tid >> 6), c16 = lane & 15, kq = lane >> 4;
    const int h = uid & 7, bc = uid >> 3, m0 = bc * 64;
    LAS bf16_t* Kt = (LAS bf16_t*)(lds);
    LAS bf16_t* Qt = (LAS bf16_t*)(lds + 18432);
    LAS bf16_t* Vt = (LAS bf16_t*)(lds + 36864);
    LAS float* Lm = (LAS float*)(lds + 55296);
    LAS float* Tm = (LAS float*)(lds + 72704);
    LAS bf16_t* VBT = (LAS bf16_t*)(lds + 90112);
    LAS bf16_t* KBT = (LAS bf16_t*)(lds + 110592);
    LAS float* sm = (LAS float*)(lds + 131072);
    LAS float* s_gc = sm, *s_beta = sm + 64, *s_eg = sm + 128, *s_egl = sm + 192, *s_bk = sm + 256;
    LAS bf16_t* Tb = Qt; LAS float* Ys = (LAS float*)Vt;
    const bf16_t* GQKV = (const bf16_t*)(a.ws + WS_GQKV); const float* GB = (const float*)(a.ws + WS_GB);
    bf16_t* G_WK = (bf16_t*)(a.ws + WS_G_WK) + (size_t)uid * 8192; bf16_t* G_QD = (bf16_t*)(a.ws + WS_G_QD) + (size_t)uid * 8192; bf16_t* G_KDT = (bf16_t*)(a.ws + WS_G_KDT) + (size_t)uid * 8192;
    bf16_t* G_QKD = (bf16_t*)(a.ws + WS_G_QKD) + (size_t)uid * 4096; float* G_UT = (float*)(a.ws + WS_G_UT) + (size_t)uid * 8192; float* G_EGL = (float*)(a.ws + WS_G_EGL);
#pragma unroll
    for (int j = 0; j < 2; ++j) { const int i = tid + 512 * j, o = (i >> 4) * 144 + (i & 15) * 8;
        *(LAS u32x4*)(Qt + o) = P.t[j]; *(LAS u32x4*)(Kt + o) = P.t[2 + j]; *(LAS u32x4*)(Vt + o) = P.t[4 + j]; }
    if (wave == 0) {
        const float beta = P.beta, g = P.g;
        float gc = g;
#pragma unroll
        for (int o = 1; o < 64; o <<= 1) { const float v = __shfl_up(gc, o); if (lane >= o) gc += v; }
        const float gl = __shfl(gc, 63);
        s_gc[lane] = gc; s_beta[lane] = beta; s_eg[lane] = __expf(gc); s_egl[lane] = __expf(gl - gc); s_bk[lane] = beta * __expf(gc);
        G_EGL[(size_t)uid * 64 + lane] = __expf(gl);
    }
    LBAR();
    if (next_uid >= 0) m2_gdn_prefetch(a, next_uid, P);
    for (int i = tid; i < 1024; i += NTHR) { const int r = i >> 4, c = (i & 15) * 8; float f[8]; unpack8(*(const LAS u32x4*)(Qt + r * 144 + c), f); const float e = s_eg[r];
#pragma unroll
        for (int j = 0; j < 8; ++j) f[j] *= e;
        *(u32x4*)(G_QD + r * 128 + c) = pack8(f); }
    transpose_scale<true, false>(Vt, 144, 128, s_beta, VBT, 80, nullptr, tid);
    transpose_scale<true, false>(Kt, 144, 128, s_bk, KBT, 80, nullptr, tid);
    transpose_scale<false, true>(Kt, 144, 128, s_egl, nullptr, 0, G_KDT, tid);
    {
        const int ti = wave >> 1;
#pragma unroll
        for (int jj = 0; jj < 2; ++jj) {
            const int tj = (wave & 1) * 2 + jj;
            f32x4 akk = (f32x4){0.f, 0.f, 0.f, 0.f}, aqk = (f32x4){0.f, 0.f, 0.f, 0.f};
            if (tj <= ti) {
#pragma unroll
                for (int ks = 0; ks < 4; ++ks) {
                    const bf16x8 bk = frag(Kt, 144, 16 * tj, 32 * ks, lane);
                    akk = MFMA16(frag(Kt, 144, 16 * ti, 32 * ks, lane), bk, akk);
                    aqk = MFMA16(frag(Qt, 144, 16 * ti, 32 * ks, lane), bk, aqk);
                }
            }
            const int s = 16 * tj + c16; const float gcs = s_gc[s];
#pragma unroll
            for (int j = 0; j < 4; ++j) {
                const int t = 16 * ti + 4 * kq + j; const float dec = __expf(fminf(s_gc[t] - gcs, 0.f));
                Lm[t * 68 + s] = (s < t) ? s_beta[t] * dec * akk[j] : 0.f;
                G_QKD[t * 64 + s] = (bf16_t)f2bf((s <= t) ? aqk[j] * dec : 0.f);
            }
        }
    }
    LBAR();
    if (wave < 4 && lane < 16) {
        float Tc[16]; const int o = 16 * wave;
#pragma unroll
        for (int t = 0; t < 16; ++t) {
            float acc = (t == lane) ? 1.f : 0.f;
#pragma unroll
            for (int s = 0; s < t; ++s) acc -= Lm[(o + t) * 68 + o + s] * Tc[s];
            Tc[t] = acc; Tm[(o + t) * 68 + o + lane] = acc;
        }
    }
    LBAR();
    for (int d = 1; d < 4; ++d) {
        const int np = 4 - d;
        for (int o = tid; o < np * 256; o += NTHR) {
            const int p = o >> 8, r = (o >> 4) & 15, c = o & 15, i = d + p, j = p;
            float acc = 0.f;
            for (int mm = 16 * j; mm < 16 * i; ++mm) acc += Lm[(16 * i + r) * 68 + mm] * Tm[mm * 68 + 16 * j + c];
            Ys[p * 272 + r * 17 + c] = acc;
        }
        LBAR();
        for (int o = tid; o < np * 256; o += NTHR) {
            const int p = o >> 8, r = (o >> 4) & 15, c = o & 15, i = d + p, j = p;
            float acc = 0.f;
#pragma unroll
            for (int mm = 0; mm < 16; ++mm) acc += Tm[(16 * i + r) * 68 + 16 * i + mm] * Ys[p * 272 + mm * 17 + c];
            Tm[(16 * i + r) * 68 + 16 * j + c] = -acc;
        }
        LBAR();
    }
    for (int i = tid; i < 2048; i += NTHR) { const int r = i >> 5, c = (i & 31) * 2;
        const float v0 = (c <= r) ? Tm[r * 68 + c] : 0.f, v1 = (c + 1 <= r) ? Tm[r * 68 + c + 1] : 0.f;
        *(LAS unsigned*)(Tb + r * 80 + c) = pk2(v0, v1); }
    LBAR();
    {
#pragma unroll
        for (int ti = 0; ti < 4; ++ti) {
            f32x4 acc = (f32x4){0.f, 0.f, 0.f, 0.f};
#pragma unroll
            for (int ks = 0; ks < 2; ++ks) acc = MFMA16(frag(Tb, 80, 16 * ti, 32 * ks, lane), frag(VBT, 80, 16 * wave, 32 * ks, lane), acc);
            *(f32x4*)(G_UT + (size_t)(16 * wave + c16) * 64 + 16 * ti + 4 * kq) = acc;
        }
#pragma unroll
        for (int tt = 0; tt < 4; ++tt) {
            f32x4 acc = (f32x4){0.f, 0.f, 0.f, 0.f};
#pragma unroll
            for (int ks = 0; ks < 2; ++ks) acc = MFMA16(frag(KBT, 80, 16 * wave, 32 * ks, lane), frag(Tb, 80, 16 * tt, 32 * ks, lane), acc);
            u32x2 w; w.x = pk2(acc[0], acc[1]); w.y = pk2(acc[2], acc[3]);
            *(u32x2*)(G_WK + (size_t)(16 * tt + c16) * 128 + 16 * wave + 4 * kq) = w;
        }
    }
    LBAR();
}

__device__ __forceinline__ void m2_gla_unit(const Args& a, LAS unsigned char* lds, int uid) {
    const int tid = ltid(), lane = tid & 63, wave = __builtin_amdgcn_readfirstlane(tid >> 6), c16 = lane & 15, kq = lane >> 4;
    const int h = uid & 3, bc = uid >> 2, m0 = bc * 64;
    LAS bf16_t* Qt = (LAS bf16_t*)(lds);
    LAS bf16_t* Kt = (LAS bf16_t*)(lds + 18432);
    LAS bf16_t* Vt = (LAS bf16_t*)(lds + 36864);
    LAS float* Bm = (LAS float*)(lds + 70656);
    LAS float* tot = (LAS float*)(lds + 104448);
    const bf16_t* PROJ = (const bf16_t*)(a.ws + WS_PROJ); const float* LA = (const float*)(a.ws + WS_LA);
    bf16_t* L_QB = (bf16_t*)(a.ws + WS_L_QB) + (size_t)uid * 8192; bf16_t* L_ATT = (bf16_t*)(a.ws + WS_L_ATT) + (size_t)uid * 4096; bf16_t* L_KDT = (bf16_t*)(a.ws + WS_L_KDT) + (size_t)uid * 8192;
    bf16_t* L_VT = (bf16_t*)(a.ws + WS_L_VT) + (size_t)uid * 16384; float* L_EBL = (float*)(a.ws + WS_L_EBL) + (size_t)uid * 128;
    const int d = tid & 127, seg = tid >> 7;
    float bl[16];
    {
        u32x4 tq[2], tk[2], tv[4];
        tile_issue<64, 128>(PROJ + (size_t)m0 * PW + P_QB + h * 128, PW, tq, tid);
        tile_issue<64, 128>(PROJ + (size_t)m0 * PW + P_KB + h * 128, PW, tk, tid);
        tile_issue<64, 256>(PROJ + (size_t)m0 * PW + P_VB + h * 256, PW, tv, tid);
#pragma unroll
        for (int i = 0; i < 16; ++i) bl[i] = LA[(size_t)(m0 + 16 * seg + i) * 512 + h * 128 + d];
        tile_commit<64, 128>(tq, Qt, 144, tid); tile_commit<64, 128>(tk, Kt, 144, tid); tile_commit<64, 256>(tv, Vt, 264, tid);
        float run = 0.f;
#pragma unroll
        for (int i = 0; i < 16; ++i) { run += bl[i]; bl[i] = run; }
        tot[seg * 128 + d] = run;
    }
    LBAR();
    {
        float off = 0.f;
        for (int s2 = 0; s2 < seg; ++s2) off += tot[s2 * 128 + d];
#pragma unroll
        for (int i = 0; i < 16; ++i) Bm[(16 * seg + i) * 132 + d] = bl[i] + off;
    }
    LBAR();
    transpose_scale<false, true>(Vt, 264, 256, nullptr, nullptr, 0, L_VT, tid);
    {
        const int spair = tid & 31, cg = tid >> 5, c0 = cg * 8;
        float k0[8], k1[8];
        unpack8(*(const LAS u32x4*)(Kt + (2 * spair) * 144 + c0), k0); unpack8(*(const LAS u32x4*)(Kt + (2 * spair + 1) * 144 + c0), k1);
#pragma unroll
        for (int i = 0; i < 8; ++i) {
            const float bL = Bm[63 * 132 + c0 + i];
            const unsigned w = pk2(k0[i] * __expf(bL - Bm[(2 * spair) * 132 + c0 + i]), k1[i] * __expf(bL - Bm[(2 * spair + 1) * 132 + c0 + i]));
            *(unsigned*)(L_KDT + (size_t)(c0 + i) * 64 + 2 * spair) = w;
        }
        if (tid < 128) L_EBL[tid] = __expf(Bm[63 * 132 + tid]);
    }
    LBAR();
    for (int i = tid; i < 1024; i += NTHR) { const int r = i >> 4, c = (i & 15) * 8; float q[8], k[8];
        unpack8(*(const LAS u32x4*)(Qt + r * 144 + c), q); unpack8(*(const LAS u32x4*)(Kt + r * 144 + c), k);
#pragma unroll
        for (int j = 0; j < 8; ++j) { const float bb = Bm[r * 132 + c + j]; q[j] *= 0.08838834764831845f * __expf(bb); k[j] *= __expf(-bb); }
        const u32x4 qw = pack8(q); *(LAS u32x4*)(Qt + r * 144 + c) = qw; *(u32x4*)(L_QB + r * 128 + c) = qw; *(LAS u32x4*)(Kt + r * 144 + c) = pack8(k); }
    LBAR();
    {
        const int ti = wave >> 1;
#pragma unroll
        for (int jj = 0; jj < 2; ++jj) {
            const int tj = (wave & 1) * 2 + jj;
            f32x4 acc = (f32x4){0.f, 0.f, 0.f, 0.f};
            if (tj <= ti) {
#pragma unroll
                for (int ks = 0; ks < 4; ++ks) acc = MFMA16(frag(Qt, 144, 16 * ti, 32 * ks, lane), frag(Kt, 144, 16 * tj, 32 * ks, lane), acc);
            }
            const int s = 16 * tj + c16;
#pragma unroll
            for (int j = 0; j < 4; ++j) { const int t = 16 * ti + 4 * kq + j; L_ATT[t * 64 + s] = (bf16_t)f2bf((s <= t) ? acc[j] : 0.f); }
        }
    }
    LBAR();
}

__device__ __forceinline__ void m2_ssd_unit(const Args& a, LAS unsigned char* lds, int uid, int layer) {
    const int tid = ltid(), lane = tid & 63, wave = __builtin_amdgcn_readfirstlane(tid >> 6), c16 = lane & 15, kq = lane >> 4;
    const int g = uid & 3, bc = uid >> 2, m0 = bc * 64;
    LAS bf16_t* Bt_ = (LAS bf16_t*)(lds);
    LAS bf16_t* Ct_ = (LAS bf16_t*)(lds + 18432);
    LAS bf16_t* Xt = (LAS bf16_t*)(lds + 36864);
    LAS float* CB = (LAS float*)(lds + 103424);
    LAS float* s_dt = (LAS float*)(lds + 120832);
    LAS float* s_ac = s_dt + 512;
    LAS float* s_e2 = s_ac + 512;
    const bf16_t* XBC = (const bf16_t*)(a.ws + WS_XBC); const float* DT = (const float*)(a.ws + WS_DT);
    float dt_pre;
    {
        u32x4 tb[2], tc[2], tx[8];
        tile_issue<64, 128>(XBC + (size_t)m0 * 3072 + 2048 + g * 128, 3072, tb, tid);
        tile_issue<64, 128>(XBC + (size_t)m0 * 3072 + 2560 + g * 128, 3072, tc, tid);
        tile_issue<64, 512>(XBC + (size_t)m0 * 3072 + g * 512, 3072, tx, tid);
        dt_pre = DT[(size_t)(m0 + lane) * 32 + g * 8 + wave];
        tile_commit<64, 128>(tb, Bt_, 144, tid); tile_commit<64, 128>(tc, Ct_, 144, tid); tile_commit<64, 512>(tx, Xt, 520, tid);
    }
    {
        const int hh = wave, hd = g * 8 + hh, su = (bc * 32 + hd);
        const float dt = dt_pre, A = -__expf(a.in[30][layer * 32 + hd]);
        float ac = dt * A;
#pragma unroll
        for (int o = 1; o < 64; o <<= 1) { const float v = __shfl_up(ac, o); if (lane >= o) ac += v; }
        const float al_ = __shfl(ac, 63);
        s_dt[hh * 64 + lane] = dt; s_ac[hh * 64 + lane] = ac; s_e2[hh * 64 + lane] = __expf(al_ - ac);
        ((float*)(a.ws + WS_S_EA))[(size_t)su * 64 + lane] = __expf(ac);
        ((float*)(a.ws + WS_S_EAL))[(size_t)su * 64 + lane] = __expf(al_);
    }
    LBAR();
    {
        const int ti = wave >> 1;
#pragma unroll
        for (int jj = 0; jj < 2; ++jj) {
            const int tj = (wave & 1) * 2 + jj;
            f32x4 acc = (f32x4){0.f, 0.f, 0.f, 0.f};
            if (tj <= ti) {
#pragma unroll
                for (int ks = 0; ks < 4; ++ks) acc = MFMA16(frag(Ct_, 144, 16 * ti, 32 * ks, lane), frag(Bt_, 144, 16 * tj, 32 * ks, lane), acc);
            }
#pragma unroll
            for (int j = 0; j < 4; ++j) CB[(16 * ti + 4 * kq + j) * 68 + 16 * tj + c16] = acc[j];
        }
    }
    transpose_scale<false, true>(Bt_, 144, 128, nullptr, nullptr, 0, (bf16_t*)(a.ws + WS_S_BT) + (size_t)uid * 8192, tid);
    {
        const int spair = tid & 31, cg = tid >> 5;
        for (int p = 0; p < 4; ++p) {
            const int c0 = p * 128 + cg * 8, hh = c0 >> 6, pp = c0 & 63; const size_t su = (size_t)(bc * 32 + g * 8 + hh);
            float x0[8], x1[8];
            unpack8(*(const LAS u32x4*)(Xt + (2 * spair) * 520 + c0), x0); unpack8(*(const LAS u32x4*)(Xt + (2 * spair + 1) * 520 + c0), x1);
            const float d0 = s_dt[hh * 64 + 2 * spair], d1 = s_dt[hh * 64 + 2 * spair + 1], e0 = s_e2[hh * 64 + 2 * spair], e1 = s_e2[hh * 64 + 2 * spair + 1];
            bf16_t* o1 = (bf16_t*)(a.ws + WS_S_XDTT) + su * 4096; bf16_t* o2 = (bf16_t*)(a.ws + WS_S_XDT2T) + su * 4096;
#pragma unroll
            for (int i = 0; i < 8; ++i) {
                const float v0 = x0[i] * d0, v1 = x1[i] * d1;
                *(unsigned*)(o1 + (pp + i) * 64 + 2 * spair) = pk2(v0, v1);
                *(unsigned*)(o2 + (pp + i) * 64 + 2 * spair) = pk2(v0 * e0, v1 * e1);
            }
        }
    }
    LBAR();
    for (int i = tid; i < 8 * 2048; i += NTHR) {
        const int hh = i >> 11, r = (i >> 5) & 63, c = (i & 31) * 2; const size_t su = (size_t)(bc * 32 + g * 8 + hh);
        const float at = s_ac[hh * 64 + r];
        const float v0 = (c <= r) ? CB[r * 68 + c] * __expf(fminf(at - s_ac[hh * 64 + c], 0.f)) : 0.f;
        const float v1 = (c + 1 <= r) ? CB[r * 68 + c + 1] * __expf(fminf(at - s_ac[hh * 64 + c + 1], 0.f)) : 0.f;
        *(unsigned*)((bf16_t*)(a.ws + WS_S_MH) + su * 4096 + r * 64 + c) = pk2(v0, v1);
    }
    LBAR();
}
__device__ __forceinline__ void m2_phase(const Args& a, LAS unsigned char* lds, int vcu, int G, int layer) {
    if (vcu < NGU) {
        GdnPre P; m2_gdn_prefetch(a, vcu, P);
        for (int u = vcu; u < NGU; u += G) m2_gdn_unit(a, lds, u, P, u + G < NGU ? u + G : -1);
    }
    for (int u = vcu + ((NGU - vcu + G - 1) / G) * G; u < NGU + NLU + NSG; u += G) {
        if (u < NGU) { }
        else if (u < NGU + NLU) m2_gla_unit(a, lds, u - NGU);
        else m2_ssd_unit(a, lds, u - NGU - NLU, layer);
    }
}

#define LD16(p) (*(const u32x4*)(p))

__device__ __forceinline__ void scan_gdn_unit(const Args& a, LAS unsigned char* lds, int unit, int layer) {
    const int tid = ltid(), lane = tid & 63, wave = __builtin_amdgcn_readfirstlane(tid >> 6), c16 = lane & 15, kq = lane >> 4;
    const int j = unit & 3, h = (unit >> 2) & 7, b = unit >> 5;
    constexpr int OFF_P = 0, OFF_KDT = 36864, BUFSZ = 57344;
    LAS bf16_t* St = (LAS bf16_t*)(lds + 2 * BUFSZ);
    LAS bf16_t* wT = (LAS bf16_t*)(lds + 2 * BUFSZ + 9216);
    const bf16_t* G_WK = (const bf16_t*)(a.ws + WS_G_WK); const bf16_t* G_QD = (const bf16_t*)(a.ws + WS_G_QD); const bf16_t* G_KDT = (const bf16_t*)(a.ws + WS_G_KDT);
    const bf16_t* G_QKD = (const bf16_t*)(a.ws + WS_G_QKD); const float* G_UT = (const float*)(a.ws + WS_G_UT); const float* G_EGL = (const float*)(a.ws + WS_G_EGL);
    bf16_t* OA = (bf16_t*)(a.ws + WS_OA);
    struct Regs { u32x4 r[6]; u32x4 rx[2]; float egl; };
    auto issue = [&](Regs& R, int c) {
        const size_t uid = (size_t)((b * 32 + c) * 8 + h);
        const bf16_t* wk = G_WK + uid * 8192; const bf16_t* qd = G_QD + uid * 8192; const bf16_t* kdt = G_KDT + uid * 8192; const bf16_t* qkd = G_QKD + uid * 4096;
        R.r[0] = LD16(wk + (size_t)tid * 8); R.r[1] = LD16(wk + (size_t)(tid + 512) * 8);
        R.r[2] = LD16(qd + (size_t)tid * 8); R.r[3] = LD16(qd + (size_t)(tid + 512) * 8);
        R.r[4] = LD16(kdt + (size_t)tid * 8); R.r[5] = LD16(kdt + (size_t)(tid + 512) * 8);
        {
            const char* p0 = wave < 4 ? (const char*)(G_UT + uid * 8192 + (size_t)(32 * j + c16) * 64 + 16 * wave + 4 * kq) : (const char*)(qkd + (size_t)(16 * (wave - 4) + c16) * 64 + 8 * kq);
            const size_t st = wave < 4 ? (size_t)16 * 64 * 4 : (size_t)32 * 2;
            R.rx[0] = LD16(p0); R.rx[1] = LD16(p0 + st);
        }
        R.egl = G_EGL[uid * 64 + lane];
    };
    auto commit = [&](const Regs& R, int buf) {
        LAS unsigned char* B = lds + buf * BUFSZ;
        *(LAS u32x4*)(B + OFF_P + ((tid >> 4) * 144 + (tid & 15) * 8) * 2) = R.r[0]; *(LAS u32x4*)(B + OFF_P + (((tid + 512) >> 4) * 144 + (tid & 15) * 8) * 2) = R.r[1];
        *(LAS u32x4*)(B + OFF_P + ((64 + (tid >> 4)) * 144 + (tid & 15) * 8) * 2) = R.r[2]; *(LAS u32x4*)(B + OFF_P + ((64 + ((tid + 512) >> 4)) * 144 + (tid & 15) * 8) * 2) = R.r[3];
        *(LAS u32x4*)(B + OFF_KDT + ((tid >> 3) * 80 + (tid & 7) * 8) * 2) = R.r[4]; *(LAS u32x4*)(B + OFF_KDT + (((tid + 512) >> 3) * 80 + (tid & 7) * 8) * 2) = R.r[5];
    };
    f32x4 Sreg[2] = {(f32x4){0.f, 0.f, 0.f, 0.f}, (f32x4){0.f, 0.f, 0.f, 0.f}};
#pragma unroll
    for (int tj = 0; tj < 2; ++tj) *(LAS u32x2*)(St + (16 * tj + c16) * 144 + 16 * wave + 4 * kq) = (u32x2){0u, 0u};
    Regs RA, RB, RC;
    issue(RA, 0); commit(RA, 0);
    u32x4 cx[2] = {RA.rx[0], RA.rx[1]}; float cegl = RA.egl;
    issue(RB, 1); issue(RC, 2); issue(RA, 3);
    auto step = [&](int c, Regs& Rn) {
        LBAR();
        const LAS unsigned char* B = lds + (c & 1) * BUFSZ;
        const LAS bf16_t* P = (const LAS bf16_t*)(B + OFF_P); const LAS bf16_t* KDT = (const LAS bf16_t*)(B + OFF_KDT);
        f32x4 p[2] = {(f32x4){0.f, 0.f, 0.f, 0.f}, (f32x4){0.f, 0.f, 0.f, 0.f}};
#pragma unroll
        for (int ks = 0; ks < 4; ++ks) {
            const bf16x8 af = frag(P, 144, 16 * wave, 32 * ks, lane);
#pragma unroll
            for (int tj = 0; tj < 2; ++tj) p[tj] = MFMA16(af, frag(St, 144, 16 * tj, 32 * ks, lane), p[tj]);
        }
        if (wave < 4) {
#pragma unroll
            for (int tj = 0; tj < 2; ++tj) { const f32x4 w = __builtin_bit_cast(f32x4, cx[tj]) - p[tj]; u32x2 o; o.x = pk2(w[0], w[1]); o.y = pk2(w[2], w[3]); *(LAS u32x2*)(wT + (16 * tj + c16) * 80 + 16 * wave + 4 * kq) = o; }
        }
        LBAR();
        if (wave >= 4) {
            const int ti = wave - 4;
#pragma unroll
            for (int ks = 0; ks < 2; ++ks) {
                const bf16x8 af = __builtin_bit_cast(bf16x8, cx[ks]);
#pragma unroll
                for (int tj = 0; tj < 2; ++tj) p[tj] = MFMA16(af, frag(wT, 80, 16 * tj, 32 * ks, lane), p[tj]);
            }
        }
#pragma unroll
        for (int tj = 0; tj < 2; ++tj) Sreg[tj] = Sreg[tj] * cegl;
#pragma unroll
        for (int ks = 0; ks < 2; ++ks) {
            const bf16x8 af = frag(KDT, 80, 16 * wave, 32 * ks, lane);
#pragma unroll
            for (int tj = 0; tj < 2; ++tj) Sreg[tj] = MFMA16(af, frag(wT, 80, 16 * tj, 32 * ks, lane), Sreg[tj]);
        }
#pragma unroll
        for (int tj = 0; tj < 2; ++tj) { u32x2 o; o.x = pk2(Sreg[tj][0], Sreg[tj][1]); o.y = pk2(Sreg[tj][2], Sreg[tj][3]); *(LAS u32x2*)(St + (16 * tj + c16) * 144 + 16 * wave + 4 * kq) = o; }
        if (c + 1 < NCHUNK) { commit(Rn, (c + 1) & 1); cx[0] = Rn.rx[0]; cx[1] = Rn.rx[1]; cegl = Rn.egl; if (c + 4 < NCHUNK) issue(Rn, c + 4); }
        if (wave >= 4) {
            bf16_t* op = OA + ((size_t)b * SEQ + c * 64 + 16 * (wave - 4) + 4 * kq) * 1024 + h * 128 + 32 * j + c16;
#pragma unroll
            for (int tj = 0; tj < 2; ++tj)
#pragma unroll
                for (int i = 0; i < 4; ++i) st16_asm(op + (size_t)i * 1024 + 16 * tj, f2bf(p[tj][i]));
        }
    };
#pragma unroll
    for (int c = 0; c < NCHUNK - 2; c += 3) { step(c, RB); step(c + 1, RC); step(c + 2, RA); }
    step(NCHUNK - 2, RB); step(NCHUNK - 1, RC);
    float* so = a.out + O_PG + (((size_t)layer * NB + b) * 8 + h) * 16384;
#pragma unroll
    for (int tj = 0; tj < 2; ++tj)
#pragma unroll
        for (int i = 0; i < 4; ++i) so[(size_t)(16 * wave + 4 * kq + i) * 128 + 32 * j + 16 * tj + c16] = Sreg[tj][i];
    LBAR();
}

__device__ __forceinline__ void scan_gla_unit(const Args& a, LAS unsigned char* lds, int unit, int layer) {
    const int tid = ltid(), lane = tid & 63, wave = __builtin_amdgcn_readfirstlane(tid >> 6), c16 = lane & 15, kq = lane >> 4;
    const int j = unit & 7, h = (unit >> 3) & 3, b = unit >> 5;
    constexpr int OFF_ATT = 0, OFF_QB = 10240, OFF_KDT = 28672, OFF_VT = 49152, OFF_EBL = 54272, BUFSZ = 54784;
    LAS bf16_t* St0 = (LAS bf16_t*)(lds + 2 * BUFSZ);
    const bf16_t* L_QB = (const bf16_t*)(a.ws + WS_L_QB); const bf16_t* L_ATT = (const bf16_t*)(a.ws + WS_L_ATT); const bf16_t* L_KDT = (const bf16_t*)(a.ws + WS_L_KDT);
    const bf16_t* L_VT = (const bf16_t*)(a.ws + WS_L_VT); const float* L_EBL = (const float*)(a.ws + WS_L_EBL);
    bf16_t* OB = (bf16_t*)(a.ws + WS_OB);
    struct Regs { u32x4 r[7]; };
    auto issue = [&](Regs& R, int c) {
        const size_t uid = (size_t)((b * 32 + c) * 4 + h);
        const bf16_t* att = L_ATT + uid * 4096; const bf16_t* qb = L_QB + uid * 8192; const bf16_t* kdt = L_KDT + uid * 8192; const bf16_t* vt = L_VT + uid * 16384 + (size_t)(32 * j) * 64;
        R.r[0] = LD16(att + (size_t)tid * 8);
        R.r[1] = LD16(qb + (size_t)tid * 8); R.r[2] = LD16(qb + (size_t)(tid + 512) * 8);
        R.r[3] = LD16(kdt + (size_t)tid * 8); R.r[4] = LD16(kdt + (size_t)(tid + 512) * 8);
        R.r[5] = LD16(vt + (size_t)(tid & 255) * 8);
        R.r[6] = LD16((const bf16_t*)(L_EBL + uid * 128) + (size_t)(tid & 31) * 8);
    };
    auto commit = [&](const Regs& R, int buf) {
        LAS unsigned char* B = lds + buf * BUFSZ;
        *(LAS u32x4*)(B + OFF_ATT + ((tid >> 3) * 80 + (tid & 7) * 8) * 2) = R.r[0];
        *(LAS u32x4*)(B + OFF_QB + ((tid >> 4) * 144 + (tid & 15) * 8) * 2) = R.r[1]; *(LAS u32x4*)(B + OFF_QB + (((tid + 512) >> 4) * 144 + (tid & 15) * 8) * 2) = R.r[2];
        *(LAS u32x4*)(B + OFF_KDT + ((tid >> 3) * 80 + (tid & 7) * 8) * 2) = R.r[3]; *(LAS u32x4*)(B + OFF_KDT + (((tid + 512) >> 3) * 80 + (tid & 7) * 8) * 2) = R.r[4];
        if (tid < 256) *(LAS u32x4*)(B + OFF_VT + ((tid >> 3) * 80 + (tid & 7) * 8) * 2) = R.r[5];
        if (tid < 32) *(LAS u32x4*)(B + OFF_EBL + tid * 16) = R.r[6];
    };
    f32x4 Sreg[2] = {(f32x4){0.f, 0.f, 0.f, 0.f}, (f32x4){0.f, 0.f, 0.f, 0.f}};
#pragma unroll
    for (int tj = 0; tj < 2; ++tj) *(LAS u32x2*)(St0 + (16 * tj + c16) * 144 + 16 * wave + 4 * kq) = (u32x2){0u, 0u};
    Regs RA, RB, RC;
    issue(RA, 0); commit(RA, 0); issue(RB, 1); issue(RC, 2); issue(RA, 3);
    auto step = [&](int c, Regs& Rn) {
        LBAR();
        const LAS unsigned char* B = lds + (c & 1) * BUFSZ;
        const LAS bf16_t* ATT = (const LAS bf16_t*)(B + OFF_ATT); const LAS bf16_t* QB = (const LAS bf16_t*)(B + OFF_QB); const LAS bf16_t* KDT = (const LAS bf16_t*)(B + OFF_KDT);
        const LAS bf16_t* VT = (const LAS bf16_t*)(B + OFF_VT); const LAS float* EBL = (const LAS float*)(B + OFF_EBL);
        const LAS bf16_t* Sc = St0 + (c & 1) * (32 * 144); LAS bf16_t* Sn = St0 + ((c + 1) & 1) * (32 * 144);
        f32x4 oo;
        {
            const int ti = wave >> 1, tj = wave & 1;
            f32x4 o = (f32x4){0.f, 0.f, 0.f, 0.f};
#pragma unroll
            for (int ks = 0; ks < 2; ++ks) o = MFMA16(frag(ATT, 80, 16 * ti, 32 * ks, lane), frag(VT, 80, 16 * tj, 32 * ks, lane), o);
#pragma unroll
            for (int ks = 0; ks < 4; ++ks) o = MFMA16(frag(QB, 144, 16 * ti, 32 * ks, lane), frag(Sc, 144, 16 * tj, 32 * ks, lane), o);
            oo = o;
        }
        {
            const f32x4 e = *(const LAS f32x4*)(EBL + 16 * wave + 4 * kq);
#pragma unroll
            for (int tj = 0; tj < 2; ++tj) Sreg[tj] = Sreg[tj] * e;
#pragma unroll
            for (int ks = 0; ks < 2; ++ks) {
                const bf16x8 af = frag(KDT, 80, 16 * wave, 32 * ks, lane);
#pragma unroll
                for (int tj = 0; tj < 2; ++tj) Sreg[tj] = MFMA16(af, frag(VT, 80, 16 * tj, 32 * ks, lane), Sreg[tj]);
            }
#pragma unroll
            for (int tj = 0; tj < 2; ++tj) { u32x2 o; o.x = pk2(Sreg[tj][0], Sreg[tj][1]); o.y = pk2(Sreg[tj][2], Sreg[tj][3]); *(LAS u32x2*)(Sn + (16 * tj + c16) * 144 + 16 * wave + 4 * kq) = o; }
        }
        if (c + 1 < NCHUNK) { commit(Rn, (c + 1) & 1); if (c + 4 < NCHUNK) issue(Rn, c + 4); }
        {
            bf16_t* op = OB + ((size_t)b * SEQ + c * 64 + 16 * (wave >> 1) + 4 * kq) * 1024 + h * 256 + 32 * j + 16 * (wave & 1) + c16;
#pragma unroll
            for (int i = 0; i < 4; ++i) st16_asm(op + (size_t)i * 1024, f2bf(oo[i]));
        }
    };
#pragma unroll
    for (int c = 0; c < NCHUNK - 2; c += 3) { step(c, RB); step(c + 1, RC); step(c + 2, RA); }
    step(NCHUNK - 2, RB); step(NCHUNK - 1, RC);
    float* so = a.out + O_PL + (((size_t)layer * NB + b) * 4 + h) * 32768;
#pragma unroll
    for (int tj = 0; tj < 2; ++tj)
#pragma unroll
        for (int i = 0; i < 4; ++i) so[(size_t)(16 * wave + 4 * kq + i) * 256 + 32 * j + 16 * tj + c16] = Sreg[tj][i];
    LBAR();
}

template <int DUMMY>
__device__ __forceinline__ void scan_ssd_unit(const Args& a, LAS unsigned char* lds, int unit, int layer) {
    const int tid = ltid(), lane = tid & 63, wave = __builtin_amdgcn_readfirstlane(tid >> 6), c16 = lane & 15, kq = lane >> 4;
    const int h = unit & 31, b = unit >> 5, g = h >> 3;
    constexpr int OFF_MH = 0, OFF_X1 = 10240, OFF_X2 = 20480, OFF_BT = 30720, OFF_EA = 51200, BUFSZ = 51456;
    LAS bf16_t* Hs0 = (LAS bf16_t*)(lds + 2 * BUFSZ);
    const bf16_t* S_MH = (const bf16_t*)(a.ws + WS_S_MH); const bf16_t* S_X1 = (const bf16_t*)(a.ws + WS_S_XDTT); const bf16_t* S_X2 = (const bf16_t*)(a.ws + WS_S_XDT2T);
    const bf16_t* S_BT = (const bf16_t*)(a.ws + WS_S_BT); const float* S_EA = (const float*)(a.ws + WS_S_EA); const float* S_EAL = (const float*)(a.ws + WS_S_EAL);
    const bf16_t* XBC = (const bf16_t*)(a.ws + WS_XBC); bf16_t* YC = (bf16_t*)(a.ws + WS_YC);
    struct Regs { u32x4 r[6]; bf16x8 rc[4]; };
    const int ti = wave >> 1;
    auto issue = [&](Regs& R, int c) {
        const size_t su = (size_t)((b * 32 + c) * 32 + h), sg = (size_t)((b * 32 + c) * 4 + g);
        R.r[0] = LD16(S_MH + su * 4096 + (size_t)tid * 8); R.r[1] = LD16(S_X1 + su * 4096 + (size_t)tid * 8); R.r[2] = LD16(S_X2 + su * 4096 + (size_t)tid * 8);
        R.r[3] = LD16(S_BT + sg * 8192 + (size_t)tid * 8); R.r[4] = LD16(S_BT + sg * 8192 + (size_t)(tid + 512) * 8);
        R.r[5] = LD16((const bf16_t*)(S_EA + su * 64) + (size_t)(tid & 15) * 8);
        const bf16_t* cr = XBC + ((size_t)b * SEQ + c * 64 + 16 * ti + c16) * 3072 + 2560 + g * 128 + 8 * kq;
#pragma unroll
        for (int ks = 0; ks < 4; ++ks) { if (DUMMY != 2) R.rc[ks] = *(const bf16x8*)(cr + 32 * ks); else R.rc[ks] = __builtin_bit_cast(bf16x8, R.r[ks]); }
    };
    auto commit = [&](const Regs& R, int buf) {
        LAS unsigned char* B = lds + buf * BUFSZ;
        const int o = ((tid >> 3) * 80 + (tid & 7) * 8) * 2;
        *(LAS u32x4*)(B + OFF_MH + o) = R.r[0]; *(LAS u32x4*)(B + OFF_X1 + o) = R.r[1]; *(LAS u32x4*)(B + OFF_X2 + o) = R.r[2];
        *(LAS u32x4*)(B + OFF_BT + o) = R.r[3]; *(LAS u32x4*)(B + OFF_BT + (((tid + 512) >> 3) * 80 + (tid & 7) * 8) * 2) = R.r[4];
        if (tid < 16) *(LAS u32x4*)(B + OFF_EA + tid * 16) = R.r[5];
    };
    f32x4 Hreg[4];
#pragma unroll
    for (int tp = 0; tp < 4; ++tp) { Hreg[tp] = (f32x4){0.f, 0.f, 0.f, 0.f}; *(LAS u32x2*)(Hs0 + (16 * tp + c16) * 144 + 16 * wave + 4 * kq) = (u32x2){0u, 0u}; }
    Regs RA, RB;
    issue(RA, 0); commit(RA, 0);
    bf16x8 cc[4] = {RA.rc[0], RA.rc[1], RA.rc[2], RA.rc[3]};
    issue(RB, 1); issue(RA, 2);
    auto step = [&](int c, Regs& Rn) {
        LBAR();
        const LAS unsigned char* B = lds + (c & 1) * BUFSZ;
        const LAS bf16_t* MH = (const LAS bf16_t*)(B + OFF_MH); const LAS bf16_t* X1 = (const LAS bf16_t*)(B + OFF_X1); const LAS bf16_t* X2 = (const LAS bf16_t*)(B + OFF_X2);
        const LAS bf16_t* BT = (const LAS bf16_t*)(B + OFF_BT); const LAS float* EA = (const LAS float*)(B + OFF_EA);
        const LAS bf16_t* Hc = Hs0 + (c & 1) * (64 * 144); LAS bf16_t* Hn = Hs0 + ((c + 1) & 1) * (64 * 144);
        f32x4 yy[2];
        {
            const f32x4 ea = *(const LAS f32x4*)(EA + 16 * ti + 4 * kq);
#pragma unroll
            for (int q = 0; q < 2; ++q) {
                const int tp = 2 * (wave & 1) + q;
                f32x4 y1 = (f32x4){0.f, 0.f, 0.f, 0.f}, y2 = (f32x4){0.f, 0.f, 0.f, 0.f};
#pragma unroll
                for (int ks = 0; ks < 2; ++ks) y1 = MFMA16(frag(MH, 80, 16 * ti, 32 * ks, lane), frag(X1, 80, 16 * tp, 32 * ks, lane), y1);
#pragma unroll
                for (int ks = 0; ks < 4; ++ks) y2 = MFMA16(cc[ks], frag(Hc, 144, 16 * tp, 32 * ks, lane), y2);
                yy[q] = y1 + ea * y2;
            }
        }
        const float ceal = EA[63];
#pragma unroll
        for (int tp = 0; tp < 4; ++tp) Hreg[tp] = Hreg[tp] * ceal;
#pragma unroll
        for (int ks = 0; ks < 2; ++ks) {
            const bf16x8 af = frag(BT, 80, 16 * wave, 32 * ks, lane);
#pragma unroll
            for (int tp = 0; tp < 4; ++tp) Hreg[tp] = MFMA16(af, frag(X2, 80, 16 * tp, 32 * ks, lane), Hreg[tp]);
        }
#pragma unroll
        for (int tp = 0; tp < 4; ++tp) { u32x2 o; o.x = pk2(Hreg[tp][0], Hreg[tp][1]); o.y = pk2(Hreg[tp][2], Hreg[tp][3]); *(LAS u32x2*)(Hn + (16 * tp + c16) * 144 + 16 * wave + 4 * kq) = o; }
        if (c + 1 < NCHUNK) { commit(Rn, (c + 1) & 1); cc[0] = Rn.rc[0]; cc[1] = Rn.rc[1]; cc[2] = Rn.rc[2]; cc[3] = Rn.rc[3]; if (c + 3 < NCHUNK) issue(Rn, c + 3); }
        {
            bf16_t* yp = YC + ((size_t)b * SEQ + c * 64 + 16 * ti + 4 * kq) * 2048 + h * 64 + 32 * (wave & 1) + c16;
#pragma unroll
            for (int q = 0; q < 2; ++q)
#pragma unroll
                for (int i = 0; i < 4; ++i) { if (DUMMY != 1) st16_asm(yp + (size_t)i * 2048 + 16 * q, f2bf(yy[q][i])); else asm volatile("" :: "v"(yy[q][i])); }
        }
    };
#pragma unroll
    for (int c = 0; c < NCHUNK; c += 2) { step(c, RB); step(c + 1, RA); }
    float* so = a.out + O_PS + (((size_t)layer * NB + b) * 32 + h) * 8192;
#pragma unroll
    for (int tp = 0; tp < 4; ++tp) { if (DUMMY == 0) *(f32x4*)(so + (size_t)(16 * tp + c16) * 128 + 16 * wave + 4 * kq) = Hreg[tp]; else asm volatile("" :: "v"(Hreg[tp])); }
    LBAR();
}

__device__ __forceinline__ void samp_gdn_loop(const Args& a, LAS unsigned char* lds, int u0, int ustride, int uend, int layer) {
    const int tid = ltid();
    LAS float* sk = (LAS float*)lds, *sq = sk + 128, *sv = sk + 256, *sw = sk + 384, *red = sk + 512;
    const int dv = 4 * (tid & 31), dkb = tid >> 5;
    if (u0 >= uend) return;
    f32x4 S[8], Sn[8];
    { const int h = u0 & 7, s = u0 >> 3; const float* Sin = a.in[3] + (((size_t)layer * NS + s) * 8 + h) * 16384;
#pragma unroll
      for (int i = 0; i < 8; ++i) S[i] = __builtin_nontemporal_load((const f32x4*)(Sin + (size_t)(8 * dkb + i) * 128 + dv)); }
#pragma unroll 1
    for (int unit = u0; unit < uend; unit += ustride) {
        const int h = unit & 7, s = unit >> 3, m = NPT + s, un = unit + ustride;
        if (un < uend) { const int hn = un & 7, sn = un >> 3; const float* Sin = a.in[3] + (((size_t)layer * NS + sn) * 8 + hn) * 16384;
#pragma unroll
            for (int i = 0; i < 8; ++i) Sn[i] = __builtin_nontemporal_load((const f32x4*)(Sin + (size_t)(8 * dkb + i) * 128 + dv)); }
        const bf16_t* GQKV = (const bf16_t*)(a.ws + WS_GQKV) + (size_t)m * 3072; const float* GB = (const float*)(a.ws + WS_GB) + (size_t)m * 16;
        float* Sout = a.out + O_SG + (((size_t)layer * NS + s) * 8 + h) * 16384;
        if (tid < 128) { sq[tid] = bf2f(GQKV[h * 128 + tid]); sk[tid] = bf2f(GQKV[1024 + h * 128 + tid]); sv[tid] = bf2f(GQKV[2048 + h * 128 + tid]); }
        const float beta = GB[h], eg = __expf(GB[8 + h]);
        LBAR();
        f32x4 part = (f32x4){0.f, 0.f, 0.f, 0.f};
#pragma unroll
        for (int i = 0; i < 8; ++i) part = part + S[i] * sk[8 * dkb + i];
        *(LAS f32x4*)(red + dkb * 128 + dv) = part;
        LBAR();
        if (tid < 128) { float ks = 0.f;
#pragma unroll
            for (int i = 0; i < 16; ++i) ks += red[i * 128 + tid];
            sw[tid] = beta * (sv[tid] - eg * ks); }
        LBAR();
        const f32x4 w = *(const LAS f32x4*)(sw + dv);
        part = (f32x4){0.f, 0.f, 0.f, 0.f};
#pragma unroll
        for (int i = 0; i < 8; ++i) { S[i] = S[i] * eg + w * sk[8 * dkb + i]; __builtin_nontemporal_store(S[i], (f32x4*)(Sout + (size_t)(8 * dkb + i) * 128 + dv)); part = part + S[i] * sq[8 * dkb + i]; }
        *(LAS f32x4*)(red + dkb * 128 + dv) = part;
        LBAR();
        if (tid < 128) { float o = 0.f;
#pragma unroll
            for (int i = 0; i < 16; ++i) o += red[i * 128 + tid];
            ((bf16_t*)(a.ws + WS_OA))[(size_t)m * 1024 + h * 128 + tid] = (bf16_t)f2bf(o); }
        LBAR();
#pragma unroll
        for (int i = 0; i < 8; ++i) S[i] = Sn[i];
    }
}
__device__ __forceinline__ void samp_gla_loop(const Args& a, LAS unsigned char* lds, int u0, int ustride, int uend, int layer) {
    const int tid = ltid();
    LAS float* sk = (LAS float*)lds, *sq = sk + 128, *se = sk + 256, *sv = sk + 384, *red = sk + 640;
    const int dv = 4 * (tid & 63), dkb = tid >> 6;
    if (u0 >= uend) return;
    f32x4 S[16], Sn[16];
    { const int h = u0 & 3, s = u0 >> 2; const float* Sin = a.in[4] + (((size_t)layer * NS + s) * 4 + h) * 32768;
#pragma unroll
      for (int i = 0; i < 16; ++i) S[i] = __builtin_nontemporal_load((const f32x4*)(Sin + (size_t)(16 * dkb + i) * 256 + dv)); }
#pragma unroll 1
    for (int unit = u0; unit < uend; unit += ustride) {
        const int h = unit & 3, s = unit >> 2, m = NPT + s, un = unit + ustride;
        if (un < uend) { const int hn = un & 3, sn = un >> 2; const float* Sin = a.in[4] + (((size_t)layer * NS + sn) * 4 + hn) * 32768;
#pragma unroll
            for (int i = 0; i < 16; ++i) Sn[i] = __builtin_nontemporal_load((const f32x4*)(Sin + (size_t)(16 * dkb + i) * 256 + dv)); }
        const bf16_t* PR = (const bf16_t*)(a.ws + WS_PROJ) + (size_t)m * PW; const float* LA = (const float*)(a.ws + WS_LA) + (size_t)m * 512;
        float* Sout = a.out + O_SL + (((size_t)layer * NS + s) * 4 + h) * 32768;
        if (tid < 128) { sq[tid] = bf2f(PR[P_QB + h * 128 + tid]) * 0.08838834764831845f; sk[tid] = bf2f(PR[P_KB + h * 128 + tid]); se[tid] = __expf(LA[h * 128 + tid]); }
        if (tid < 256) sv[tid] = bf2f(PR[P_VB + h * 256 + tid]);
        LBAR();
        const f32x4 v = *(const LAS f32x4*)(sv + dv);
        f32x4 part = (f32x4){0.f, 0.f, 0.f, 0.f};
#pragma unroll
        for (int i = 0; i < 16; ++i) { const int dk = 16 * dkb + i; S[i] = S[i] * se[dk] + v * sk[dk]; __builtin_nontemporal_store(S[i], (f32x4*)(Sout + (size_t)dk * 256 + dv)); part = part + S[i] * sq[dk]; }
        *(LAS f32x4*)(red + dkb * 256 + dv) = part;
        LBAR();
        if (tid < 256) { float o = 0.f;
#pragma unroll
            for (int i = 0; i < 8; ++i) o += red[i * 256 + tid];
            ((bf16_t*)(a.ws + WS_OB))[(size_t)m * 1024 + h * 256 + tid] = (bf16_t)f2bf(o); }
        LBAR();
#pragma unroll
        for (int i = 0; i < 16; ++i) S[i] = Sn[i];
    }
}
__device__ __forceinline__ void samp_ssd_loop(const Args& a, int u0, int ustride, int uend, int layer) {
    const int tid = ltid(), lane = tid & 63, wave = __builtin_amdgcn_readfirstlane(tid >> 6);
    const int n = 4 * (lane & 31), pb = 32 * (lane >> 5);
#pragma unroll 1
    for (int unit = u0; unit < uend; unit += ustride) {
        const int g = unit & 3, s = unit >> 2, m = NPT + s, h = g * 8 + wave;
        const bf16_t* XB = (const bf16_t*)(a.ws + WS_XBC) + (size_t)m * 3072; const float dt = ((const float*)(a.ws + WS_DT))[(size_t)m * 32 + h];
        const float dA = __expf(dt * -__expf(a.in[30][layer * 32 + h]));
        const float* Hin = a.in[6] + (((size_t)layer * NS + s) * 32 + h) * 8192 + (size_t)pb * 128 + n; float* Hout = a.out + O_SS + (((size_t)layer * NS + s) * 32 + h) * 8192 + (size_t)pb * 128 + n;
        const u32x2 bw = *(const u32x2*)(XB + 2048 + g * 128 + n), cw = *(const u32x2*)(XB + 2560 + g * 128 + n);
        const f32x4 Bv = (f32x4){bflo(bw.x), bfhi(bw.x), bflo(bw.y), bfhi(bw.y)} * dt, Cv = (f32x4){bflo(cw.x), bfhi(cw.x), bflo(cw.y), bfhi(cw.y)};
        bf16_t* YC = (bf16_t*)(a.ws + WS_YC) + (size_t)m * 2048 + h * 64 + pb;
        f32x4 hv[8], hn8[8];
#pragma unroll
        for (int i = 0; i < 8; ++i) hv[i] = __builtin_nontemporal_load((const f32x4*)(Hin + (size_t)i * 128));
#pragma unroll
        for (int i0 = 0; i0 < 32; i0 += 8) {
            if (i0 + 8 < 32) {
#pragma unroll
                for (int i = 0; i < 8; ++i) hn8[i] = __builtin_nontemporal_load((const f32x4*)(Hin + (size_t)(i0 + 8 + i) * 128));
            }
            const u32x4 xw = *(const u32x4*)(XB + h * 64 + pb + i0);
            float xs[8]; unpack8(xw, xs);
#pragma unroll
            for (int i = 0; i < 8; ++i) {
                const f32x4 hnew = hv[i] * dA + Bv * xs[i]; __builtin_nontemporal_store(hnew, (f32x4*)(Hout + (size_t)(i0 + i) * 128));
                float y = (hnew.x * Cv.x + hnew.y * Cv.y) + (hnew.z * Cv.z + hnew.w * Cv.w);
                y += __shfl_xor(y, 1); y += __shfl_xor(y, 2); y += __shfl_xor(y, 4); y += __shfl_xor(y, 8); y += __shfl_xor(y, 16);
                if ((lane & 31) == 0) YC[i0 + i] = (bf16_t)f2bf(y);
            }
#pragma unroll
            for (int i = 0; i < 8; ++i) hv[i] = hn8[i];
        }
    }
}
#ifndef REPMASK
#define REPMASK 0
#endif
__device__ __forceinline__ void m3_phase(const Args& a, LAS unsigned char* lds, int vcu, int G, int layer) {
#pragma unroll 1
    for (int u = vcu; u < 256; u += G) { if (u < 128) { scan_gdn_unit(a, lds, u, layer); scan_gla_unit(a, lds, u, layer); } else scan_ssd_unit<0>(a, lds, u - 128, layer); }
    int g0 = vcu, gs = G, ge = 1024, l0 = vcu, ls = G, le = 512;
    if (G == 256) { const int r = vcu & 127; gs = 128; ls = 128;
        if (vcu < 128) { g0 = r; ge = 256; l0 = r; le = 128; } else { g0 = 256 + r; ge = 1024; l0 = 128 + r; le = 512; } }
    samp_gdn_loop(a, lds, g0, gs, ge, layer);
    samp_gla_loop(a, lds, l0, ls, le, layer);
    samp_ssd_loop(a, vcu, G, 512, layer);
}

__device__ __forceinline__ void m4_phase(const Args& a, int vcu, int G, int layer) {
    const int tid = ltid(), lane = tid & 63, wave = __builtin_amdgcn_readfirstlane(tid >> 6);
    const int gw = vcu * NWAVES + wave, NGW = G * NWAVES;
    const bf16_t* PROJ = (const bf16_t*)(a.ws + WS_PROJ); const bf16_t* OA = (const bf16_t*)(a.ws + WS_OA); const bf16_t* OB = (const bf16_t*)(a.ws + WS_OB); const bf16_t* YC = (const bf16_t*)(a.ws + WS_YC);
    const bf16_t* XBC = (const bf16_t*)(a.ws + WS_XBC); bf16_t* BR = (bf16_t*)(a.ws + WS_BR);
    const float* gnw = a.in[24] + (size_t)layer * 128; const float* lnw = a.in[27] + (size_t)layer * 256; const float* snw = a.in[33] + (size_t)layer * 2048; const float* sd = a.in[32] + (size_t)layer * 32;
    auto gdn_piece = [&](int m, int it, const u32x4 loa, const u32x4 lza) __attribute__((always_inline)) {
        const int ch = it * 512 + lane * 8; float o[8], z[8];
        unpack8(loa, o); unpack8(lza, z);
        float ss = 0.f;
#pragma unroll
        for (int i = 0; i < 8; ++i) ss += o[i] * o[i];
        ss += __shfl_xor(ss, 1); ss += __shfl_xor(ss, 2); ss += __shfl_xor(ss, 4); ss += __shfl_xor(ss, 8);
        const float r = 1.0f / sqrtf(ss * (1.f / 128.f) + EPS);
        const f32x4 w0 = *(const f32x4*)(gnw + (ch & 127)), w1 = *(const f32x4*)(gnw + (ch & 127) + 4);
#pragma unroll
        for (int i = 0; i < 4; ++i) { o[i] = o[i] * r * w0[i] * siluf_(z[i]); o[4 + i] = o[4 + i] * r * w1[i] * siluf_(z[4 + i]); }
        *(u32x4*)(BR + (size_t)m * 4096 + ch) = pack8(o);
    };
    auto gla_piece = [&](int m, int it, const u32x4 lob, const u32x4 lrb) __attribute__((always_inline)) {
        const int ch = it * 512 + lane * 8; float o[8], z[8];
        unpack8(lob, o); unpack8(lrb, z);
        float ss = 0.f;
#pragma unroll
        for (int i = 0; i < 8; ++i) ss += o[i] * o[i];
        ss += __shfl_xor(ss, 1); ss += __shfl_xor(ss, 2); ss += __shfl_xor(ss, 4); ss += __shfl_xor(ss, 8); ss += __shfl_xor(ss, 16);
        const float r = 1.0f / sqrtf(ss * (1.f / 256.f) + EPS);
        const f32x4 w0 = *(const f32x4*)(lnw + (ch & 255)), w1 = *(const f32x4*)(lnw + (ch & 255) + 4);
#pragma unroll
        for (int i = 0; i < 4; ++i) { o[i] = o[i] * r * w0[i] * siluf_(z[i]); o[4 + i] = o[4 + i] * r * w1[i] * siluf_(z[4 + i]); }
        *(u32x4*)(BR + (size_t)m * 4096 + 1024 + ch) = pack8(o);
    };
    auto ssd_piece = [&](int m, int it, const u32x4 lyc, const u32x4 lxc, const u32x4 lzc) __attribute__((always_inline)) {
        const int ch = it * 512 + lane * 8; float y[8], x[8], z[8];
        unpack8(lyc, y); unpack8(lxc, x); unpack8(lzc, z);
        const float dd = sd[ch >> 6]; float ss = 0.f;
#pragma unroll
        for (int i = 0; i < 8; ++i) { y[i] = (y[i] + dd * x[i]) * siluf_(z[i]); ss += y[i] * y[i]; }
        ss = wave_sum(ss);
        const float r = 1.0f / sqrtf(ss * (1.f / 512.f) + EPS);
        const f32x4 w0 = *(const f32x4*)(snw + ch), w1 = *(const f32x4*)(snw + ch + 4);
#pragma unroll
        for (int i = 0; i < 4; ++i) { y[i] = y[i] * r * w0[i]; y[4 + i] = y[4 + i] * r * w1[i]; }
        *(u32x4*)(BR + (size_t)m * 4096 + 2048 + ch) = pack8(y);
    };
#pragma unroll 1
    for (int m = gw; m < NPT; m += NGW) {
        const bf16_t* pr = PROJ + (size_t)m * PW;
        u32x4 l_oa[2], l_za[2], l_ob[2], l_rb[2], l_yc[4], l_xc[4], l_zc[4];
#pragma unroll
        for (int it = 0; it < 2; ++it) { const int ch = it * 512 + lane * 8;
            l_oa[it] = *(const u32x4*)(OA + (size_t)m * 1024 + ch); l_za[it] = *(const u32x4*)(pr + P_ZA + ch);
            l_ob[it] = *(const u32x4*)(OB + (size_t)m * 1024 + ch); l_rb[it] = *(const u32x4*)(pr + P_RB + ch); }
#pragma unroll
        for (int it = 0; it < 4; ++it) { const int ch = it * 512 + lane * 8;
            l_yc[it] = *(const u32x4*)(YC + (size_t)m * 2048 + ch); l_xc[it] = *(const u32x4*)(XBC + (size_t)m * 3072 + ch); l_zc[it] = *(const u32x4*)(pr + P_ZC + ch); }
#pragma unroll
        for (int it = 0; it < 2; ++it) gdn_piece(m, it, l_oa[it], l_za[it]);
#pragma unroll
        for (int it = 0; it < 2; ++it) gla_piece(m, it, l_ob[it], l_rb[it]);
#pragma unroll
        for (int it = 0; it < 4; ++it) ssd_piece(m, it, l_yc[it], l_xc[it], l_zc[it]);
    }
#pragma unroll 1
    for (int p = gw; p < 8 * NS; p += NGW) {
        const int m = NPT + (p >> 3), pc = p & 7; const bf16_t* pr = PROJ + (size_t)m * PW;
        if (pc < 2) { const int ch = pc * 512 + lane * 8; gdn_piece(m, pc, *(const u32x4*)(OA + (size_t)m * 1024 + ch), *(const u32x4*)(pr + P_ZA + ch)); }
        else if (pc < 4) { const int it = pc - 2, ch = it * 512 + lane * 8; gla_piece(m, it, *(const u32x4*)(OB + (size_t)m * 1024 + ch), *(const u32x4*)(pr + P_RB + ch)); }
        else { const int it = pc - 4, ch = it * 512 + lane * 8; ssd_piece(m, it, *(const u32x4*)(YC + (size_t)m * 2048 + ch), *(const u32x4*)(XBC + (size_t)m * 3072 + ch), *(const u32x4*)(pr + P_ZC + ch)); }
    }
}

#ifndef MK_N_LAUNCHES
#define MK_N_LAUNCHES 1
#endif
constexpr int PH_PER_LAYER = 14, N_PHASES = 2 + 2 * PH_PER_LAYER + 1;
constexpr int CW_BAR = 4096;

#define AS4 __attribute__((address_space(4)))
__device__ __forceinline__ Args load_args() {
    Args r;
#if defined(__HIP_DEVICE_COMPILE__)
    const AS4 Args* ap = (const AS4 Args*)__builtin_amdgcn_kernarg_segment_ptr(); asm volatile("" : "+s"(ap));
    for (int i = 0; i < 39; ++i) r.in[i] = ap->in[i]; r.out = ap->out; r.ws = ap->ws; r.ph_lo = ap->ph_lo; r.ph_hi = ap->ph_hi;
#else
    r = Args{};
#endif
    return r;
}
#define LAYER_PTRS unsigned char* lw = a.ws + WS_W + (size_t)layer * LW_SIZE; const float* modl = (const float*)(a.ws + WS_MOD) + (size_t)layer * NCR * NMOD; \
    float* X = (float*)(a.ws + WS_X); const bf16_t* H = (const bf16_t*)(a.ws + WS_H); bf16_t* ACT = (bf16_t*)(a.ws + WS_ACT); bf16_t* PROJ = (bf16_t*)(a.ws + WS_PROJ); float* SMALL = (float*)(a.ws + WS_SMALL); \
    bf16_t* BR = (bf16_t*)(a.ws + WS_BR); float* MRG = (float*)(a.ws + WS_MRG); bf16_t* MRGB = (bf16_t*)(a.ws + WS_MRGB); (void)lw; (void)modl; (void)X; (void)H; (void)ACT; (void)PROJ; (void)SMALL; (void)BR; (void)MRG; (void)MRGB;
#define PHASE_FN __device__ __forceinline__ void
PHASE_FN ph_gateup(LAS unsigned char* lds, int G, int bx, int layer, int which) {
    const Args a = load_args(); LAYER_PTRS
    pg8::Gemm g{H, (const bf16_t*)(lw + (which ? LW_GU2 : LW_GU1)), D}; pg8::Sched S; S.init(MP / 256, 2 * FF / 256, G, bx, D);
    EpiSwiglu E{ACT}; pg8::gemm_phase<EpiSwiglu>(lds, g, S, E);
#ifndef CVT_ALL_IN_P0
    {
        constexpr int NWG = (MP / 256) * (2 * FF / 256); const int rem = NWG % G, set = layer == 0 ? (which ? 3 : 1) : (which ? -1 : 4);
        if (rem != 0 && bx >= rem && set > 0) convert_set(a, lds, bx - rem, G - rem, set);
    }
#endif
}
PHASE_FN ph_down(LAS unsigned char* lds, int vcu, int G, int bx, int layer, int which) {
    const Args a = load_args(); LAYER_PTRS
    const bf16_t* W = (const bf16_t*)(lw + (which ? LW_D2 : LW_D1)); const float* gate = modl + (which ? 8 : 2) * D;
    pg8::Gemm g{ACT, W, FF}; pg8::Sched S; S.init(NPT / 256, D / 256, G, bx, FF); S.nmini = 8 * 21; S.mini_last_nt = 6;
    EpiResid E{X, gate, 0.5f, (float*)(a.ws + WS_PART)}; pg8::gemm_phase<EpiResid>(lds, g, S, E);
}
PHASE_FN ph_win(LAS unsigned char* lds, int G, int bx, int layer) {
    const Args a = load_args(); LAYER_PTRS
    pg8::Gemm g{H, (const bf16_t*)(lw + LW_IN), D}; pg8::Sched S; S.init(MP / 256, NINP / 256, G, bx, D);
    EpiWin E{PROJ, SMALL}; pg8::gemm_phase<EpiWin>(lds, g, S, E);
#ifndef CVT_ALL_IN_P0
    {
        constexpr int NWG = (MP / 256) * (NINP / 256); const int rem = NWG % G;
        if (rem != 0 && bx >= rem) convert_set(a, lds, bx - rem, G - rem, layer == 0 ? 2 : 5);
    }
#endif
}
PHASE_FN ph_branch(LAS unsigned char* lds, int vcu, int G, int bx, int layer) {
    const Args a = load_args(); LAYER_PTRS
    pg8::Gemm g{BR, (const bf16_t*)(lw + LW_BR), 4096}; pg8::Sched S; S.init(NPT / 256, D / 256, G, bx, 4096);
    S.nseg = 3;
    EpiBranch E{MRG, MRGB, PROJ}; pg8::gemm_phase<EpiBranch>(lds, g, S, E);
    skinny_branch(lds, vcu, G, BR, (const bf16_t*)(lw + LW_BR), MRGB, PROJ);
    if ((REPMASK >> 23) & 1) { skinny_gemm(a, lds, vcu, G, BR, 4096, (const bf16_t*)(lw + LW_BR), 4096, 3, 1024, 1024, 2048, 1, nullptr, nullptr, 0.f, MRGB, PROJ); skinny_gemm(a, lds, vcu, G, BR, 4096, (const bf16_t*)(lw + LW_BR), 4096, 3, 1024, 1024, 2048, 1, nullptr, nullptr, 0.f, MRGB, PROJ); skinny_gemm(a, lds, vcu, G, BR, 4096, (const bf16_t*)(lw + LW_BR), 4096, 3, 1024, 1024, 2048, 1, nullptr, nullptr, 0.f, MRGB, PROJ); }
}
PHASE_FN ph_out(LAS unsigned char* lds, int vcu, int G, int bx, int layer) {
    const Args a = load_args(); LAYER_PTRS
    pg8::Gemm g{MRGB, (const bf16_t*)(lw + LW_OUT), D}; pg8::Sched S; S.init(NPT / 256, D / 256, G, bx, D); S.nmini = 8 * 8; S.mini_last_nt = 4;
    EpiResid E{X, modl + 5 * D, 1.0f, (float*)(a.ws + WS_PART)}; pg8::gemm_phase<EpiResid>(lds, g, S, E);
}

__global__ void __launch_bounds__(NTHR, 2) mk_fwd(Args a0) {
    extern __shared__ __attribute__((aligned(16))) unsigned char lds_raw[];
    LAS unsigned char* lds = (LAS unsigned char*)lds_raw;
    const int G = gridDim.x, bx = blockIdx.x, vcu = (G % 8 == 0) ? (bx % 8) * (G / 8) + bx / 8 : bx;
    const int lo = a0.ph_lo, hi = a0.ph_hi;
    if (threadIdx.x < 16) ((LAS unsigned*)(lds + LDSCTL_OFF))[threadIdx.x] = 0u;
    __syncthreads();
    XcdBarrier bar; bar.bar = (unsigned*)(a0.ws + WS_CTL) + CW_BAR; bar.x = 0; bar.st = (volatile LAS unsigned*)(lds + LDSCTL_OFF);
    if (hi - lo > 1) bar = xcd_barrier_post((unsigned*)(a0.ws + WS_CTL) + CW_BAR, (volatile LAS unsigned*)(lds + LDSCTL_OFF));
#ifndef ONLY_PH
#define ONLY_PH -1
#endif
#define IN(k) ((ONLY_PH < 0 || ONLY_PH == (((k) < 2 || (k) == N_PHASES - 1) ? (k) : 2 + ((k) - 2) % PH_PER_LAYER)) && lo <= (k) && (k) < hi)
#ifndef REPMASK
#define REPMASK 0
#endif
#define REP(j) if ((REPMASK >> (j)) & 1)
#define SEAM(k) do { if (IN(k) && IN((k) + 1)) { xcd_barrier(bar); if ((REPMASK >> 24) & 1) { xcd_barrier(bar); xcd_barrier(bar); } } } while (0)
    if (IN(0)) { const Args a = load_args(); p0_convert(a, lds, vcu, G); REP(14) p0_convert(a, lds, vcu, G); } SEAM(0);
    if (IN(1)) { const Args a = load_args(); p1_mod(a, lds, vcu, G); REP(15) p1_mod(a, lds, vcu, G); } SEAM(1);
    for (int layer = 0; layer < 2; ++layer) {
        const int pb = 2 + layer * PH_PER_LAYER;
        if ((REPMASK >> 25) & 1) { const unsigned long long t0 = __builtin_amdgcn_s_memrealtime(); while (__builtin_amdgcn_s_memrealtime() - t0 < 20000ull) __builtin_amdgcn_s_sleep(32); }
        if (IN(pb + 0)) { const Args a = load_args(); const float* mod0 = (const float*)(a.ws + WS_MOD); norm_mod_phase(a, lds, vcu, G, layer, 0, layer == 0, layer == 0 ? 0 : 21, mod0 + 8 * D, 0.5f); } SEAM(pb + 0);
        if (IN(pb + 1)) { ph_gateup(lds, G, bx, layer, 0); REP(1) ph_gateup(lds, G, bx, layer, 0); } SEAM(pb + 1);
        if (IN(pb + 2)) ph_down(lds, vcu, G, bx, layer, 0); SEAM(pb + 2);
        if (IN(pb + 3)) { const Args a = load_args(); const float* modl = (const float*)(a.ws + WS_MOD) + (size_t)layer * NCR * NMOD; norm_mod_phase(a, lds, vcu, G, layer, 1, false, 21, modl + 2 * D, 0.5f); } SEAM(pb + 3);
        if (IN(pb + 4)) { ph_win(lds, G, bx, layer); REP(4) ph_win(lds, G, bx, layer); } SEAM(pb + 4);
        if (IN(pb + 5)) { const Args a = load_args(); m1_phase(a, vcu, G, layer); REP(5) m1_phase(a, vcu, G, layer); } SEAM(pb + 5);
        if (IN(pb + 6)) { const Args a = load_args(); m2_phase(a, lds, vcu, G, layer); REP(6) m2_phase(a, lds, vcu, G, layer); } SEAM(pb + 6);
        if (IN(pb + 7)) { const Args a = load_args(); m3_phase(a, lds, vcu, G, layer); REP(7) m3_phase(a, lds, vcu, G, layer); } SEAM(pb + 7);
        if (IN(pb + 8)) { const Args a = load_args(); m4_phase(a, vcu, G, layer); REP(8) m4_phase(a, vcu, G, layer); } SEAM(pb + 8);
        if (IN(pb + 9)) { ph_branch(lds, vcu, G, bx, layer); REP(9) ph_branch(lds, vcu, G, bx, layer); } SEAM(pb + 9);
        if (IN(pb + 10)) ph_out(lds, vcu, G, bx, layer); SEAM(pb + 10);
        if (IN(pb + 11)) { const Args a = load_args(); const float* modl = (const float*)(a.ws + WS_MOD) + (size_t)layer * NCR * NMOD; norm_mod_phase(a, lds, vcu, G, layer, 2, false, 8, modl + 5 * D, 1.0f); } SEAM(pb + 11);
        if (IN(pb + 12)) ph_gateup(lds, G, bx, layer, 1); SEAM(pb + 12);
        if (IN(pb + 13)) ph_down(lds, vcu, G, bx, layer, 1); SEAM(pb + 13);
    }
    { const Args af = load_args(); if (af.ph_lo <= N_PHASES - 1 && N_PHASES - 1 < af.ph_hi) {
    const Args a = af; const float* mod1 = (const float*)(a.ws + WS_MOD) + (size_t)NCR * NMOD; final_norm_phase(a, lds, vcu, G, 21, mod1 + 8 * D, 0.5f); } }
#undef IN
#undef SEAM
}

extern "C" void kernel_launch(void* const* d_in, const int* in_sizes, int n_in, void* d_out, int out_size, void* d_ws, size_t ws_size, hipStream_t stream) {
    static int grid = 0;
    if (grid == 0) {
        if (n_in != 39 || (size_t)out_size != O_END || ws_size < WS_END) {
            fprintf(stderr, "kernel_launch: built for 39 inputs, %zu outputs, >= %zu bytes of workspace; got n_in %d, out %d, ws %zu; nothing launched\n", (size_t)O_END, (size_t)WS_END, n_in, out_size, ws_size);
            grid = -1; return; }
        int dev = 0, cus = 0, per_cu = 0;
        if (hipGetDevice(&dev) != hipSuccess || hipDeviceGetAttribute(&cus, hipDeviceAttributeMultiprocessorCount, dev) != hipSuccess) { grid = -1; return; }
        if (hipFuncSetAttribute((const void*)mk_fwd, hipFuncAttributeMaxDynamicSharedMemorySize, LDS_BYTES) != hipSuccess) { fprintf(stderr, "kernel_launch: hipFuncSetAttribute failed\n"); grid = -1; return; }
        if (hipOccupancyMaxActiveBlocksPerMultiprocessor(&per_cu, (const void*)mk_fwd, NTHR, LDS_BYTES) != hipSuccess || per_cu < 1)
            fprintf(stderr, "kernel_launch: note: occupancy query reports %d workgroups per CU\n", per_cu);
        (void)hipGetLastError();
        grid = cus;
    }
    if (grid < 0) return;
    if (hipMemsetAsync((char*)d_ws + WS_CTL, 0, CTL_BYTES, stream) != hipSuccess) { fprintf(stderr, "kernel_launch: memset failed\n"); return; }
    Args a{};
    for (int i = 0; i < 39; ++i) a.in[i] = (const float*)d_in[i];
    a.out = (float*)d_out; a.ws = (unsigned char*)d_ws;
#if MK_N_LAUNCHES == 1
    a.ph_lo = 0; a.ph_hi = N_PHASES;
    hipLaunchKernelGGL(mk_fwd, dim3(grid), dim3(NTHR), LDS_BYTES, stream, a);
#else
    for (int p = 0; p < N_PHASES; ++p) { a.ph_lo = p; a.ph_hi = p + 1; hipLaunchKernelGGL(mk_fwd, dim3(grid), dim3(NTHR), LDS_BYTES, stream, a); }
#endif
    const hipError_t le = hipPeekAtLastError();
    if (le != hipSuccess) fprintf(stderr, "kernel_launch: launch failed: %s\n", hipGetErrorName(le));
}
```
